# Optimizing an MI355X kernel written in HIP

```python
import jax, jax.numpy as jnp
from jax import lax
import numpy as np

D_MODEL = 4096
BATCH = 4
SEQ = 4096
DEPTH = 4

CTX_LEN = 256
GRID_W = 64
EPS = 1e-6
ROPE_BASE = 10000.0
ATTN_BLOCK = 128
CHUNK = 64

MLA_V = 128
MLA_NOPE = 128
MLA_ROPE = 64
MLA_QK = MLA_NOPE + MLA_ROPE
MLA_HEADS = (D_MODEL // 2) // MLA_V
MLA_W = MLA_HEADS * MLA_V
Q_LORA = 1536
KV_LORA = 512
HG_DK = 128
HG_DV = 128
HG_HEADS = (D_MODEL // 2) // HG_DV
HG_K = HG_HEADS * HG_DK
HG_W = HG_HEADS * HG_DV
RET_DK = 256
RET_DV = 2 * RET_DK
RET_HEADS = D_MODEL // RET_DK
RET_K = RET_HEADS * RET_DK
RET_W = RET_HEADS * RET_DV

N_EVEN = (DEPTH + 1) // 2
N_ODD = DEPTH // 2

E_CQ = 0
E_CKV = E_CQ + Q_LORA
E_KPE = E_CKV + KV_LORA
E_GM = E_KPE + MLA_ROPE
E_QH = E_GM + MLA_W
E_FF = E_QH + HG_K
E_FB = E_FF + HG_K
E_IH = E_FB + HG_K
E_GH = E_IH + HG_W
E_END = E_GH + HG_W
EVEN_SPLIT = (E_CKV, E_KPE, E_GM, E_QH, E_FF, E_FB, E_IH, E_GH)
O_K = RET_K
O_V = 2 * RET_K
O_G = 2 * RET_K + RET_W
O_END = O_G + RET_W

kernel_name = "hybrid_mla_hgrn2_retention_dit"


def rms_norm(x, gain=None):
    xf = x.astype(jnp.float32)
    y = xf * lax.rsqrt(jnp.mean(xf * xf, axis=-1, keepdims=True) + EPS)
    if gain is not None:
        y = y * gain.astype(jnp.float32)
    return y.astype(x.dtype)


def adaln(cond, w_mod, b_mod):
    m = (jax.nn.silu(cond) @ w_mod + b_mod)[..., None, :]
    shift, scale, gate = jnp.split(m, 3, axis=-1)
    return shift, scale, gate


def ada_in(x, gain, mod):
    shift, scale, _ = mod
    return rms_norm(x, gain) * (1 + scale) + shift


def grid_positions(n_tok):
    rows = n_tok // GRID_W
    row = jnp.repeat(jnp.arange(rows), GRID_W).astype(jnp.float32)
    col = jnp.tile(jnp.arange(GRID_W), rows).astype(jnp.float32)
    return row, col


def rotate(x, ang):
    cos = jnp.cos(ang)[:, None, :].astype(x.dtype)
    sin = jnp.sin(ang)[:, None, :].astype(x.dtype)
    x1, x2 = jnp.split(x, 2, axis=-1)
    return jnp.concatenate([x1 * cos - x2 * sin, x1 * sin + x2 * cos], axis=-1)


def rope_2d(x, row, col):
    half = x.shape[-1] // 2
    inv = ROPE_BASE ** (-jnp.arange(0, half, 2, dtype=jnp.float32) / half)
    return jnp.concatenate([rotate(x[..., :half], row[:, None] * inv),
                            rotate(x[..., half:], col[:, None] * inv)], axis=-1)


def rope_retnet(x, pos):
    inv = 1.0 / (ROPE_BASE ** jnp.linspace(0.0, 1.0, x.shape[-1] // 2, dtype=jnp.float32))
    return rotate(x, pos[:, None] * inv)


def to_heads(a, n_heads):
    bn, t, _ = a.shape
    return a.reshape(bn, t, n_heads, -1).transpose(0, 2, 1, 3)


def rope_part(t, pos):
    row, col = pos
    return jnp.concatenate([t[..., :MLA_NOPE], rope_2d(t[..., MLA_NOPE:], row, col)], axis=-1)


def mla_q(cq, q_a_gain, w_uq, q_gain, pos):
    bn, t = cq.shape[:2]
    q = (rms_norm(cq, q_a_gain) @ w_uq).reshape(bn, t, MLA_HEADS, MLA_QK)
    q = rms_norm(q, q_gain)
    return q if pos is None else rope_part(q, pos)


def mla_kv(ckv, kpe, kv_a_gain, w_ukv, k_gain, pos):
    bn, t = ckv.shape[:2]
    kv = (rms_norm(ckv, kv_a_gain) @ w_ukv).reshape(bn, t, MLA_HEADS, MLA_NOPE + MLA_V)
    k = jnp.concatenate([kv[..., :MLA_NOPE],
                         jnp.broadcast_to(kpe[:, :, None, :], (bn, t, MLA_HEADS, MLA_ROPE))], axis=-1)
    k = rms_norm(k, k_gain)
    if pos is not None:
        k = rope_part(k, pos)
    return k, kv[..., MLA_NOPE:]


def attend(q, k, v):
    s = jnp.einsum('bqhd,bkhd->bhqk', q, k).astype(jnp.float32) * (MLA_QK ** -0.5)
    p = jax.nn.softmax(s, axis=-1).astype(v.dtype)
    return jnp.einsum('bhqk,bkhd->bqhd', p, v)


def blocked_attend(q, k, v):
    bn, t, h, d = q.shape
    n_blk = t // ATTN_BLOCK
    qb = q.reshape(bn, n_blk, ATTN_BLOCK, h, d).transpose(1, 0, 2, 3, 4)
    ob = lax.map(lambda qq: attend(qq, k, v), qb)
    return ob.transpose(1, 0, 2, 3, 4).reshape(bn, t, h, -1)


def chunk_scan(q, k, v, logf, s0):
    out_dtype = v.dtype
    f32 = jnp.float32
    q, k, v, logf, s0 = (a.astype(f32) for a in (q, k, v, logf, s0))
    bn, h, t, _ = q.shape
    n_chunk = t // CHUNK

    def to_chunks(a):
        return a.reshape(bn, h, n_chunk, CHUNK, a.shape[-1]).transpose(2, 0, 1, 3, 4)

    mask = jnp.tril(jnp.ones((CHUNK, CHUNK), dtype=bool))[:, :, None]

    def step(state, inp):
        qc, kc, vc, gc = inp
        b = jnp.cumsum(gc, axis=2)
        b_last = b[:, :, -1:, :]
        rel = b[:, :, :, None, :] - b[:, :, None, :, :]
        dec = jnp.exp(jnp.where(mask, rel, -jnp.inf))
        if gc.shape[-1] == 1:
            a = jnp.einsum('bhtd,bhsd->bhts', qc, kc) * dec[..., 0]
        else:
            a = jnp.einsum('bhtd,bhsd,bhtsd->bhts', qc, kc, dec)
        o = (jnp.einsum('bhts,bhsv->bhtv', a, vc)
             + jnp.einsum('bhtd,bhdv->bhtv', qc * jnp.exp(b), state))
        state = (jnp.exp(b_last[:, :, 0, :, None]) * state
                 + jnp.einsum('bhsd,bhsv->bhdv', kc * jnp.exp(b_last - b), vc))
        return state, o

    s_fin, o = lax.scan(step, s0, (to_chunks(q), to_chunks(k), to_chunks(v), to_chunks(logf)))
    o = o.transpose(1, 2, 0, 3, 4).reshape(bn, h, t, -1)
    return o.astype(out_dtype), s_fin


def final_state(k, v, logf):
    f32 = jnp.float32
    b = jnp.cumsum(logf.astype(f32), axis=2)
    return jnp.einsum('bhsd,bhsv->bhdv', k.astype(f32) * jnp.exp(b[:, :, -1:] - b), v.astype(f32))


def flip_t(a):
    return jnp.flip(a, axis=2)


def bidir_scan(q, k_f, k_b, v, lg_f, lg_b, s0_f, s0_b):
    o_f, s_f = chunk_scan(q, k_f, v, lg_f, s0_f)
    o_b, s_b = chunk_scan(flip_t(q), flip_t(k_b), flip_t(v), flip_t(lg_b), s0_b)
    return o_f + flip_t(o_b), s_f, s_b


def bidir_final_states(k_f, k_b, v, lg_f, lg_b):
    s_f = final_state(k_f, v, lg_f)
    s_b = final_state(flip_t(k_b), flip_t(v), flip_t(lg_b))
    return s_f, s_b


def hgrn_gates(f, lb):
    ff = f.astype(jnp.float32)
    log_g = jnp.logaddexp(jnp.log(lb), jnp.log1p(-lb) + jax.nn.log_sigmoid(ff))
    key = (1.0 - lb) * jax.nn.sigmoid(-ff)
    return to_heads(key, HG_HEADS), to_heads(log_g, HG_HEADS)


def even_merge(att, g_m, o_h, g_h, hg_gain):
    bn, t = att.shape[:2]
    a = att.reshape(bn, t, MLA_W) * jax.nn.silu(g_m)
    o = rms_norm(o_h.transpose(0, 2, 1, 3), hg_gain).reshape(bn, t, HG_W) * jax.nn.silu(g_h)
    return jnp.concatenate([a, o], axis=-1)


def ret_merge(o, g):
    bn, _, t, _ = o.shape
    return rms_norm(o.transpose(0, 2, 1, 3)).reshape(bn, t, RET_W) * jax.nn.silu(g)


def even_layer(x, xc, mod_lat, mod_ctx, gain, w_in, q_a_gain, kv_a_gain, w_uq, w_ukv,
               q_gain, k_gain, lb, hg_gain, w_out, pos, ctx_out):
    bn = x.shape[0]
    zeros = jnp.zeros((bn, HG_HEADS, HG_DK, HG_DV), jnp.float32)
    hc = ada_in(xc, gain, mod_ctx)
    if ctx_out:
        cq, ckv, kpe, gm, qh, ff, fb, ih, gh = jnp.split(hc @ w_in, EVEN_SPLIT, axis=-1)
        kc, vc = mla_kv(ckv, kpe, kv_a_gain, w_ukv, k_gain, None)
        att_c = attend(mla_q(cq, q_a_gain, w_uq, q_gain, None), kc, vc)
        kf, lgf = hgrn_gates(ff, lb[0])
        kb, lgb = hgrn_gates(fb, lb[1])
        o_c, s_f, s_b = bidir_scan(to_heads(qh, HG_HEADS), kf, kb, to_heads(ih, HG_HEADS),
                                   lgf, lgb, zeros, zeros)
        xc = xc + mod_ctx[2] * (even_merge(att_c, gm, o_c, gh, hg_gain) @ w_out)
    else:
        ckv, kpe = jnp.split(hc @ w_in[:, E_CKV:E_GM], [KV_LORA], axis=-1)
        ff, fb, ih = jnp.split(hc @ w_in[:, E_FF:E_GH], [HG_K, 2 * HG_K], axis=-1)
        kc, vc = mla_kv(ckv, kpe, kv_a_gain, w_ukv, k_gain, None)
        kf, lgf = hgrn_gates(ff, lb[0])
        kb, lgb = hgrn_gates(fb, lb[1])
        s_f, s_b = bidir_final_states(kf, kb, to_heads(ih, HG_HEADS), lgf, lgb)
        xc = None
    h = ada_in(x, gain, mod_lat)
    cq, ckv, kpe, gm, qh, ff, fb, ih, gh = jnp.split(h @ w_in, EVEN_SPLIT, axis=-1)
    q = mla_q(cq, q_a_gain, w_uq, q_gain, pos)
    k, v = mla_kv(ckv, kpe, kv_a_gain, w_ukv, k_gain, pos)
    att = blocked_attend(q, jnp.concatenate([k, kc], axis=1), jnp.concatenate([v, vc], axis=1))
    kf, lgf = hgrn_gates(ff, lb[0])
    kb, lgb = hgrn_gates(fb, lb[1])
    o_h, _, _ = bidir_scan(to_heads(qh, HG_HEADS), kf, kb, to_heads(ih, HG_HEADS), lgf, lgb, s_f, s_b)
    x = x + mod_lat[2] * (even_merge(att, gm, o_h, gh, hg_gain) @ w_out)
    return x, xc


def odd_layer(x, xc, mod_lat, mod_ctx, gain, w_in, decay_logit, w_out, tpos, ctx_out):
    bn = x.shape[0]
    log_gamma = jax.nn.log_sigmoid(decay_logit.astype(jnp.float32))

    def decays(t):
        return (jnp.broadcast_to(log_gamma[0][None, :, None, None], (bn, RET_HEADS, t, 1)),
                jnp.broadcast_to(log_gamma[1][None, :, None, None], (bn, RET_HEADS, t, 1)))

    zeros = jnp.zeros((bn, RET_HEADS, RET_DK, RET_DV), jnp.float32)
    k_scale = RET_DK ** -0.5
    hc = ada_in(xc, gain, mod_ctx)
    t_c = xc.shape[1]
    lgf_c, lgb_c = decays(t_c)
    if ctx_out:
        q, k, v, g = jnp.split(hc @ w_in, [O_K, O_V, O_G], axis=-1)
        kh = to_heads(k, RET_HEADS) * k_scale
        o_c, s_f, s_b = bidir_scan(to_heads(q, RET_HEADS), kh, kh, to_heads(v, RET_HEADS),
                                   lgf_c, lgb_c, zeros, zeros)
        xc = xc + mod_ctx[2] * (ret_merge(o_c, g) @ w_out)
    else:
        k, v = jnp.split(hc @ w_in[:, O_K:O_G], [RET_K], axis=-1)
        kh = to_heads(k, RET_HEADS) * k_scale
        s_f, s_b = bidir_final_states(kh, kh, to_heads(v, RET_HEADS), lgf_c, lgb_c)
        xc = None
    h = ada_in(x, gain, mod_lat)
    t = x.shape[1]
    q, k, v, g = jnp.split(h @ w_in, [O_K, O_V, O_G], axis=-1)
    qh = rope_retnet(q.reshape(bn, t, RET_HEADS, RET_DK), tpos).transpose(0, 2, 1, 3)
    kh = (rope_retnet(k.reshape(bn, t, RET_HEADS, RET_DK), tpos) * k_scale).transpose(0, 2, 1, 3)
    lgf, lgb = decays(t)
    o, _, _ = bidir_scan(qh, kh, kh, to_heads(v, RET_HEADS), lgf, lgb, s_f, s_b)
    x = x + mod_lat[2] * (ret_merge(o, g) @ w_out)
    return x, xc


def setup_inputs(seed: int = 0) -> dict:
    key = jax.random.key(seed)
    ks = jax.random.split(key, 24)
    f32 = jnp.float32

    def nrm(k, shape, scale):
        return jax.random.normal(k, shape, f32) * scale

    gam = 1.0 - 2.0 ** (-5.0 - jnp.arange(RET_HEADS, dtype=f32))
    ret_logit = jnp.log(gam) - jnp.log1p(-gam)
    return {
        "x": nrm(ks[0], (BATCH, SEQ, D_MODEL), 1.0),
        "c": nrm(ks[1], (BATCH, D_MODEL), 1.0),
        "ctx": nrm(ks[2], (BATCH, CTX_LEN, D_MODEL), 1.0),
        "c_ctx": nrm(ks[3], (D_MODEL,), 1.0),
        "mod_w": nrm(ks[4], (DEPTH, D_MODEL, 3 * D_MODEL), D_MODEL ** -0.5),
        "mod_b": nrm(ks[5], (DEPTH, 3 * D_MODEL), 0.02),
        "norm_gain": 1.0 + nrm(ks[6], (DEPTH, D_MODEL), 0.02),
        "even_w_in": nrm(ks[7], (N_EVEN, D_MODEL, E_END), D_MODEL ** -0.5),
        "q_a_gain": 1.0 + nrm(ks[8], (N_EVEN, Q_LORA), 0.02),
        "kv_a_gain": 1.0 + nrm(ks[9], (N_EVEN, KV_LORA), 0.02),
        "w_uq": nrm(ks[10], (N_EVEN, Q_LORA, MLA_HEADS * MLA_QK), Q_LORA ** -0.5),
        "w_ukv": nrm(ks[11], (N_EVEN, KV_LORA, MLA_HEADS * (MLA_NOPE + MLA_V)), KV_LORA ** -0.5),
        "q_norm_gain": 1.0 + nrm(ks[12], (N_EVEN, MLA_QK), 0.02),
        "k_norm_gain": 1.0 + nrm(ks[13], (N_EVEN, MLA_QK), 0.02),
        "hg_lb": nrm(ks[14], (N_EVEN, 2, HG_K), 1.0),
        "hg_norm_gain": 1.0 + nrm(ks[15], (N_EVEN, HG_DV), 0.02),
        "even_w_out": nrm(ks[16], (N_EVEN, MLA_W + HG_W, D_MODEL), (MLA_W + HG_W) ** -0.5),
        "odd_w_in": nrm(ks[17], (N_ODD, D_MODEL, O_END), D_MODEL ** -0.5),
        "ret_decay": ret_logit + nrm(ks[18], (N_ODD, 2, RET_HEADS), 0.1),
        "odd_w_out": nrm(ks[19], (N_ODD, RET_W, D_MODEL), RET_W ** -0.5),
    }


def reference(x, c, ctx, c_ctx, mod_w, mod_b, norm_gain, even_w_in, q_a_gain, kv_a_gain, w_uq,
              w_ukv, q_norm_gain, k_norm_gain, hg_lb, hg_norm_gain, even_w_out, odd_w_in,
              ret_decay, odd_w_out):
    n_tok = x.shape[1]
    row, col = grid_positions(n_tok)
    tpos = jnp.arange(n_tok, dtype=jnp.float32)
    p = jax.nn.softmax(hg_lb.astype(jnp.float32), axis=0)
    lower_bounds = jnp.cumsum(p, axis=0) - p[0]
    xc = ctx
    for l in range(DEPTH):
        i = l // 2
        mod_lat = adaln(c, mod_w[l], mod_b[l])
        mod_ctx = adaln(c_ctx, mod_w[l], mod_b[l])
        ctx_out = l < DEPTH - 1
        if l % 2 == 0:
            x, xc = even_layer(x, xc, mod_lat, mod_ctx, norm_gain[l], even_w_in[i], q_a_gain[i],
                               kv_a_gain[i], w_uq[i], w_ukv[i], q_norm_gain[i], k_norm_gain[i],
                               lower_bounds[i], hg_norm_gain[i], even_w_out[i], (row, col), ctx_out)
        else:
            x, xc = odd_layer(x, xc, mod_lat, mod_ctx, norm_gain[l], odd_w_in[i], ret_decay[i],
                              odd_w_out[i], tpos, ctx_out)
    return x
```

```cpp
#include <hip/hip_runtime.h>
#include <cstdio>
#include <cstdint>
namespace pg8 {
#define PG8_LAS __attribute__((address_space(3)))
typedef unsigned short bf16_t;
typedef short bf16x8 __attribute__((ext_vector_type(8)));
typedef float f32x4 __attribute__((ext_vector_type(4)));
typedef unsigned u32x4 __attribute__((ext_vector_type(4)));
constexpr int BM = 256, BK = 64, HALF = 128, HTB = HALF * BK * 2  , STAGE_BYTES = 8 * HTB, NXCD = 8, WGM = 8;

__host__ __device__ __forceinline__ int lds_byte(int r, int c) { const int st = (r >> 4) * 2 + (c >> 5), rr = r & 15, cc = c & 31, ob = rr * 64 + cc * 2; return st * 1024 + (ob ^ (((ob >> 9) & 1) << 5)); }
__host__ __device__ __forceinline__ void stage_rc(int b, int& R, int& C) { const int st = b / 1024, sb = b % 1024, swz = sb ^ (((sb >> 9) & 1) << 5); R = (st >> 1) * 16 + swz / 64; C = (st & 1) * 32 + (swz % 64) / 2; }
__host__ __device__ __forceinline__ int perm32(int rho) { const int n = rho >> 4, i = rho & 15; return 8 * (i >> 2) + 4 * n + (i & 3); }

struct Unit { int pm, pn; };
struct Gemm { const bf16_t* A; const bf16_t* Bt; int M, N, K; };

struct StaticOrder {
    int nM, nN, nwg, G, c;
    __host__ __device__ void init(int M, int N, int G_, int c_) { nM = M / BM; nN = N / BM; nwg = nM * nN; G = G_; c = c_; }
    __host__ __device__ bool next(int i, Unit& u) const {
        const long L = (long)i * G + c; if (L >= nwg) return false;
        int wgid = (int)L; { const int q = nwg / NXCD, r = nwg % NXCD, xcd = wgid % NXCD, off = wgid / NXCD; wgid = (xcd < r ? xcd * (q + 1) : r * (q + 1) + (xcd - r) * q) + off; }
        const int nig = WGM * nN, gid = wgid / nig, fm = gid * WGM, gsz = (nM - fm) < WGM ? (nM - fm) : WGM;
        u.pm = fm + ((wgid % nig) % gsz); u.pn = (wgid % nig) / gsz; return true;
    }
    __device__ __forceinline__ void a_ready(const Unit&) const {}
    __device__ __forceinline__ void done(const Unit&) const {}
};
__device__ __forceinline__ unsigned cvt_pk_bf16(float lo, float hi) { unsigned r; asm volatile("v_cvt_pk_bf16_f32 %0, %1, %2" : "=v"(r) : "v"(lo), "v"(hi)); return r; }
struct EpiBf16 {
    static constexpr bool PERM = true, AFTER_DRAIN = false;
    bf16_t* O; int ldc;
    __device__ __forceinline__ void operator()(const f32x4 (&acc)[2][2][4][2], const Unit& u, int wr, int wc, int fr, int fq) const {
        const int row0 = u.pm * BM + wr * 64 + fr; const int col0 = u.pn * BM + wc * 32 + 8 * fq;
#pragma unroll
        for (int ai = 0; ai < 2; ++ai)
#pragma unroll
            for (int m = 0; m < 4; ++m) { bf16_t* rowp = O + (size_t)(row0 + ai * HALF + m * 16) * ldc + col0;
#pragma unroll
                for (int bj = 0; bj < 2; ++bj) { const f32x4 v0 = acc[ai][bj][m][0], v1 = acc[ai][bj][m][1];
                    u32x4 w; w.x = cvt_pk_bf16(v0[0], v0[1]); w.y = cvt_pk_bf16(v0[2], v0[3]); w.z = cvt_pk_bf16(v1[0], v1[1]); w.w = cvt_pk_bf16(v1[2], v1[3]);
                    *(u32x4*)(rowp + bj * HALF) = w; } }
    }
};
struct EpiRes {
    static constexpr bool PERM = false, AFTER_DRAIN = false;
    const float* res_lat; const float* res_ctx; float* out_lat; float* out_ctx; const float* gate_base;
    __device__ __forceinline__ void operator()(const f32x4 (&acc)[2][2][4][2], const Unit& u, int wr, int wc, int fr, int fq) const {
        const bool isctx = u.pm >= 64; const int seg = isctx ? 4 : (u.pm >> 4);
        const int lrow0 = (isctx ? (u.pm - 64) : u.pm) * BM + wr * 64 + fr, col0 = u.pn * BM + wc * 32 + 4 * fq;
        const float* res = isctx ? res_ctx : res_lat; float* out = isctx ? out_ctx : out_lat; const float* gate = gate_base + (size_t)seg * 12288;
        f32x4 gv[2][2];
#pragma unroll
        for (int bj = 0; bj < 2; ++bj)
#pragma unroll
            for (int n = 0; n < 2; ++n) gv[bj][n] = *(const f32x4*)(gate + col0 + bj * HALF + n * 16);
#pragma unroll
        for (int ai = 0; ai < 2; ++ai)
#pragma unroll
            for (int m = 0; m < 4; ++m) { const size_t off = (size_t)(lrow0 + ai * HALF + m * 16) * 4096 + col0;
#pragma unroll
                for (int bj = 0; bj < 2; ++bj)
#pragma unroll
                    for (int n = 0; n < 2; ++n) { const f32x4 r = *(const f32x4*)(res + off + bj * HALF + n * 16);
                        *(f32x4*)(out + off + bj * HALF + n * 16) = r + gv[bj][n] * acc[ai][bj][m][n]; }
                asm volatile("" ::: "memory"); }
    }
};

template <class Epi, class Sched, bool ALIGN_EPI = false, bool SP2 = false>
__device__ __forceinline__ void gemm_phase(PG8_LAS unsigned char* lds, const Gemm g, const Sched& S, const Epi& E) {
    int tid = threadIdx.x; asm volatile("" : "+v"(tid));
    const int wid = __builtin_amdgcn_readfirstlane(tid >> 6), lane = tid & 63, wr = wid >> 2, wc = wid & 3, fr = lane & 15, fq = lane >> 4;
    const int K = g.K, nt = K / BK;
    unsigned voffA[2], voffB[2];
#pragma unroll
    for (int i = 0; i < 2; ++i) { int R, C; stage_rc(tid * 16 + i * 8192, R, C); const int Rb = Epi::PERM ? ((R & ~31) + perm32(R & 31)) : R;
        voffA[i] = (unsigned)(R * K + C) * 2u; voffB[i] = (unsigned)(Rb * K + C) * 2u; }
    const size_t kstep = (size_t)(BK * 2);
    const size_t hstep = (size_t)HALF * K * 2;
    const size_t tstep = 2 * hstep;
    const unsigned ldsw = (unsigned)wid * 1024u;
    const int aoff = lds_byte(wr * 64 + fr, fq * 8), boff = lds_byte(wc * 32 + fr, fq * 8);
#define PG8_SA(b, h) (((b) * 2 + (h)) * HTB)
#define PG8_SB(b, h) ((4 + (b) * 2 + (h)) * HTB)
#define PG8_STAGE(bufoff, gbase, voff) do { _Pragma("unroll") for (int _i = 0; _i < 2; ++_i) \
        __builtin_amdgcn_global_load_lds((const unsigned*)((const char*)(gbase) + (voff)[_i]), (PG8_LAS unsigned*)(lds + (bufoff) + ldsw + _i * 8192), 16, 0, 0); } while (0)
#define PG8_LDA(dst, b, h) do { _Pragma("unroll") for (int m = 0; m < 4; ++m) _Pragma("unroll") for (int k = 0; k < 2; ++k) dst[m][k] = *(const PG8_LAS bf16x8*)(lds + PG8_SA(b, h) + aoff + m * 2048 + k * 1024); } while (0)
#define PG8_LDB(dst, b, h) do { _Pragma("unroll") for (int n = 0; n < 2; ++n) _Pragma("unroll") for (int k = 0; k < 2; ++k) dst[n][k] = *(const PG8_LAS bf16x8*)(lds + PG8_SB(b, h) + boff + n * 2048 + k * 1024); } while (0)
#define PG8_MMA(ai, bj, At, Bt) do { __builtin_amdgcn_s_setprio(1); _Pragma("unroll") for (int m = 0; m < 4; ++m) _Pragma("unroll") for (int n = 0; n < 2; ++n) _Pragma("unroll") for (int k = 0; k < 2; ++k) \
        acc[ai][bj][m][n] = __builtin_amdgcn_mfma_f32_16x16x32_bf16(Bt[n][k], At[m][k], acc[ai][bj][m][n], 0, 0, 0); __builtin_amdgcn_s_setprio(0); } while (0)
#define PG8_WAIT_V(n) asm volatile("s_waitcnt vmcnt(" #n ")" ::: "memory")
#define PG8_WAIT_L(n) asm volatile("s_waitcnt lgkmcnt(" #n ")" ::: "memory")
#define PG8_BAR __builtin_amdgcn_s_barrier()
#define PG8_SCHED __builtin_amdgcn_sched_barrier(0)
    Unit cur, nxt; int ui = 0;
    if (!S.next(0, cur)) return;
    f32x4 acc[2][2][4][2];
#pragma unroll
    for (int a = 0; a < 2; ++a)
#pragma unroll
        for (int b = 0; b < 2; ++b)
#pragma unroll
            for (int m = 0; m < 4; ++m)
#pragma unroll
                for (int n = 0; n < 2; ++n) acc[a][b][m][n] = (f32x4){0.f, 0.f, 0.f, 0.f};
    bf16x8 At[4][2], B0[2][2], B1[2][2];
    const char* cA = (const char*)g.A + (size_t)cur.pm * tstep; const char* cB = (const char*)g.Bt + (size_t)cur.pn * tstep;
    S.a_ready(cur);
    if constexpr (SP2) {
        PG8_STAGE(PG8_SB(0, 0), cB, voffB); PG8_STAGE(PG8_SB(0, 1), cB + hstep, voffB); PG8_STAGE(PG8_SA(0, 0), cA, voffA); PG8_STAGE(PG8_SA(0, 1), cA + hstep, voffA);
        if (wr == 1) PG8_BAR;
        PG8_WAIT_V(2); PG8_BAR;
        PG8_STAGE(PG8_SB(1, 0), cB + kstep, voffB); PG8_STAGE(PG8_SA(1, 0), cA + kstep, voffA); PG8_STAGE(PG8_SB(1, 1), cB + hstep + kstep, voffB);
        PG8_WAIT_V(6); PG8_BAR;
    } else {
        PG8_STAGE(PG8_SB(0, 0), cB, voffB); PG8_STAGE(PG8_SA(0, 0), cA, voffA); PG8_STAGE(PG8_SB(0, 1), cB + hstep, voffB); PG8_STAGE(PG8_SA(0, 1), cA + hstep, voffA);
        if (wr == 1) PG8_BAR;
        PG8_WAIT_V(4); PG8_BAR;
        PG8_STAGE(PG8_SB(1, 0), cB + kstep, voffB); PG8_STAGE(PG8_SA(1, 0), cA + kstep, voffA); PG8_STAGE(PG8_SB(1, 1), cB + hstep + kstep, voffB);
        PG8_WAIT_V(6); PG8_BAR;
    }
    for (;;) {
        const bool has_next = S.next(ui + 1, nxt);
        const char* nA = has_next ? (const char*)g.A + (size_t)nxt.pm * tstep : cA; const char* nB = has_next ? (const char*)g.Bt + (size_t)nxt.pn * tstep : cB;
        for (int t = 0; t < nt; t += 2) {
            const bool last = (t == nt - 2);
            const char* a1 = cA + (size_t)(t + 1) * kstep;
            const char* a2 = last ? nA : cA + (size_t)(t + 2) * kstep; const char* b2 = last ? nB : cB + (size_t)(t + 2) * kstep;
            const char* a3 = a2 + kstep; const char* b3 = b2 + kstep;
            if (last && has_next) S.a_ready(nxt);
            if constexpr (SP2) {
            PG8_LDB(B0, 0, 0); PG8_LDB(B1, 0, 1); PG8_SCHED; PG8_LDA(At, 0, 0); PG8_STAGE(PG8_SA(1, 1), a1 + hstep, voffA);
            PG8_WAIT_V(8); PG8_WAIT_L(0); PG8_BAR; PG8_MMA(0, 0, At, B0); PG8_MMA(0, 1, At, B1); PG8_BAR; PG8_SCHED;
            PG8_LDA(At, 0, 1); PG8_STAGE(PG8_SB(0, 0), b2, voffB); PG8_STAGE(PG8_SB(0, 1), b2 + hstep, voffB); PG8_STAGE(PG8_SA(0, 0), a2, voffA);
            PG8_WAIT_V(8); PG8_WAIT_L(0); PG8_BAR; PG8_MMA(1, 0, At, B0); PG8_MMA(1, 1, At, B1); PG8_BAR; PG8_SCHED;
            PG8_LDB(B0, 1, 0); PG8_LDB(B1, 1, 1); PG8_SCHED; PG8_LDA(At, 1, 0); PG8_STAGE(PG8_SA(0, 1), a2 + hstep, voffA);
            PG8_WAIT_V(8); PG8_WAIT_L(0); PG8_BAR; PG8_MMA(0, 0, At, B0); PG8_MMA(0, 1, At, B1); PG8_BAR; PG8_SCHED;
            PG8_LDA(At, 1, 1); PG8_STAGE(PG8_SB(1, 0), b3, voffB); PG8_STAGE(PG8_SB(1, 1), b3 + hstep, voffB); PG8_STAGE(PG8_SA(1, 0), a3, voffA);
            PG8_WAIT_V(8); PG8_WAIT_L(0); PG8_BAR; PG8_MMA(1, 0, At, B0); PG8_MMA(1, 1, At, B1); PG8_BAR; PG8_SCHED;
            } else {
            PG8_LDB(B0, 0, 0); PG8_SCHED; PG8_LDA(At, 0, 0); PG8_STAGE(PG8_SA(1, 1), a1 + hstep, voffA);
            PG8_WAIT_L(8); PG8_BAR; PG8_WAIT_L(0); PG8_MMA(0, 0, At, B0); PG8_BAR; PG8_SCHED;
            PG8_LDB(B1, 0, 1); PG8_STAGE(PG8_SB(0, 0), b2, voffB);
            PG8_BAR; PG8_WAIT_L(0); PG8_MMA(0, 1, At, B1); PG8_BAR;
            PG8_LDA(At, 0, 1); PG8_STAGE(PG8_SA(0, 0), a2, voffA);
            PG8_BAR; PG8_WAIT_L(0); PG8_MMA(1, 0, At, B0); PG8_BAR; PG8_SCHED;
            PG8_STAGE(PG8_SB(0, 1), b2 + hstep, voffB);
            PG8_WAIT_V(6); PG8_BAR; PG8_MMA(1, 1, At, B1); PG8_BAR;
            PG8_LDB(B0, 1, 0); PG8_SCHED; PG8_LDA(At, 1, 0); PG8_STAGE(PG8_SA(0, 1), a2 + hstep, voffA);
            PG8_WAIT_L(8); PG8_BAR; PG8_WAIT_L(0); PG8_MMA(0, 0, At, B0); PG8_BAR; PG8_SCHED;
            PG8_LDB(B1, 1, 1); PG8_STAGE(PG8_SB(1, 0), b3, voffB);
            PG8_BAR; PG8_WAIT_L(0); PG8_MMA(0, 1, At, B1); PG8_BAR;
            PG8_LDA(At, 1, 1); PG8_STAGE(PG8_SA(1, 0), a3, voffA);
            PG8_BAR; PG8_WAIT_L(0); PG8_MMA(1, 0, At, B0); PG8_BAR; PG8_SCHED;
            PG8_STAGE(PG8_SB(1, 1), b3 + hstep, voffB);
            PG8_WAIT_V(6); PG8_BAR; PG8_MMA(1, 1, At, B1); PG8_BAR;
            }
        }
        if constexpr (ALIGN_EPI) { if (wr == 0) PG8_BAR; }
        if constexpr (!Epi::AFTER_DRAIN) { E(acc, cur, wr, wc, fr, fq); S.done(cur); }
        if (!has_next) break;
#pragma unroll
        for (int a = 0; a < 2; ++a)
#pragma unroll
            for (int b = 0; b < 2; ++b)
#pragma unroll
                for (int m = 0; m < 4; ++m)
#pragma unroll
                    for (int n = 0; n < 2; ++n) acc[a][b][m][n] = (f32x4){0.f, 0.f, 0.f, 0.f};
        cur = nxt; cA = nA; cB = nB; ++ui;
        if constexpr (ALIGN_EPI) { if (wr == 1) PG8_BAR; }
    }
    PG8_WAIT_V(0);
    if constexpr (!ALIGN_EPI) { if (wr == 0) PG8_BAR; }
    PG8_BAR;
    if constexpr (Epi::AFTER_DRAIN) { E.fused(acc, cur, wr, wc, fr, fq, lds, wid, lane); S.done(cur); }
#undef PG8_SA
#undef PG8_SB
#undef PG8_STAGE
#undef PG8_LDA
#undef PG8_LDB
#undef PG8_MMA
#undef PG8_WAIT_V
#undef PG8_WAIT_L
#undef PG8_BAR
#undef PG8_SCHED
}
}
#ifndef PG8_SP2
#define PG8_SP2 true
#endif
#ifndef PG8_ALIGN
#define PG8_ALIGN true
#endif
constexpr int NWAVES = 8;
constexpr int DM = 4096, NB = 4, SEQ = 4096, CTXL = 256, DEPTH = 4;
constexpr int M_LAT = NB * SEQ, M_CTX = NB * CTXL, MT = M_LAT + M_CTX;
constexpr int HEADS = 16, QKD = 192, NOPE = 128, ROPED = 64, VDIM = 128, Q_LORA = 1536, KV_LORA = 512;
constexpr int E_CQ = 0, E_CKV = 1536, E_KPE = 2048, E_GM = 2112, E_QH = 4160, E_FF = 6208, E_FB = 8256, E_IH = 10304, E_GH = 12352, E_END = 14400, E_PAD = 14592;
constexpr int O_Q = 0, O_K = 4096, O_V = 8192, O_G = 16384, O_END = 24576;
constexpr int NQ = HEADS * QKD, NKV = HEADS * 256;
constexpr float EPS = 1e-6f;
constexpr int MODW = 3 * DM;
constexpr int KCH = 32;
constexpr size_t al256(size_t x) { return (x + 255) / 256 * 256; }
constexpr size_t WS_CTL = 0, CTL_ZERO_BYTES = 1u << 20;
constexpr size_t WS_MODP = CTL_ZERO_BYTES;
constexpr size_t WS_MOD  = WS_MODP + al256((size_t)KCH * 4 * 5 * MODW * 4);
constexpr size_t WS_LB   = WS_MOD + al256((size_t)4 * 5 * MODW * 4);
constexpr size_t WS_WINE = WS_LB + al256((size_t)2 * 2 * 2048 * 4);
constexpr size_t WS_WUQ  = WS_WINE + (size_t)2 * E_PAD * DM * 2;
constexpr size_t WS_WUKV = WS_WUQ + (size_t)2 * NQ * Q_LORA * 2;
constexpr size_t WS_WOE  = WS_WUKV + (size_t)2 * NKV * KV_LORA * 2;
constexpr size_t WS_WINO = WS_WOE + (size_t)2 * DM * DM * 2;
constexpr size_t WS_WOO  = WS_WINO + (size_t)2 * O_END * DM * 2;
constexpr size_t WS_XS   = WS_WOO + (size_t)2 * DM * 8192 * 2;
constexpr size_t WS_H    = WS_XS + (size_t)MT * DM * 4;
constexpr size_t WS_P    = WS_H + (size_t)MT * DM * 2;
constexpr size_t WS_U    = WS_P + (size_t)MT * O_END * 2;
constexpr size_t WS_CQN  = WS_U;
constexpr size_t WS_CKVN = WS_CQN + (size_t)MT * Q_LORA * 2;
constexpr size_t WS_QF   = WS_CKVN + (size_t)MT * KV_LORA * 2;
constexpr size_t WS_KV   = WS_QF + (size_t)MT * NQ * 2;
constexpr size_t WS_KF   = WS_KV + (size_t)MT * NKV * 2;
constexpr size_t WS_OFE  = WS_KF + (size_t)MT * NQ * 2;
constexpr size_t WS_OBE  = WS_OFE + (size_t)MT * 2048 * 2;
constexpr size_t WS_UE_END = WS_OBE + (size_t)MT * 2048 * 2;
constexpr size_t WS_OFO  = WS_U;
constexpr size_t WS_OBO  = WS_OFO + (size_t)MT * 8192 * 2;
constexpr size_t WS_UO_END = WS_OBO + (size_t)MT * 8192 * 2;
constexpr size_t WS_A    = WS_UE_END > WS_UO_END ? WS_UE_END : WS_UO_END;
constexpr size_t WS_END  = WS_A + (size_t)MT * 8192 * 2;
constexpr int CW_BAR = 4096;
constexpr int LDS_BYTES = 163840 - 1024;
constexpr int MISC_OFF = LDS_BYTES - 256;
#define LAS __attribute__((address_space(3)))
typedef unsigned short bf16;
typedef unsigned v4u __attribute__((ext_vector_type(4)));
typedef unsigned v2u __attribute__((ext_vector_type(2)));
typedef float f32x4 __attribute__((ext_vector_type(4)));
typedef float f32x16 __attribute__((ext_vector_type(16)));
typedef short bf16x8 __attribute__((ext_vector_type(8)));
typedef short s16x4 __attribute__((ext_vector_type(4)));
#define DI __device__ __forceinline__
DI unsigned f2bf(float f) { unsigned u = __builtin_bit_cast(unsigned, f); return (u + 0x7fffu + ((u >> 16) & 1u)) >> 16; }
DI unsigned pk2(float lo, float hi) { return f2bf(lo) | (f2bf(hi) << 16); }
DI float bflo(unsigned w) { return __uint_as_float(w << 16); }
DI float bfhi(unsigned w) { return __uint_as_float(w & 0xffff0000u); }
DI float bf2f(bf16 v) { return __uint_as_float(((unsigned)v) << 16); }
DI float bperm(int srclane, float v) { return __int_as_float(__builtin_amdgcn_ds_bpermute(srclane << 2, __float_as_int(v))); }
DI float wave_sum(float v, int lane) {
#pragma unroll
    for (int o = 1; o < 64; o <<= 1) v += bperm(lane ^ o, v);
    return v;
}
DI float siluf(float x) { return x / (1.0f + __expf(-x)); }
#define MFMA16(a, b, c) __builtin_amdgcn_mfma_f32_16x16x32_bf16((a), (b), (c), 0, 0, 0)
#define MFMA32(a, b, c) __builtin_amdgcn_mfma_f32_32x32x16_bf16((a), (b), (c), 0, 0, 0)
DI int crow(int r, int hi) { return (r & 3) + 8 * (r >> 2) + 4 * hi; }
DI unsigned img_off(unsigned row, unsigned ch) { return 256u * row + 16u * (ch ^ (((row & 3u) << 2) | ((row >> 2) & 3u))); }
DI unsigned tr32_addr(unsigned lane, unsigned k0, unsigned c, unsigned t) {
    const unsigned h = lane >> 5, blk = (lane >> 4) & 1u, q = (lane & 15u) >> 2, p = lane & 3u;
    return img_off(k0 + 8 * h + 4 * t + q, 4 * c + 2 * blk + (p >> 1)) + 8 * (p & 1u);
}
DI unsigned tr16_addr(unsigned lane, unsigned k0, unsigned c, unsigned t) {
    const unsigned g = lane >> 4, q = (lane & 15u) >> 2, p = lane & 3u;
    return img_off(k0 + 8 * g + 4 * t + q, 2 * c + (p >> 1)) + 8 * (p & 1u);
}
DI s16x4 tr_issue(unsigned lds_addr) { s16x4 r; asm volatile("ds_read_b64_tr_b16 %0, %1" : "=&v"(r) : "v"(lds_addr) : "memory"); return r; }
#define LDS_WAIT_PIN() do { asm volatile("s_waitcnt lgkmcnt(0)" ::: "memory"); __builtin_amdgcn_sched_barrier(0); } while (0)
#define CAT8(L, H) (bf16x8){L[0], L[1], L[2], L[3], H[0], H[1], H[2], H[3]}
DI unsigned cvtpk(float lo, float hi) { unsigned r; asm volatile("v_cvt_pk_bf16_f32 %0, %1, %2" : "=v"(r) : "v"(lo), "v"(hi)); return r; }

static_assert(WS_END <= (size_t)3221225472ull, "workspace map must fit 4 x the largest tensor (3 GiB)");
#define XB_TMO      128
#define XB_XCNT(j)  (256  + 64 * (j))
#define XB_XSUB(j)  (1280 + 64 * (j))
#define XB_XGEN(j)  (2304 + 64 * (j))
#define XB_TOP      3328
#define XB_TOPGEN   3392
#define XCD_BAR_WORDS 3456
#define XB_SPIN_CAP (1u << 18)

__device__ __forceinline__ unsigned xb_ld(unsigned* p)              { return __hip_atomic_load(p, __ATOMIC_RELAXED, __HIP_MEMORY_SCOPE_AGENT); }
__device__ __forceinline__ unsigned xb_add(unsigned* p, unsigned v) { return __hip_atomic_fetch_add(p, v, __ATOMIC_RELAXED, __HIP_MEMORY_SCOPE_AGENT); }
__device__ __forceinline__ unsigned xb_xcc_id() { return (unsigned)__builtin_amdgcn_s_getreg((3 << 11) | 20) & 0xFu; }
#define XB_SPIN(cond, bar) do { unsigned _sp = 0; while (cond) { __builtin_amdgcn_s_sleep(1); \
    if ((++_sp & 255u) == 0u) { if (xb_ld(&(bar)[XB_TMO])) break; if (_sp > XB_SPIN_CAP) { atomicAdd(&(bar)[XB_TMO], 1u); break; } } } } while (0)

struct XcdBarrier {
    unsigned* bar; unsigned x;
    volatile LAS unsigned* st;
};

__device__ __forceinline__ XcdBarrier xcd_barrier_post(unsigned* bar, volatile LAS unsigned* st) {
    XcdBarrier b; b.bar = bar; b.x = xb_xcc_id(); b.st = st;
    if (threadIdx.x == 0) (void)xb_add(&bar[XB_XCNT(b.x)], 1u);
    return b;
}
__device__ __forceinline__ void xcd_barrier_complete(unsigned* bar, unsigned x, unsigned& nloc, unsigned& nx) {
    const unsigned G = gridDim.x * gridDim.y * gridDim.z;
    unsigned sum, cnt, mine, sp = 0u;
    for (;;) {
        sum = 0u; cnt = 0u; mine = 0u;
#pragma unroll
        for (unsigned j = 0; j < 16; ++j) { const unsigned c = xb_ld(&bar[XB_XCNT(j)]); sum += c; cnt += (c > 0u) ? 1u : 0u; mine = (j == x) ? c : mine; }
        if (sum == G) break;
        __builtin_amdgcn_s_sleep(1);
        if ((++sp & 255u) == 0u) { if (xb_ld(&bar[XB_TMO])) break; if (sp > XB_SPIN_CAP) { atomicAdd(&bar[XB_TMO], 1u); break; } }
    }
    nloc = mine > 0u ? mine : 1u; nx = cnt > 0u ? cnt : 1u;
}

__device__ __forceinline__ void xcd_barrier(const XcdBarrier& b) {
    asm volatile("s_waitcnt vmcnt(0)" ::: "memory");
    __syncthreads();
    if (threadIdx.x == 0) {
        unsigned* bar = b.bar;
        __builtin_amdgcn_s_waitcnt(0);
        unsigned nloc = b.st[0], nx = b.st[1];
        if (nloc == 0u) { xcd_barrier_complete(bar, b.x, nloc, nx); b.st[0] = nloc; b.st[1] = nx; }
        const unsigned old = xb_add(&bar[XB_XSUB(b.x)], 1u);
        const unsigned gen = old / nloc;
        if (old + 1u == (gen + 1u) * nloc) {
            __builtin_amdgcn_fence(__ATOMIC_RELEASE, "agent");
            asm volatile("s_waitcnt vmcnt(0)" ::: "memory");
            const unsigned og = xb_add(&bar[XB_TOP], 1u);
            const unsigned tg = og / nx;
            if (og + 1u == (tg + 1u) * nx) xb_add(&bar[XB_TOPGEN], 1u);
            else XB_SPIN(xb_ld(&bar[XB_TOPGEN]) == tg, bar);
            __builtin_amdgcn_fence(__ATOMIC_ACQUIRE, "agent");
            xb_add(&bar[XB_XGEN(b.x)], 1u);
            asm volatile("s_waitcnt vmcnt(0)" ::: "memory");
        } else {
            XB_SPIN(xb_ld(&bar[XB_XGEN(b.x)]) == gen, bar);
            __builtin_amdgcn_fence(__ATOMIC_ACQUIRE, "agent");
            asm volatile("s_waitcnt vmcnt(0)" ::: "memory");
        }
    }
    __syncthreads();
}
struct Frame {
    LAS unsigned char* lds;
    int tid, lane, wave, vcu, G;
    unsigned char* ws;
    const float *x, *c, *ctx, *c_ctx, *mod_w, *mod_b, *norm_gain, *even_w_in, *q_a_gain, *kv_a_gain, *w_uq, *w_ukv, *q_norm_gain, *k_norm_gain, *hg_lb, *hg_norm_gain, *even_w_out, *odd_w_in, *ret_decay, *odd_w_out;
    float* out;
};
#define WSP(T, off) ((T*)(F.ws + (off)))
DI const float* ld_ptr(const LAS unsigned* tbl, int k) { const unsigned lo = __builtin_amdgcn_readfirstlane(tbl[2 * k]), hi = __builtin_amdgcn_readfirstlane(tbl[2 * k + 1]); return (const float*)(uintptr_t)(((unsigned long long)hi << 32) | lo); }
#define LOADPTRS(F) do { const LAS unsigned* t_ = (const LAS unsigned*)((F).lds + MISC_OFF + 64); \
    (F).x = ld_ptr(t_, 0); (F).c = ld_ptr(t_, 1); (F).ctx = ld_ptr(t_, 2); (F).c_ctx = ld_ptr(t_, 3); (F).mod_w = ld_ptr(t_, 4); (F).mod_b = ld_ptr(t_, 5); (F).norm_gain = ld_ptr(t_, 6); (F).even_w_in = ld_ptr(t_, 7); \
    (F).q_a_gain = ld_ptr(t_, 8); (F).kv_a_gain = ld_ptr(t_, 9); (F).w_uq = ld_ptr(t_, 10); (F).w_ukv = ld_ptr(t_, 11); (F).q_norm_gain = ld_ptr(t_, 12); (F).k_norm_gain = ld_ptr(t_, 13); (F).hg_lb = ld_ptr(t_, 14); \
    (F).hg_norm_gain = ld_ptr(t_, 15); (F).even_w_out = ld_ptr(t_, 16); (F).odd_w_in = ld_ptr(t_, 17); (F).ret_decay = ld_ptr(t_, 18); (F).odd_w_out = ld_ptr(t_, 19); } while (0)

DI void p0_transpose_item(const float* W, int K, int N, bf16* WT, LAS float* scr, int item, int lane) {
    const int nblk = N / 32, kb = item / nblk, nb = item % nblk, k0 = 64 * kb, n0 = 32 * nb;
#pragma unroll 8
    for (int i = 0; i < 32; ++i) { const int kk = 2 * i + (lane >> 5); scr[kk * 33 + (lane & 31)] = W[(size_t)(k0 + kk) * N + n0 + (lane & 31)]; }
    asm volatile("s_waitcnt lgkmcnt(0)" ::: "memory");
    const int c = lane & 7;
#pragma unroll
    for (int j = 0; j < 4; ++j) { const int n = (lane >> 3) + 8 * j; const LAS float* s = scr + (8 * c) * 33 + n;
        v4u o; o.x = pk2(s[0 * 33], s[1 * 33]); o.y = pk2(s[2 * 33], s[3 * 33]); o.z = pk2(s[4 * 33], s[5 * 33]); o.w = pk2(s[6 * 33], s[7 * 33]);
        *(v4u*)(WT + (size_t)(n0 + n) * K + k0 + 8 * c) = o; }
    asm volatile("s_waitcnt lgkmcnt(0)" ::: "memory");
}
DI void ph_prologue(Frame& F) {
    LAS float* scr = (LAS float*)(F.lds + F.wave * 16384);
    const int gw = F.vcu * NWAVES + F.wave, NGW = F.G * NWAVES;
    constexpr int I_WINE = (DM / 64) * (E_END / 32), I_WUQ = (Q_LORA / 64) * (NQ / 32), I_WUKV = (KV_LORA / 64) * (NKV / 32), I_WOE = (DM / 64) * (DM / 32),
                  I_WINO = (DM / 64) * (O_END / 32), I_WOO = (8192 / 64) * (DM / 32);
    constexpr int I_PER = I_WINE + I_WUQ + I_WUKV + I_WOE + I_WINO + I_WOO;
    for (int it = gw; it < 2 * I_PER; it += NGW) {
        const int i = it / I_PER; int r = it % I_PER;
        if (r < I_WINE) { p0_transpose_item(F.even_w_in + (size_t)i * DM * E_END, DM, E_END, WSP(bf16, WS_WINE) + (size_t)i * E_PAD * DM, scr, r, F.lane); continue; } r -= I_WINE;
        if (r < I_WUQ) { p0_transpose_item(F.w_uq + (size_t)i * Q_LORA * NQ, Q_LORA, NQ, WSP(bf16, WS_WUQ) + (size_t)i * NQ * Q_LORA, scr, r, F.lane); continue; } r -= I_WUQ;
        if (r < I_WUKV) { p0_transpose_item(F.w_ukv + (size_t)i * KV_LORA * NKV, KV_LORA, NKV, WSP(bf16, WS_WUKV) + (size_t)i * NKV * KV_LORA, scr, r, F.lane); continue; } r -= I_WUKV;
        if (r < I_WOE) { p0_transpose_item(F.even_w_out + (size_t)i * DM * DM, DM, DM, WSP(bf16, WS_WOE) + (size_t)i * DM * DM, scr, r, F.lane); continue; } r -= I_WOE;
        if (r < I_WINO) { p0_transpose_item(F.odd_w_in + (size_t)i * DM * O_END, DM, O_END, WSP(bf16, WS_WINO) + (size_t)i * O_END * DM, scr, r, F.lane); continue; } r -= I_WINO;
        p0_transpose_item(F.odd_w_out + (size_t)i * 8192 * DM, 8192, DM, WSP(bf16, WS_WOO) + (size_t)i * DM * 8192, scr, r, F.lane);
    }
    { const size_t n16 = (size_t)(E_PAD - E_END) * DM * 2 / 16;
      for (size_t j = (size_t)blockIdx.x * 512 + F.tid; j < 2 * n16; j += (size_t)F.G * 512) { const size_t i = j / n16, o = j % n16;
          *((v4u*)(WSP(bf16, WS_WINE) + (i * E_PAD + E_END) * DM) + o) = (v4u){0u, 0u, 0u, 0u}; } }
    __syncthreads();
    LAS float* tab = (LAS float*)F.lds;
    for (int j = F.tid; j < 5 * DM; j += 512) { const int r = j >> 12, k = j & 4095; const float v = r < 4 ? F.c[r * DM + k] : F.c_ctx[k]; tab[j] = v / (1.0f + __expf(-v)); }
    __syncthreads();
    constexpr int NT = MODW / 256, KC = DM / KCH;
    float* modp = WSP(float, WS_MODP);
    for (int it = gw; it < 4 * NT * KCH; it += NGW) {
        const int kc = it % KCH, nt = (it / KCH) % NT, l = it / (KCH * NT);
        const float* W = F.mod_w + ((size_t)l * DM + (size_t)kc * KC) * MODW + nt * 256 + F.lane * 4;
        f32x4 acc[5];
#pragma unroll
        for (int r = 0; r < 5; ++r) acc[r] = (f32x4){0.f, 0.f, 0.f, 0.f};
#pragma unroll 8
        for (int k = 0; k < KC; ++k) { const f32x4 w = *(const f32x4*)(W + (size_t)k * MODW);
#pragma unroll
            for (int r = 0; r < 5; ++r) { const float s = tab[r * DM + kc * KC + k]; acc[r] += w * s; } }
#pragma unroll
        for (int r = 0; r < 5; ++r) *(f32x4*)(modp + ((size_t)(kc * 4 + l) * 5 + r) * MODW + nt * 256 + F.lane * 4) = acc[r];
    }
}
DI void ph_finalize(Frame& F) {
    const float* modp = WSP(float, WS_MODP); float* mod = WSP(float, WS_MOD);
    for (int j = blockIdx.x * 512 + F.tid; j < 4 * 5 * MODW / 4; j += F.G * 512) {
        const int n4 = j % (MODW / 4), lr = j / (MODW / 4), l = lr / 5;
        f32x4 s = *(const f32x4*)(F.mod_b + (size_t)l * MODW + n4 * 4);
        for (int kc = 0; kc < KCH; ++kc) s += *(const f32x4*)(modp + ((size_t)kc * 20 + lr) * MODW + n4 * 4);
        *(f32x4*)(mod + (size_t)lr * MODW + n4 * 4) = s;
    }
    float* lb = WSP(float, WS_LB);
    for (int j = blockIdx.x * 512 + F.tid; j < 2 * 2048; j += F.G * 512) {
        const float a0 = F.hg_lb[j], a1 = F.hg_lb[2 * 2048 + j], m = fmaxf(a0, a1), e0 = expf(a0 - m), e1 = expf(a1 - m);
        lb[j] = 0.f; lb[2 * 2048 + j] = e1 / (e0 + e1);
    }
}
DI void ph_ada_in(Frame& F, int l, const float* xl, const float* xc) {
    const int gw = F.vcu * NWAVES + F.wave, NGW = F.G * NWAVES;
    const float* gain = F.norm_gain + (size_t)l * DM; bf16* H = WSP(bf16, WS_H);
    for (int row = gw; row < MT; row += NGW) {
        const float* src = row < M_LAT ? xl + (size_t)row * DM : xc + (size_t)(row - M_LAT) * DM;
        const int seg = row < M_LAT ? (row >> 12) : 4;
        const float* md = WSP(float, WS_MOD) + ((size_t)l * 5 + seg) * MODW;
        f32x4 v[16]; float ss = 0.f;
#pragma unroll
        for (int j = 0; j < 16; ++j) { v[j] = *((const f32x4*)src + F.lane + 64 * j); ss += (v[j].x * v[j].x + v[j].y * v[j].y) + (v[j].z * v[j].z + v[j].w * v[j].w); }
        const float rinv = rsqrtf(wave_sum(ss, F.lane) * (1.0f / DM) + EPS);
#pragma unroll
        for (int j = 0; j < 16; ++j) { const int c4 = F.lane + 64 * j;
            const f32x4 g = *((const f32x4*)gain + c4), sh = *((const f32x4*)md + c4), sc = *((const f32x4*)(md + DM) + c4);
            const f32x4 y = v[j] * rinv * g * (sc + 1.0f) + sh;
            v2u o; o.x = pk2(y.x, y.y); o.y = pk2(y.z, y.w); *((v2u*)(H + (size_t)row * DM) + c4) = o; }
    }
}
DI void ph_lora_norm(Frame& F, int i) {
    const int gw = F.vcu * NWAVES + F.wave, NGW = F.G * NWAVES;
    const bf16* P = WSP(bf16, WS_P); bf16* CQN = WSP(bf16, WS_CQN); bf16* CKVN = WSP(bf16, WS_CKVN);
    const float* qg = F.q_a_gain + (size_t)i * Q_LORA; const float* kg = F.kv_a_gain + (size_t)i * KV_LORA;
    for (int row = gw; row < MT; row += NGW) {
        const bf16* pr = P + (size_t)row * E_PAD;
        v4u a[3]; float ss = 0.f;
#pragma unroll
        for (int j = 0; j < 3; ++j) { a[j] = *((const v4u*)(pr + E_CQ) + F.lane + 64 * j);
#pragma unroll
            for (int e = 0; e < 4; ++e) { const float lo = bflo(a[j][e]), hi = bfhi(a[j][e]); ss += lo * lo + hi * hi; } }
        const float rq = rsqrtf(wave_sum(ss, F.lane) * (1.0f / Q_LORA) + EPS);
#pragma unroll
        for (int j = 0; j < 3; ++j) { const int c8 = F.lane + 64 * j; const f32x4 g0 = *((const f32x4*)qg + 2 * c8), g1 = *((const f32x4*)qg + 2 * c8 + 1); v4u o;
            o.x = pk2(bflo(a[j].x) * rq * g0.x, bfhi(a[j].x) * rq * g0.y); o.y = pk2(bflo(a[j].y) * rq * g0.z, bfhi(a[j].y) * rq * g0.w);
            o.z = pk2(bflo(a[j].z) * rq * g1.x, bfhi(a[j].z) * rq * g1.y); o.w = pk2(bflo(a[j].w) * rq * g1.z, bfhi(a[j].w) * rq * g1.w);
            *((v4u*)(CQN + (size_t)row * Q_LORA) + c8) = o; }
        const v4u b = *((const v4u*)(pr + E_CKV) + F.lane); float s2 = 0.f;
#pragma unroll
        for (int e = 0; e < 4; ++e) { const float lo = bflo(b[e]), hi = bfhi(b[e]); s2 += lo * lo + hi * hi; }
        const float rk = rsqrtf(wave_sum(s2, F.lane) * (1.0f / KV_LORA) + EPS);
        { const f32x4 g0 = *((const f32x4*)kg + 2 * F.lane), g1 = *((const f32x4*)kg + 2 * F.lane + 1); v4u o;
          o.x = pk2(bflo(b.x) * rk * g0.x, bfhi(b.x) * rk * g0.y); o.y = pk2(bflo(b.y) * rk * g0.z, bfhi(b.y) * rk * g0.w);
          o.z = pk2(bflo(b.z) * rk * g1.x, bfhi(b.z) * rk * g1.y); o.w = pk2(bflo(b.w) * rk * g1.z, bfhi(b.w) * rk * g1.w);
          *((v4u*)(CKVN + (size_t)row * KV_LORA) + F.lane) = o; }
    }
}
DI void ph_qk_norm_rope(Frame& F, int i) {
    const int gw = F.vcu * NWAVES + F.wave, NGW = F.G * NWAVES;
    bf16* QF = WSP(bf16, WS_QF); const bf16* KV = WSP(bf16, WS_KV); bf16* KF = WSP(bf16, WS_KF); const bf16* P = WSP(bf16, WS_P);
    const float* qg = F.q_norm_gain + (size_t)i * QKD; const float* kg = F.k_norm_gain + (size_t)i * QKD;
    const int h = F.lane >> 2, part = F.lane & 3;
    float inv[8];
#pragma unroll
    for (int j = 0; j < 8; ++j) inv[j] = exp2f(-(float)(8 * (part & 1) + j) * (13.287712379549449f / 16.0f));
    constexpr float QSCL = 0.07216878364870322f * 1.4426950408889634f;
    for (int row = gw; row < MT; row += NGW) {
        const bool lat = row < M_LAT; const int t = row & 4095; const float prow = (float)(t >> 6), pcol = (float)(t & 63);
        float cs[2][8], sn[2][8];
        if (lat) {
#pragma unroll
            for (int j = 0; j < 8; ++j) { sincosf(prow * inv[j], &sn[0][j], &cs[0][j]); sincosf(pcol * inv[j], &sn[1][j], &cs[1][j]); }
        }
#pragma unroll
        for (int which = 0; which < 2; ++which) {
            float v[6][8]; float ss = 0.f;
#pragma unroll
            for (int ii = 0; ii < 6; ++ii) { const int c = part + 4 * ii; v4u w;
                if (which == 0) w = *(const v4u*)(QF + (size_t)row * NQ + h * QKD + 8 * c);
                else if (ii < 4) w = *(const v4u*)(KV + (size_t)row * NKV + h * 256 + 8 * c);
                else w = *(const v4u*)(P + (size_t)row * E_PAD + E_KPE + 8 * (c - 16));
#pragma unroll
                for (int e = 0; e < 4; ++e) { v[ii][2 * e] = bflo(w[e]); v[ii][2 * e + 1] = bfhi(w[e]); ss += v[ii][2 * e] * v[ii][2 * e] + v[ii][2 * e + 1] * v[ii][2 * e + 1]; } }
            ss += bperm(F.lane ^ 1, ss); ss += bperm(F.lane ^ 2, ss);
            const float rn = rsqrtf(ss * (1.0f / QKD) + EPS); const float* gg = which == 0 ? qg : kg;
#pragma unroll
            for (int ii = 0; ii < 6; ++ii) { const int c = part + 4 * ii;
#pragma unroll
                for (int e = 0; e < 8; ++e) v[ii][e] = v[ii][e] * rn * gg[8 * c + e]; }
            if (lat) {
#pragma unroll
                for (int hf = 0; hf < 2; ++hf) {
#pragma unroll
                    for (int e = 0; e < 8; ++e) { const float m = v[4 + hf][e], o = bperm(F.lane ^ 2, m);
                        v[4 + hf][e] = (part < 2) ? (m * cs[hf][e] - o * sn[hf][e]) : (o * sn[hf][e] + m * cs[hf][e]); } }
            }
            const float scl = which == 0 ? QSCL : 1.0f;
#pragma unroll
            for (int ii = 0; ii < 6; ++ii) { const int c = part + 4 * ii; v4u o;
#pragma unroll
                for (int e = 0; e < 4; ++e) o[e] = pk2(v[ii][2 * e] * scl, v[ii][2 * e + 1] * scl);
                if (which == 0) *(v4u*)(QF + (size_t)row * NQ + h * QKD + 8 * c) = o; else *(v4u*)(KF + (size_t)row * NQ + h * QKD + 8 * c) = o; }
        }
    }
}
DI void ph_hg_merge(Frame& F, int i) {
    const int gw = F.vcu * NWAVES + F.wave, NGW = F.G * NWAVES;
    const bf16* OFp = WSP(bf16, WS_OFE); const bf16* OBp = WSP(bf16, WS_OBE); const bf16* P = WSP(bf16, WS_P); bf16* A = WSP(bf16, WS_A);
    const float* hgg = F.hg_norm_gain + (size_t)i * 128; const int h = F.lane >> 2, part = F.lane & 3;
    for (int row = gw; row < MT; row += NGW) {
        const size_t o0 = (size_t)row * 2048 + h * 128 + part * 32; f32x4 v[8]; float ss = 0.f;
#pragma unroll
        for (int j = 0; j < 4; ++j) { const v4u a = *((const v4u*)(OFp + o0) + j), b = *((const v4u*)(OBp + o0) + j);
            v[2 * j] = (f32x4){bflo(a.x) + bflo(b.x), bfhi(a.x) + bfhi(b.x), bflo(a.y) + bflo(b.y), bfhi(a.y) + bfhi(b.y)};
            v[2 * j + 1] = (f32x4){bflo(a.z) + bflo(b.z), bfhi(a.z) + bfhi(b.z), bflo(a.w) + bflo(b.w), bfhi(a.w) + bfhi(b.w)}; }
#pragma unroll
        for (int j = 0; j < 8; ++j) ss += (v[j].x * v[j].x + v[j].y * v[j].y) + (v[j].z * v[j].z + v[j].w * v[j].w);
        ss += bperm(F.lane ^ 1, ss); ss += bperm(F.lane ^ 2, ss);
        const float rn = rsqrtf(ss * (1.0f / 128) + EPS);
        const bf16* gp = P + (size_t)row * E_PAD + E_GH + h * 128 + part * 32; bf16* ap = A + (size_t)row * DM + 2048 + h * 128 + part * 32;
#pragma unroll
        for (int j = 0; j < 4; ++j) { const v4u g = *((const v4u*)gp + j); const f32x4 a = v[2 * j], b = v[2 * j + 1];
            const f32x4 g0 = *((const f32x4*)(hgg + part * 32) + 2 * j), g1 = *((const f32x4*)(hgg + part * 32) + 2 * j + 1); v4u o;
            o.x = pk2(a.x * rn * g0.x * siluf(bflo(g.x)), a.y * rn * g0.y * siluf(bfhi(g.x))); o.y = pk2(a.z * rn * g0.z * siluf(bflo(g.y)), a.w * rn * g0.w * siluf(bfhi(g.y)));
            o.z = pk2(b.x * rn * g1.x * siluf(bflo(g.z)), b.y * rn * g1.y * siluf(bfhi(g.z))); o.w = pk2(b.z * rn * g1.z * siluf(bflo(g.w)), b.w * rn * g1.w * siluf(bfhi(g.w)));
            *((v4u*)ap + j) = o; }
    }
}
DI void ph_ret_rope(Frame& F) {
    const int gw = F.vcu * NWAVES + F.wave, NGW = F.G * NWAVES; bf16* P = WSP(bf16, WS_P);
    const int hsub = F.lane >> 4, i0 = 8 * (F.lane & 15);
    float inv[8];
#pragma unroll
    for (int j = 0; j < 8; ++j) inv[j] = 1.0f / powf(10000.0f, (float)(i0 + j) * (1.0f / 127.0f));
    for (int row = gw; row < MT; row += NGW) {
        const bool lat = row < M_LAT; const float pos = (float)(row & 4095);
        float cs[8], sn[8];
#pragma unroll
        for (int j = 0; j < 8; ++j) { if (lat) sincosf(pos * inv[j], &sn[j], &cs[j]); else { cs[j] = 1.f; sn[j] = 0.f; } }
#pragma unroll
        for (int which = 0; which < 2; ++which) {
            const float scl = which ? 0.0625f : 1.0f;
#pragma unroll
            for (int it = 0; it < 4; ++it) { const int h = 4 * it + hsub; bf16* p1 = P + (size_t)row * O_END + (which ? O_K : O_Q) + h * 256 + i0; bf16* p2 = p1 + 128;
                const v4u a = *(const v4u*)p1, b = *(const v4u*)p2; v4u oa, ob;
#pragma unroll
                for (int e = 0; e < 4; ++e) { const float x1l = bflo(a[e]), x1h = bfhi(a[e]), x2l = bflo(b[e]), x2h = bfhi(b[e]);
                    oa[e] = pk2((x1l * cs[2 * e] - x2l * sn[2 * e]) * scl, (x1h * cs[2 * e + 1] - x2h * sn[2 * e + 1]) * scl);
                    ob[e] = pk2((x1l * sn[2 * e] + x2l * cs[2 * e]) * scl, (x1h * sn[2 * e + 1] + x2h * cs[2 * e + 1]) * scl); }
                *(v4u*)p1 = oa; *(v4u*)p2 = ob; }
        }
    }
}
DI void ph_ret_merge(Frame& F) {
    const int gw = F.vcu * NWAVES + F.wave, NGW = F.G * NWAVES;
    const bf16* OFp = WSP(bf16, WS_OFO); const bf16* OBp = WSP(bf16, WS_OBO); const bf16* P = WSP(bf16, WS_P); bf16* A = WSP(bf16, WS_A);
    for (int row = gw; row < MT; row += NGW) {
#pragma unroll 4
        for (int h = 0; h < 16; ++h) { const size_t o0 = (size_t)row * 8192 + h * 512 + F.lane * 8;
            const v4u fa = *(const v4u*)(OFp + o0), fb = *(const v4u*)(OBp + o0);
            const f32x4 a = (f32x4){bflo(fa.x) + bflo(fb.x), bfhi(fa.x) + bfhi(fb.x), bflo(fa.y) + bflo(fb.y), bfhi(fa.y) + bfhi(fb.y)};
            const f32x4 b = (f32x4){bflo(fa.z) + bflo(fb.z), bfhi(fa.z) + bfhi(fb.z), bflo(fa.w) + bflo(fb.w), bfhi(fa.w) + bfhi(fb.w)};
            const float ss = (a.x * a.x + a.y * a.y) + (a.z * a.z + a.w * a.w) + (b.x * b.x + b.y * b.y) + (b.z * b.z + b.w * b.w);
            const float rn = rsqrtf(wave_sum(ss, F.lane) * (1.0f / 512) + EPS);
            const v4u g = *(const v4u*)(P + (size_t)row * O_END + O_G + h * 512 + F.lane * 8); v4u o;
            o.x = pk2(a.x * rn * siluf(bflo(g.x)), a.y * rn * siluf(bfhi(g.x))); o.y = pk2(a.z * rn * siluf(bflo(g.y)), a.w * rn * siluf(bfhi(g.y)));
            o.z = pk2(b.x * rn * siluf(bflo(g.z)), b.y * rn * siluf(bfhi(g.z))); o.w = pk2(b.z * rn * siluf(bflo(g.w)), b.w * rn * siluf(bfhi(g.w)));
            *(v4u*)(A + (size_t)row * 8192 + h * 512 + F.lane * 8) = o; }
    }
}
namespace att {
constexpr int KP = 400;
constexpr int VB = 64 * 128 * 2, KB = 64 * KP;
constexpr int OFF_V = 0, OFF_K = 2 * VB, OFF_WS = OFF_K + 2 * KB;
constexpr float THR2 = 11.5f;
DI int v_st(int k, int c) { const int kk = (k & ~0xC) | ((k & 4) << 1) | ((k & 8) >> 1); return ((kk >> 3) * 4 + (c >> 5)) * 512 + ((kk & 7) * 32 + (c & 31)) * 2; }
DI int v_rd_base(int lane) { return ((lane & 3) << 3) | (((lane >> 2) & 3) << 6) | (((lane >> 4) & 1) << 5) | (((lane >> 5) & 1) << 8); }
constexpr int v_rd_off(int d0, int ks, int half) { return d0 * 512 + ks * 4096 + half * 2048; }
template <int OFF> DI s16x4 tr_read(int vb) { s16x4 r; asm volatile("ds_read_b64_tr_b16 %0, %1 offset:%2" : "=&v"(r) : "v"(vb), "i"(OFF) : "memory"); return r; }
template <int D0> DI void pv_one(f32x16& od, int vb, bf16x8 pa0, bf16x8 pa1, bf16x8 pa2, bf16x8 pa3) {
    const s16x4 l0 = tr_read<v_rd_off(D0, 0, 0)>(vb), h0 = tr_read<v_rd_off(D0, 0, 1)>(vb), l1 = tr_read<v_rd_off(D0, 1, 0)>(vb), h1 = tr_read<v_rd_off(D0, 1, 1)>(vb);
    const s16x4 l2 = tr_read<v_rd_off(D0, 2, 0)>(vb), h2 = tr_read<v_rd_off(D0, 2, 1)>(vb), l3 = tr_read<v_rd_off(D0, 3, 0)>(vb), h3 = tr_read<v_rd_off(D0, 3, 1)>(vb);
    LDS_WAIT_PIN();
    od = MFMA32(pa0, CAT8(l0, h0), od); od = MFMA32(pa1, CAT8(l1, h1), od); od = MFMA32(pa2, CAT8(l2, h2), od); od = MFMA32(pa3, CAT8(l3, h3), od);
}
DI void unit(Frame& F, int h, int qrow0, int klat0, int nlat, int kctx0, int NT, int ldp) {
    const int tid = F.tid, wid = F.wave, lane = F.lane, r32 = lane & 31, hi = lane >> 5;
    const bf16* QF = WSP(bf16, WS_QF); const bf16* KF = WSP(bf16, WS_KF); const bf16* KV = WSP(bf16, WS_KV); const bf16* P = WSP(bf16, WS_P); bf16* A = WSP(bf16, WS_A);
    LAS unsigned char* Vl = F.lds + OFF_V; LAS unsigned char* Kl = F.lds + OFF_K;
    LAS float* wsl = (LAS float*)(F.lds + OFF_WS) + wid * 64; LAS float* li_l = wsl; LAS float* al_l = wsl + 32;
    float m_reg = -1e30f, l_reg = 0.f; f32x16 o[4];
#pragma unroll
    for (int d = 0; d < 4; ++d)
#pragma unroll
        for (int r = 0; r < 16; ++r) o[d][r] = 0.f;
    bf16x8 qr[12];
    { const bf16* Qw = QF + (size_t)(qrow0 + wid * 32 + r32) * NQ + h * QKD + hi * 8;
#pragma unroll
      for (int d0 = 0; d0 < 12; ++d0) qr[d0] = *(const bf16x8*)(Qw + d0 * 16); }
    int krow[3], kch[3];
#pragma unroll
    for (int i = 0; i < 3; ++i) { const int idx = tid + 512 * i; krow[i] = idx / 24; kch[i] = idx % 24; }
    const int vrow0 = tid >> 4, vc = (tid & 15) * 8;
    v4u sk[3], sv[2];
    const int vb0 = (int)(uintptr_t)Vl + v_rd_base(lane);
#define KEYROW(kt) ((kt) < nlat ? klat0 + 64 * (kt) : kctx0 + 64 * ((kt) - nlat))
#define SLOAD(kt) do { const int kr_ = KEYROW(kt); _Pragma("unroll") for (int i = 0; i < 3; ++i) sk[i] = *(const v4u*)(KF + (size_t)(kr_ + krow[i]) * NQ + h * QKD + kch[i] * 8); \
        _Pragma("unroll") for (int i = 0; i < 2; ++i) sv[i] = *(const v4u*)(KV + (size_t)(kr_ + vrow0 + 32 * i) * NKV + h * 256 + 128 + vc); } while (0)
#define SWRITE(b) do { _Pragma("unroll") for (int i = 0; i < 3; ++i) *(LAS v4u*)(Kl + (b) * KB + krow[i] * KP + kch[i] * 16) = sk[i]; \
        _Pragma("unroll") for (int i = 0; i < 2; ++i) *(LAS v4u*)(Vl + (b) * VB + v_st(vrow0 + 32 * i, vc)) = sv[i]; } while (0)
    SLOAD(0); SWRITE(0);
    if (NT > 1) SLOAD(1);
    __syncthreads();
    for (int j = 0; j < NT; ++j) {
        const int buf = j & 1;
        f32x16 p0, p1;
#pragma unroll
        for (int r = 0; r < 16; ++r) { p0[r] = 0.f; p1[r] = 0.f; }
        { const LAS unsigned char* Ks = Kl + buf * KB;
#pragma unroll
          for (int d0 = 0; d0 < 12; ++d0) { const int cb = (d0 * 16 + hi * 8) * 2;
              const bf16x8 b0 = *(const LAS bf16x8*)(Ks + r32 * KP + cb), b1 = *(const LAS bf16x8*)(Ks + (32 + r32) * KP + cb);
              p0 = MFMA32(b0, qr[d0], p0); p1 = MFMA32(b1, qr[d0], p1); } }
        float pmax = p0[0];
#pragma unroll
        for (int r = 1; r < 16; ++r) pmax = fmaxf(pmax, p0[r]);
#pragma unroll
        for (int r = 0; r < 16; ++r) pmax = fmaxf(pmax, p1[r]);
        { auto rr = __builtin_amdgcn_permlane32_swap(__float_as_uint(pmax), __float_as_uint(pmax), false, false); pmax = fmaxf(__uint_as_float(rr[0]), __uint_as_float(rr[1])); }
        float mn, alpha;
        if (__all(pmax - m_reg <= THR2)) { mn = m_reg; alpha = 1.f; }
        else { mn = fmaxf(m_reg, pmax); alpha = __builtin_amdgcn_exp2f(m_reg - mn); m_reg = mn; }
        float ps = 0.f;
#pragma unroll
        for (int r = 0; r < 16; ++r) { p0[r] = __builtin_amdgcn_exp2f(p0[r] - mn); p1[r] = __builtin_amdgcn_exp2f(p1[r] - mn); ps += p0[r] + p1[r]; }
        { auto rr = __builtin_amdgcn_permlane32_swap(__float_as_uint(ps), __float_as_uint(ps), false, false); ps = __uint_as_float(rr[0]) + __uint_as_float(rr[1]); }
        l_reg = l_reg * alpha + ps;
        bf16x8 pa0, pa1, pa2, pa3;
#define PK4(Pv, BASE, OUT) do { unsigned a0 = cvtpk(Pv[BASE + 0], Pv[BASE + 1]), a1 = cvtpk(Pv[BASE + 2], Pv[BASE + 3]); \
        unsigned b0_ = cvtpk(Pv[BASE + 4], Pv[BASE + 5]), b1_ = cvtpk(Pv[BASE + 6], Pv[BASE + 7]); \
        auto r0 = __builtin_amdgcn_permlane32_swap(a0, b0_, false, false); auto r1 = __builtin_amdgcn_permlane32_swap(a1, b1_, false, false); \
        v4u w = {r0[0], r1[0], r0[1], r1[1]}; OUT = __builtin_bit_cast(bf16x8, w); } while (0)
        PK4(p0, 0, pa0); PK4(p0, 8, pa1); PK4(p1, 0, pa2); PK4(p1, 8, pa3);
#undef PK4
        if (__any(alpha < 1.f)) { if (hi == 0) al_l[r32] = alpha; asm volatile("s_waitcnt lgkmcnt(0)" ::: "memory");
#pragma unroll
            for (int r = 0; r < 16; ++r) { const float a = al_l[crow(r, hi)];
#pragma unroll
                for (int d = 0; d < 4; ++d) o[d][r] *= a; } }
        if (j + 1 < NT) SWRITE(buf ^ 1);
        if (j + 2 < NT) SLOAD(j + 2);
        { const int vb = vb0 + buf * VB;
          pv_one<0>(o[0], vb, pa0, pa1, pa2, pa3); pv_one<1>(o[1], vb, pa0, pa1, pa2, pa3); pv_one<2>(o[2], vb, pa0, pa1, pa2, pa3); pv_one<3>(o[3], vb, pa0, pa1, pa2, pa3); }
        __syncthreads();
    }
#undef SLOAD
#undef SWRITE
#undef KEYROW
    if (hi == 0) li_l[r32] = l_reg; asm volatile("s_waitcnt lgkmcnt(0)" ::: "memory");
#pragma unroll
    for (int r = 0; r < 16; ++r) { const int orow = crow(r, hi); const float rl = __builtin_amdgcn_rcpf(li_l[orow]); const size_t grow = (size_t)(qrow0 + wid * 32 + orow);
#pragma unroll
        for (int d0 = 0; d0 < 4; ++d0) { const int col = h * 128 + d0 * 32 + r32; const float g = bf2f(P[grow * ldp + E_GM + col]);
            A[grow * DM + col] = (bf16)f2bf(o[d0][r] * rl * siluf(g)); } }
    __syncthreads();
}
}
namespace hg {
constexpr int OFF_QP = 0, OFF_KP = 8192, OFF_QS = 16384, OFF_KH = 24576, OFF_V = 32768, OFF_A = 40960, OFF_E = 45056, OFF_SB = 49152, SB_BYTES = 32768;
constexpr int NCH = 8 + 128;
DI int row_of(int b, int dir, int cidx, int i) {
    if (cidx < 8) { const int pos = cidx * 32 + i; return M_LAT + b * CTXL + (dir ? CTXL - 1 - pos : pos); }
    const int pos = (cidx - 8) * 32 + i; return b * SEQ + (dir ? SEQ - 1 - pos : pos);
}
DI void unit(Frame& F, int li, int b, int h, int dir) {
    const int wid = F.wave, lane = F.lane, p = lane & 31, chalf = lane >> 5, ch = 2 * wid + chalf;
    const bf16* P = WSP(bf16, WS_P); bf16* OUT = dir ? WSP(bf16, WS_OBE) : WSP(bf16, WS_OFE);
    LAS unsigned char* L = F.lds;
    float lbv[8];
    { const float* lbp = WSP(float, WS_LB) + ((size_t)li * 2 + dir) * 2048 + h * 128 + ch * 8;
#pragma unroll
      for (int j = 0; j < 8; ++j) lbv[j] = lbp[j]; }
    const int fcol = (dir ? E_FB : E_FF) + h * 128 + ch * 8, qcol = E_QH + h * 128 + ch * 8, vcol = E_IH + h * 128 + ch * 8;
    f32x16 accS[2];
#pragma unroll
    for (int i = 0; i < 2; ++i)
#pragma unroll
        for (int r = 0; r < 16; ++r) accS[i][r] = 0.f;
    for (int j = F.tid; j < SB_BYTES / 16; j += 512) *((LAS v4u*)(L + OFF_SB) + j) = (v4u){0u, 0u, 0u, 0u};
    v4u rq, rf, rv;
    { const size_t ro = (size_t)row_of(b, dir, 0, p) * E_PAD; rq = *(const v4u*)(P + ro + qcol); rf = *(const v4u*)(P + ro + fcol); rv = *(const v4u*)(P + ro + vcol); }
    __syncthreads();
    for (int cidx = 0; cidx < NCH; ++cidx) {
        const int cur = cidx & 1;
        LAS unsigned char* SBc = L + OFF_SB + cur * SB_BYTES; LAS unsigned char* SBn = L + OFF_SB + (cur ^ 1) * SB_BYTES;
        const v4u cq = rq, cf = rf, cv = rv;
        if (cidx + 1 < NCH) { const size_t ro = (size_t)row_of(b, dir, cidx + 1, p) * E_PAD; rq = *(const v4u*)(P + ro + qcol); rf = *(const v4u*)(P + ro + fcol); rv = *(const v4u*)(P + ro + vcol); }
        {
            float bq[8], key[8], bb[8];
#pragma unroll
            for (int e = 0; e < 4; ++e) { bq[2 * e] = bflo(cq[e]); bq[2 * e + 1] = bfhi(cq[e]); }
#pragma unroll
            for (int e = 0; e < 8; ++e) { const float f = (e & 1) ? bfhi(cf[e >> 1]) : bflo(cf[e >> 1]);
                const float sp = 1.0f / (1.0f + __expf(-f)), sn = 1.0f / (1.0f + __expf(f));
                const float g = lbv[e] + (1.0f - lbv[e]) * sp; key[e] = (1.0f - lbv[e]) * sn; bb[e] = fmaxf(__log2f(g), -120.0f); }
#pragma unroll
            for (int d = 1; d < 32; d <<= 1) {
#pragma unroll
                for (int e = 0; e < 8; ++e) { const float y = bperm(lane - d, bb[e]); if (p >= d) bb[e] += y; } }
            v4u oqp, okp, oqs, okh; float qp[8], kp[8], qs[8], kh[8];
#pragma unroll
            for (int e = 0; e < 8; ++e) { const float c = bperm((lane & 32) + 15, bb[e]), bl = bperm((lane & 32) + 31, bb[e]);
                const float e1 = __builtin_amdgcn_exp2f(bb[e] - c), e2 = __builtin_amdgcn_exp2f(c - bb[e]), ec = __builtin_amdgcn_exp2f(c), ebc = __builtin_amdgcn_exp2f(bl - c);
                qp[e] = bq[e] * e1; kp[e] = key[e] * e2; qs[e] = qp[e] * ec; kh[e] = kp[e] * ebc;
                if (p == 31) *(LAS float*)(L + OFF_E + (ch * 8 + e) * 4) = __builtin_amdgcn_exp2f(bl); }
#pragma unroll
            for (int e = 0; e < 4; ++e) { oqp[e] = pk2(qp[2 * e], qp[2 * e + 1]); okp[e] = pk2(kp[2 * e], kp[2 * e + 1]); oqs[e] = pk2(qs[2 * e], qs[2 * e + 1]); okh[e] = pk2(kh[2 * e], kh[2 * e + 1]); }
            const unsigned off = img_off(p, ch);
            *(LAS v4u*)(L + OFF_QP + off) = oqp; *(LAS v4u*)(L + OFF_KP + off) = okp; *(LAS v4u*)(L + OFF_QS + off) = oqs; *(LAS v4u*)(L + OFF_KH + off) = okh; *(LAS v4u*)(L + OFF_V + off) = cv;
        }
        __syncthreads();
        if (wid < 4) { const int mi = wid >> 1, ni = wid & 1; f32x4 acc = {0.f, 0.f, 0.f, 0.f};
#pragma unroll
            for (int ks = 0; ks < 4; ++ks) { const bf16x8 a = *(const LAS bf16x8*)(L + OFF_QP + img_off(mi * 16 + (lane & 15), 4 * ks + (lane >> 4)));
                const bf16x8 bfr = *(const LAS bf16x8*)(L + OFF_KP + img_off(ni * 16 + (lane & 15), 4 * ks + (lane >> 4))); acc = MFMA16(a, bfr, acc); }
#pragma unroll
            for (int r = 0; r < 4; ++r) { const int t = mi * 16 + 4 * (lane >> 4) + r, s = ni * 16 + (lane & 15);
                *(LAS bf16*)(L + OFF_A + t * 80 + s * 2) = (bf16)f2bf(t >= s ? acc[r] : 0.f); } }
        __syncthreads();
        {
            const unsigned vbase = (unsigned)(uintptr_t)(L + OFF_V), kbase = (unsigned)(uintptr_t)(L + OFF_KH);
            const s16x4 v0 = tr_issue(vbase + tr16_addr(lane, 0, wid, 0)), v1 = tr_issue(vbase + tr16_addr(lane, 0, wid, 1));
            const int mk = wid >> 1, nv0 = 2 * (wid & 1);
            s16x4 ka[2][2], vb[2][2][2];
#pragma unroll
            for (int ks = 0; ks < 2; ++ks) { ka[ks][0] = tr_issue(kbase + tr32_addr(lane, 16 * ks, mk, 0)); ka[ks][1] = tr_issue(kbase + tr32_addr(lane, 16 * ks, mk, 1));
#pragma unroll
                for (int nvi = 0; nvi < 2; ++nvi) { vb[nvi][ks][0] = tr_issue(vbase + tr32_addr(lane, 16 * ks, nv0 + nvi, 0)); vb[nvi][ks][1] = tr_issue(vbase + tr32_addr(lane, 16 * ks, nv0 + nvi, 1)); } }
            LDS_WAIT_PIN();
            const bf16x8 vfr = CAT8(v0, v1);
            f32x4 accO[2];
#pragma unroll
            for (int mi = 0; mi < 2; ++mi) { accO[mi] = (f32x4){0.f, 0.f, 0.f, 0.f};
                const bf16x8 afr = *(const LAS bf16x8*)(L + OFF_A + (mi * 16 + (lane & 15)) * 80 + (lane >> 4) * 16);
                accO[mi] = MFMA16(afr, vfr, accO[mi]);
#pragma unroll
                for (int ks = 0; ks < 4; ++ks) { const bf16x8 qf = *(const LAS bf16x8*)(L + OFF_QS + img_off(mi * 16 + (lane & 15), 4 * ks + (lane >> 4)));
                    const bf16x8 sf = *(const LAS bf16x8*)(SBc + img_off(16 * wid + (lane & 15), 4 * ks + (lane >> 4))); accO[mi] = MFMA16(qf, sf, accO[mi]); } }
#pragma unroll
            for (int mi = 0; mi < 2; ++mi)
#pragma unroll
                for (int r = 0; r < 4; ++r) { const int t = mi * 16 + 4 * (lane >> 4) + r;
                    OUT[(size_t)row_of(b, dir, cidx, t) * 2048 + h * 128 + 16 * wid + (lane & 15)] = (bf16)f2bf(accO[mi][r]); }
            const int hi = lane >> 5;
#pragma unroll
            for (int nvi = 0; nvi < 2; ++nvi) {
#pragma unroll
                for (int g = 0; g < 4; ++g) { const f32x4 ev = *(const LAS f32x4*)(L + OFF_E + (32 * mk + 8 * g + 4 * hi) * 4);
#pragma unroll
                    for (int j = 0; j < 4; ++j) accS[nvi][4 * g + j] *= ev[j]; }
#pragma unroll
                for (int ks = 0; ks < 2; ++ks) accS[nvi] = MFMA32(CAT8(ka[ks][0], ka[ks][1]), CAT8(vb[nvi][ks][0], vb[nvi][ks][1]), accS[nvi]);
#pragma unroll
                for (int g = 0; g < 4; ++g) { v2u w; w.x = pk2(accS[nvi][4 * g], accS[nvi][4 * g + 1]); w.y = pk2(accS[nvi][4 * g + 2], accS[nvi][4 * g + 3]);
                    *(LAS v2u*)(SBn + img_off(32 * (nv0 + nvi) + (lane & 31), 4 * mk + g) + 8 * hi) = w; }
            }
        }
        __syncthreads();
    }
}
}
namespace rt {
constexpr int OFF_Q = 0, OFF_K = 32768, OFF_V = 65536, OFF_P = 81920, OFF_SB = 91136;
constexpr int NCH = 4 + 64;
DI int row_of(int b, int dir, int cidx, int i) {
    if (cidx < 4) { const int pos = cidx * 64 + i; return M_LAT + b * CTXL + (dir ? CTXL - 1 - pos : pos); }
    const int pos = (cidx - 4) * 64 + i; return b * SEQ + (dir ? SEQ - 1 - pos : pos);
}
DI void unit(Frame& F, int li, int b, int h, int dir, int vs) {
    const int tid = F.tid, wid = F.wave;
    const bf16* P = WSP(bf16, WS_P); bf16* OUT = dir ? WSP(bf16, WS_OBO) : WSP(bf16, WS_OFO);
    LAS unsigned char* L = F.lds;
    const float dl = F.ret_decay[((size_t)li * 2 + dir) * 16 + h];
    const float l2g = -log1pf(expf(-dl)) * 1.4426950408889634f;
    const float g64 = exp2f(64.0f * l2g);
    f32x16 accS[4];
#pragma unroll
    for (int i = 0; i < 4; ++i)
#pragma unroll
        for (int r = 0; r < 16; ++r) accS[i][r] = 0.f;
    const int qrow = tid >> 5, qc = tid & 31;
    const int vrow = tid >> 4, vc = tid & 15;
    v4u sq[4], sk[4], sv[2];
#define RLOAD(ci) do { _Pragma("unroll") for (int i = 0; i < 4; ++i) { const size_t ro = (size_t)row_of(b, dir, (ci), qrow + 16 * i) * O_END; \
            sq[i] = *(const v4u*)(P + ro + O_Q + h * 256 + qc * 8); sk[i] = *(const v4u*)(P + ro + O_K + h * 256 + qc * 8); } \
        _Pragma("unroll") for (int i = 0; i < 2; ++i) sv[i] = *(const v4u*)(P + (size_t)row_of(b, dir, (ci), vrow + 32 * i) * O_END + O_V + h * 512 + vs * 128 + vc * 8); } while (0)
    RLOAD(0);
    const int nv = wid & 3, mk0 = 4 * (wid >> 2);
    for (int cidx = 0; cidx < NCH; ++cidx) {
        int lane = F.lane; asm volatile("" : "+v"(lane));
        const int r32 = lane & 31, hi = lane >> 5;
#pragma unroll
        for (int i = 0; i < 4; ++i) { const unsigned off = (qc >> 4) * 16384 + img_off(qrow + 16 * i, qc & 15); *(LAS v4u*)(L + OFF_Q + off) = sq[i]; *(LAS v4u*)(L + OFF_K + off) = sk[i]; }
#pragma unroll
        for (int i = 0; i < 2; ++i) { const int s = vrow + 32 * i; const float w = exp2f((float)(63 - s) * l2g); v4u o;
#pragma unroll
            for (int e = 0; e < 4; ++e) o[e] = pk2(bflo(sv[i][e]) * w, bfhi(sv[i][e]) * w);
            *(LAS v4u*)(L + OFF_V + img_off(s, vc)) = o; }
        if (cidx + 1 < NCH) RLOAD(cidx + 1);
        __syncthreads();
        { const int ni = wid & 3;
#pragma unroll
          for (int mm = 0; mm < 2; ++mm) { const int mi = 2 * (wid >> 2) + mm; f32x4 acc = {0.f, 0.f, 0.f, 0.f};
              if (ni <= mi) {
#pragma unroll
                  for (int ks = 0; ks < 8; ++ks) { const unsigned io = (ks >> 2) * 16384; if (ks == 4) asm volatile("" ::: "memory");
                      const bf16x8 a = *(const LAS bf16x8*)(L + OFF_Q + io + img_off(mi * 16 + (lane & 15), 4 * (ks & 3) + (lane >> 4)));
                      const bf16x8 bfr = *(const LAS bf16x8*)(L + OFF_K + io + img_off(ni * 16 + (lane & 15), 4 * (ks & 3) + (lane >> 4))); acc = MFMA16(a, bfr, acc); } }
#pragma unroll
              for (int r = 0; r < 4; ++r) { const int t = mi * 16 + 4 * (lane >> 4) + r, s = ni * 16 + (lane & 15);
                  *(LAS bf16*)(L + OFF_P + t * 144 + s * 2) = (bf16)f2bf(t >= s ? acc[r] : 0.f); } }
#pragma unroll
          for (int i = 0; i < 4; ++i) { const int mk = mk0 + i;
#pragma unroll
              for (int r = 0; r < 16; ++r) accS[i][r] *= g64;
#pragma unroll
              for (int g = 0; g < 4; ++g) { v2u w; w.x = pk2(accS[i][4 * g], accS[i][4 * g + 1]); w.y = pk2(accS[i][4 * g + 2], accS[i][4 * g + 3]);
                  *(LAS v2u*)(L + OFF_SB + (mk >> 2) * 32768 + img_off(32 * nv + r32, 4 * (mk & 3) + g) + 8 * hi) = w; } } }
        __syncthreads();
        {
            const unsigned vbase = (unsigned)(uintptr_t)(L + OFF_V), kbase = (unsigned)(uintptr_t)(L + OFF_K);
            const int mt = wid >> 2;
            s16x4 vf[4][2];
#pragma unroll
            for (int ks = 0; ks < 4; ++ks) { vf[ks][0] = tr_issue(vbase + tr32_addr(lane, 16 * ks, nv, 0)); vf[ks][1] = tr_issue(vbase + tr32_addr(lane, 16 * ks, nv, 1)); }
            LDS_WAIT_PIN();
            f32x16 accO;
#pragma unroll
            for (int r = 0; r < 16; ++r) accO[r] = 0.f;
#pragma unroll
            for (int ks = 0; ks < 4; ++ks) { const bf16x8 pf = *(const LAS bf16x8*)(L + OFF_P + (32 * mt + r32) * 144 + (16 * ks + 8 * hi) * 2); accO = MFMA32(pf, CAT8(vf[ks][0], vf[ks][1]), accO); }
#pragma unroll
            for (int kg = 0; kg < 4; ++kg) {
#pragma unroll
                for (int kk = 0; kk < 4; ++kk) { const int ks = 4 * kg + kk; const unsigned io = (ks >> 3) * 16384, so = (ks >> 3) * 32768;
                    const bf16x8 qf = *(const LAS bf16x8*)(L + OFF_Q + io + img_off(32 * mt + r32, 2 * (ks & 7) + hi));
                    const bf16x8 sf = *(const LAS bf16x8*)(L + OFF_SB + so + img_off(32 * nv + r32, 2 * (ks & 7) + hi)); accO = MFMA32(qf, sf, accO); }
                asm volatile("" ::: "memory"); }
#pragma unroll
            for (int r = 0; r < 16; ++r) { const int t = 32 * mt + crow(r, hi);
                OUT[(size_t)row_of(b, dir, cidx, t) * 8192 + h * 512 + vs * 128 + 32 * nv + r32] = (bf16)f2bf(accO[r] * exp2f((float)(t - 63) * l2g)); }
#pragma unroll
            for (int i = 0; i < 4; ++i) { const int mk = mk0 + i; s16x4 kf[4][2];
#pragma unroll
                for (int ks = 0; ks < 4; ++ks) { kf[ks][0] = tr_issue(kbase + (mk >> 2) * 16384 + tr32_addr(lane, 16 * ks, mk & 3, 0)); kf[ks][1] = tr_issue(kbase + (mk >> 2) * 16384 + tr32_addr(lane, 16 * ks, mk & 3, 1)); }
                LDS_WAIT_PIN();
#pragma unroll
                for (int ks = 0; ks < 4; ++ks) accS[i] = MFMA32(CAT8(kf[ks][0], kf[ks][1]), CAT8(vf[ks][0], vf[ks][1]), accS[i]); }
        }
        __syncthreads();
    }
#undef RLOAD
}
}
#ifndef MK_MULTI
#define MK_MULTI 0
#endif
constexpr int N_PHASES = 2 + 2 * 14;
struct Args { const float* in[20]; float* out; unsigned char* ws; int ph_lo, ph_hi; };
__global__ void __launch_bounds__(NWAVES * 64, 2) fwd_kernel(Args args) {
    extern __shared__ __attribute__((aligned(16))) unsigned char lds_raw[];
    Frame F0;
    F0.lds = (LAS unsigned char*)lds_raw;
    F0.tid = threadIdx.x; F0.lane = F0.tid & 63; F0.wave = __builtin_amdgcn_readfirstlane(F0.tid >> 6);
    F0.G = gridDim.x; { const int bx = blockIdx.x; F0.vcu = (F0.G % 8 == 0) ? (bx % 8) * (F0.G / 8) + bx / 8 : bx; }
    F0.ws = args.ws; F0.out = args.out;
    LAS unsigned* MISC = (LAS unsigned*)(F0.lds + MISC_OFF);
    if (F0.tid < 16) MISC[F0.tid] = 0u;
    if (F0.tid < 20) { const unsigned long long pv = (unsigned long long)(uintptr_t)args.in[F0.tid]; MISC[16 + 2 * F0.tid] = (unsigned)pv; MISC[17 + 2 * F0.tid] = (unsigned)(pv >> 32); }
    __syncthreads();
    unsigned* ctl = (unsigned*)(F0.ws + WS_CTL);
    if (!MK_MULTI) (void)xcd_barrier_post(ctl + CW_BAR, (volatile LAS unsigned*)(MISC + 8));
#define GRID_BAR() do { XcdBarrier b_; b_.bar = (unsigned*)(F0.ws + WS_CTL) + CW_BAR; b_.x = xb_xcc_id(); b_.st = (volatile LAS unsigned*)(F0.lds + MISC_OFF + 32); xcd_barrier(b_); } while (0)
    const int lo = args.ph_lo, hi = args.ph_hi;
    int ph = 0;
#ifndef PHASE_MASK
#define PHASE_MASK 0xFFFFFFFFu
#endif
#define PH_BEGIN(kind) if ((((PHASE_MASK) >> (kind)) & 1u) && lo <= ph && ph < hi) { Frame F = F0; { int t_ = F0.tid; asm volatile("" : "+v"(t_)); F.tid = t_; F.lane = t_ & 63; F.wave = __builtin_amdgcn_readfirstlane(t_ >> 6); } LOADPTRS(F);
#define PH_END   } if (!MK_MULTI && lo <= ph && ph + 1 < hi) GRID_BAR(); ++ph;
#define PH_END_NOBAR }

    PH_BEGIN(0) ph_prologue(F); PH_END
    PH_BEGIN(1) ph_finalize(F); PH_END
    float* XS = (float*)(F0.ws + WS_XS);
    for (int L2 = 0; L2 < 2; ++L2) {
        { const int l = 2 * L2, i = L2;
          const bool first = (L2 == 0);
          PH_BEGIN(2) ph_ada_in(F, l, first ? F.x : XS, first ? F.ctx : XS + (size_t)M_LAT * DM); PH_END
          PH_BEGIN(3) { pg8::Gemm g{WSP(pg8::bf16_t, WS_H), WSP(pg8::bf16_t, WS_WINE) + (size_t)i * E_PAD * DM, MT, E_PAD, DM}; pg8::StaticOrder S; S.init(MT, E_PAD, F.G, (int)blockIdx.x);
                     pg8::EpiBf16 E{WSP(pg8::bf16_t, WS_P), E_PAD}; pg8::gemm_phase<pg8::EpiBf16, pg8::StaticOrder, PG8_ALIGN, PG8_SP2>(F.lds, g, S, E); } PH_END
          PH_BEGIN(4) ph_lora_norm(F, i); PH_END
          PH_BEGIN(5) { { pg8::Gemm g{WSP(pg8::bf16_t, WS_CQN), WSP(pg8::bf16_t, WS_WUQ) + (size_t)i * NQ * Q_LORA, MT, NQ, Q_LORA}; pg8::StaticOrder S; S.init(MT, NQ, F.G, (int)blockIdx.x);
                       pg8::EpiBf16 E{WSP(pg8::bf16_t, WS_QF), NQ}; pg8::gemm_phase<pg8::EpiBf16, pg8::StaticOrder, PG8_ALIGN, PG8_SP2>(F.lds, g, S, E); } __syncthreads(); } PH_END_NOBAR
          PH_BEGIN(16) { { pg8::Gemm g{WSP(pg8::bf16_t, WS_CKVN), WSP(pg8::bf16_t, WS_WUKV) + (size_t)i * NKV * KV_LORA, MT, NKV, KV_LORA}; pg8::StaticOrder S; S.init(MT, NKV, F.G, (int)blockIdx.x);
                       pg8::EpiBf16 E{WSP(pg8::bf16_t, WS_KV), NKV}; pg8::gemm_phase<pg8::EpiBf16, pg8::StaticOrder, PG8_ALIGN, PG8_SP2>(F.lds, g, S, E); } } PH_END
          PH_BEGIN(6) ph_qk_norm_rope(F, i); PH_END
          PH_BEGIN(17) { for (int s = 0; s < 128; ++s) if ((64 + s) % F.G == F.vcu) { hg::unit(F, i, s >> 5, (s >> 1) & 15, s & 1); __syncthreads(); } } PH_END_NOBAR
          PH_BEGIN(7) {
#ifndef NO_ATT
              for (int u = F.vcu; u < 1088; u += F.G) {
                  if (u < 1024) { const int b = u >> 8, h = (u >> 4) & 15, qb = u & 15; att::unit(F, h, b * SEQ + qb * 256, b * SEQ, 64, M_LAT + b * CTXL, 68, E_PAD); }
                  else { const int v = u - 1024, b = v >> 4, h = v & 15; att::unit(F, h, M_LAT + b * CTXL, 0, 0, M_LAT + b * CTXL, 4, E_PAD); } }
#endif
              } PH_END
          PH_BEGIN(8) ph_hg_merge(F, i); PH_END
          PH_BEGIN(9) { pg8::Gemm g{WSP(pg8::bf16_t, WS_A), WSP(pg8::bf16_t, WS_WOE) + (size_t)i * DM * DM, MT, DM, DM}; pg8::StaticOrder S; S.init(MT, DM, F.G, (int)blockIdx.x);
                     pg8::EpiRes E{first ? F.x : XS, first ? F.ctx : XS + (size_t)M_LAT * DM, XS, XS + (size_t)M_LAT * DM, WSP(float, WS_MOD) + (size_t)l * 5 * MODW + 2 * DM};
                     pg8::gemm_phase<pg8::EpiRes, pg8::StaticOrder, PG8_ALIGN, PG8_SP2>(F.lds, g, S, E); } PH_END
        }
        { const int l = 2 * L2 + 1, i = L2; const bool last = (L2 == 1);
          PH_BEGIN(10) ph_ada_in(F, l, XS, XS + (size_t)M_LAT * DM); PH_END
          PH_BEGIN(11) { pg8::Gemm g{WSP(pg8::bf16_t, WS_H), WSP(pg8::bf16_t, WS_WINO) + (size_t)i * O_END * DM, MT, O_END, DM}; pg8::StaticOrder S; S.init(MT, O_END, F.G, (int)blockIdx.x);
                     pg8::EpiBf16 E{WSP(pg8::bf16_t, WS_P), O_END}; pg8::gemm_phase<pg8::EpiBf16, pg8::StaticOrder, PG8_ALIGN, PG8_SP2>(F.lds, g, S, E); } PH_END
          PH_BEGIN(12) ph_ret_rope(F); PH_END
          PH_BEGIN(13) { for (int u = F.vcu; u < 512; u += F.G) { rt::unit(F, i, u >> 7, (u >> 3) & 15, (u >> 2) & 1, u & 3); __syncthreads(); } } PH_END
          PH_BEGIN(14) ph_ret_merge(F); PH_END
          PH_BEGIN(15) { const int M = last ? M_LAT : MT; pg8::Gemm g{WSP(pg8::bf16_t, WS_A), WSP(pg8::bf16_t, WS_WOO) + (size_t)i * DM * 8192, M, DM, 8192}; pg8::StaticOrder S; S.init(M, DM, F.G, (int)blockIdx.x);
                     pg8::EpiRes E{XS, XS + (size_t)M_LAT * DM, last ? F.out : XS, XS + (size_t)M_LAT * DM, WSP(float, WS_MOD) + (size_t)l * 5 * MODW + 2 * DM};
                     pg8::gemm_phase<pg8::EpiRes, pg8::StaticOrder, PG8_ALIGN, PG8_SP2>(F.lds, g, S, E); } PH_END
        }
    }
#undef PH_BEGIN
#undef PH_END
}

extern "C" void kernel_launch(void* const* d_in, const int* in_sizes, int n_in, void* d_out, int out_size, void* d_ws, size_t ws_size, hipStream_t stream) {
    static int grid = 0;
    if (grid == 0) {
        if (n_in != 20 || in_sizes[0] != M_LAT * DM || out_size != M_LAT * DM || ws_size < WS_END) {
            fprintf(stderr, "kernel_launch: shape mismatch (n_in %d, in0 %d, out %d, ws %zu need %zu); nothing launched\n", n_in, n_in > 0 ? in_sizes[0] : -1, out_size, ws_size, (size_t)WS_END); grid = -1; return; }
        int dev = 0, cus = 0, per_cu = 0;
        if (hipGetDevice(&dev) != hipSuccess || hipDeviceGetAttribute(&cus, hipDeviceAttributeMultiprocessorCount, dev) != hipSuccess) { grid = -1; return; }
        if (hipFuncSetAttribute((const void*)fwd_kernel, hipFuncAttributeMaxDynamicSharedMemorySize, LDS_BYTES) != hipSuccess) { fprintf(stderr, "kernel_launch: hipFuncSetAttribute failed\n"); grid = -1; return; }
        if (hipOccupancyMaxActiveBlocksPerMultiprocessor(&per_cu, (const void*)fwd_kernel, NWAVES * 64, LDS_BYTES) != hipSuccess || per_cu < 1) { fprintf(stderr, "kernel_launch: occupancy query says %d\n", per_cu); }
        (void)hipGetLastError();
        grid = cus;
    }
    if (grid < 0) return;
    if (hipMemsetAsync((char*)d_ws + WS_CTL, 0, CTL_ZERO_BYTES, stream) != hipSuccess) return;
    Args a{};
    for (int i = 0; i < 20; ++i) a.in[i] = (const float*)d_in[i];
    a.out = (float*)d_out; a.ws = (unsigned char*)d_ws;
#if MK_MULTI
#ifndef DBG_HI
#define DBG_HI N_PHASES
#endif
#ifndef DBG_LO
#define DBG_LO 0
#endif
    for (int p = DBG_LO; p < DBG_HI; ++p) { a.ph_lo = p; a.ph_hi = p + 1; hipLaunchKernelGGL(fwd_kernel, dim3(grid), dim3(NWAVES * 64), LDS_BYTES, stream, a); }
#else
    a.ph_lo = 0; a.ph_hi = N_PHASES; hipLaunchKernelGGL(fwd_kernel, dim3(grid), dim3(NWAVES * 64), LDS_BYTES, stream, a);
#endif
    const hipError_t le = hipPeekAtLastError();
    if (le != hipSuccess) fprintf(stderr, "kernel_launch: launch failed: %s\n", hipGetErrorName(le));
}
```

```cpp
#include <hip/hip_runtime.h>
#include <cstdio>
#include <cstdint>
namespace pg8 {
#define PG8_LAS __attribute__((address_space(3)))
typedef unsigned short bf16_t;
typedef short bf16x8 __attribute__((ext_vector_type(8)));
typedef float f32x4 __attribute__((ext_vector_type(4)));
typedef unsigned u32x4 __attribute__((ext_vector_type(4)));
constexpr int BM = 256, BK = 64, HALF = 128, HTB = HALF * BK * 2  , STAGE_BYTES = 8 * HTB, NXCD = 8, WGM = 8;

__host__ __device__ __forceinline__ int lds_byte(int r, int c) { const int st = (r >> 4) * 2 + (c >> 5), rr = r & 15, cc = c & 31, ob = rr * 64 + cc * 2; return st * 1024 + (ob ^ (((ob >> 9) & 1) << 5)); }
__host__ __device__ __forceinline__ void stage_rc(int b, int& R, int& C) { const int st = b / 1024, sb = b % 1024, swz = sb ^ (((sb >> 9) & 1) << 5); R = (st >> 1) * 16 + swz / 64; C = (st & 1) * 32 + (swz % 64) / 2; }
__host__ __device__ __forceinline__ int perm32(int rho) { const int n = rho >> 4, i = rho & 15; return 8 * (i >> 2) + 4 * n + (i & 3); }

struct Unit { int pm, pn; };
struct Gemm { const bf16_t* A; const bf16_t* Bt; int M, N, K; };

struct StaticOrder {
    int nM, nN, nwg, G, c;
    __host__ __device__ void init(int M, int N, int G_, int c_) { nM = M / BM; nN = N / BM; nwg = nM * nN; G = G_; c = c_; }
    __host__ __device__ bool next(int i, Unit& u) const {
        const long L = (long)i * G + c; if (L >= nwg) return false;
        int wgid = (int)L; { const int q = nwg / NXCD, r = nwg % NXCD, xcd = wgid % NXCD, off = wgid / NXCD; wgid = (xcd < r ? xcd * (q + 1) : r * (q + 1) + (xcd - r) * q) + off; }
        const int nig = WGM * nN, gid = wgid / nig, fm = gid * WGM, gsz = (nM - fm) < WGM ? (nM - fm) : WGM;
        u.pm = fm + ((wgid % nig) % gsz); u.pn = (wgid % nig) / gsz; return true;
    }
    __device__ __forceinline__ void a_ready(const Unit&) const {}
    __device__ __forceinline__ void done(const Unit&) const {}
};
__device__ __forceinline__ unsigned cvt_pk_bf16(float lo, float hi) { unsigned r; asm volatile("v_cvt_pk_bf16_f32 %0, %1, %2" : "=v"(r) : "v"(lo), "v"(hi)); return r; }
struct EpiBf16 {
    static constexpr bool PERM = true, AFTER_DRAIN = false;
    bf16_t* O; int ldc;
    __device__ __forceinline__ void operator()(const f32x4 (&acc)[2][2][4][2], const Unit& u, int wr, int wc, int fr, int fq) const {
        const int row0 = u.pm * BM + wr * 64 + fr; const int col0 = u.pn * BM + wc * 32 + 8 * fq;
#pragma unroll
        for (int ai = 0; ai < 2; ++ai)
#pragma unroll
            for (int m = 0; m < 4; ++m) { bf16_t* rowp = O + (size_t)(row0 + ai * HALF + m * 16) * ldc + col0;
#pragma unroll
                for (int bj = 0; bj < 2; ++bj) { const f32x4 v0 = acc[ai][bj][m][0], v1 = acc[ai][bj][m][1];
                    u32x4 w; w.x = cvt_pk_bf16(v0[0], v0[1]); w.y = cvt_pk_bf16(v0[2], v0[3]); w.z = cvt_pk_bf16(v1[0], v1[1]); w.w = cvt_pk_bf16(v1[2], v1[3]);
                    *(u32x4*)(rowp + bj * HALF) = w; } }
    }
};
struct EpiRes {
    static constexpr bool PERM = false, AFTER_DRAIN = false;
    const float* res_lat; const float* res_ctx; float* out_lat; float* out_ctx; const float* gate_base;
    __device__ __forceinline__ void operator()(const f32x4 (&acc)[2][2][4][2], const Unit& u, int wr, int wc, int fr, int fq) const {
        const bool isctx = u.pm >= 64; const int seg = isctx ? 4 : (u.pm >> 4);
        const int lrow0 = (isctx ? (u.pm - 64) : u.pm) * BM + wr * 64 + fr, col0 = u.pn * BM + wc * 32 + 4 * fq;
        const float* res = isctx ? res_ctx : res_lat; float* out = isctx ? out_ctx : out_lat; const float* gate = gate_base + (size_t)seg * 12288;
        f32x4 gv[2][2];
#pragma unroll
        for (int bj = 0; bj < 2; ++bj)
#pragma unroll
            for (int n = 0; n < 2; ++n) gv[bj][n] = *(const f32x4*)(gate + col0 + bj * HALF + n * 16);
#pragma unroll
        for (int ai = 0; ai < 2; ++ai)
#pragma unroll
            for (int m = 0; m < 4; ++m) { const size_t off = (size_t)(lrow0 + ai * HALF + m * 16) * 4096 + col0;
#pragma unroll
                for (int bj = 0; bj < 2; ++bj)
#pragma unroll
                    for (int n = 0; n < 2; ++n) { const f32x4 r = *(const f32x4*)(res + off + bj * HALF + n * 16);
                        *(f32x4*)(out + off + bj * HALF + n * 16) = r + gv[bj][n] * acc[ai][bj][m][n]; }
                asm volatile("" ::: "memory"); }
    }
};

template <class Epi, class Sched, bool ALIGN_EPI = false, bool SP2 = false>
__device__ __forceinline__ void gemm_phase(PG8_LAS unsigned char* lds, const Gemm g, const Sched& S, const Epi& E) {
    int tid = threadIdx.x; asm volatile("" : "+v"(tid));
    const int wid = __builtin_amdgcn_readfirstlane(tid >> 6), lane = tid & 63, wr = wid >> 2, wc = wid & 3, fr = lane & 15, fq = lane >> 4;
    const int K = g.K, nt = K / BK;
    unsigned voffA[2], voffB[2];
#pragma unroll
    for (int i = 0; i < 2; ++i) { int R, C; stage_rc(tid * 16 + i * 8192, R, C); const int Rb = Epi::PERM ? ((R & ~31) + perm32(R & 31)) : R;
        voffA[i] = (unsigned)(R * K + C) * 2u; voffB[i] = (unsigned)(Rb * K + C) * 2u; }
    const size_t kstep = (size_t)(BK * 2);
    const size_t hstep = (size_t)HALF * K * 2;
    const size_t tstep = 2 * hstep;
    const unsigned ldsw = (unsigned)wid * 1024u;
    const int aoff = lds_byte(wr * 64 + fr, fq * 8), boff = lds_byte(wc * 32 + fr, fq * 8);
#define PG8_SA(b, h) (((b) * 2 + (h)) * HTB)
#define PG8_SB(b, h) ((4 + (b) * 2 + (h)) * HTB)
#define PG8_STAGE(bufoff, gbase, voff) do { _Pragma("unroll") for (int _i = 0; _i < 2; ++_i) \
        __builtin_amdgcn_global_load_lds((const unsigned*)((const char*)(gbase) + (voff)[_i]), (PG8_LAS unsigned*)(lds + (bufoff) + ldsw + _i * 8192), 16, 0, 0); } while (0)
#define PG8_LDA(dst, b, h) do { _Pragma("unroll") for (int m = 0; m < 4; ++m) _Pragma("unroll") for (int k = 0; k < 2; ++k) dst[m][k] = *(const PG8_LAS bf16x8*)(lds + PG8_SA(b, h) + aoff + m * 2048 + k * 1024); } while (0)
#define PG8_LDB(dst, b, h) do { _Pragma("unroll") for (int n = 0; n < 2; ++n) _Pragma("unroll") for (int k = 0; k < 2; ++k) dst[n][k] = *(const PG8_LAS bf16x8*)(lds + PG8_SB(b, h) + boff + n * 2048 + k * 1024); } while (0)
#define PG8_MMA(ai, bj, At, Bt) do { __builtin_amdgcn_s_setprio(1); _Pragma("unroll") for (int m = 0; m < 4; ++m) _Pragma("unroll") for (int n = 0; n < 2; ++n) _Pragma("unroll") for (int k = 0; k < 2; ++k) \
        acc[ai][bj][m][n] = __builtin_amdgcn_mfma_f32_16x16x32_bf16(Bt[n][k], At[m][k], acc[ai][bj][m][n], 0, 0, 0); __builtin_amdgcn_s_setprio(0); } while (0)
#define PG8_WAIT_V(n) asm volatile("s_waitcnt vmcnt(" #n ")" ::: "memory")
#define PG8_WAIT_L(n) asm volatile("s_waitcnt lgkmcnt(" #n ")" ::: "memory")
#define PG8_BAR __builtin_amdgcn_s_barrier()
#define PG8_SCHED __builtin_amdgcn_sched_barrier(0)
    Unit cur, nxt; int ui = 0;
    if (!S.next(0, cur)) return;
    f32x4 acc[2][2][4][2];
#pragma unroll
    for (int a = 0; a < 2; ++a)
#pragma unroll
        for (int b = 0; b < 2; ++b)
#pragma unroll
            for (int m = 0; m < 4; ++m)
#pragma unroll
                for (int n = 0; n < 2; ++n) acc[a][b][m][n] = (f32x4){0.f, 0.f, 0.f, 0.f};
    bf16x8 At[4][2], B0[2][2], B1[2][2];
    const char* cA = (const char*)g.A + (size_t)cur.pm * tstep; const char* cB = (const char*)g.Bt + (size_t)cur.pn * tstep;
    S.a_ready(cur);
    if constexpr (SP2) {
        PG8_STAGE(PG8_SB(0, 0), cB, voffB); PG8_STAGE(PG8_SB(0, 1), cB + hstep, voffB); PG8_STAGE(PG8_SA(0, 0), cA, voffA); PG8_STAGE(PG8_SA(0, 1), cA + hstep, voffA);
        if (wr == 1) PG8_BAR;
        PG8_WAIT_V(2); PG8_BAR;
        PG8_STAGE(PG8_SB(1, 0), cB + kstep, voffB); PG8_STAGE(PG8_SA(1, 0), cA + kstep, voffA); PG8_STAGE(PG8_SB(1, 1), cB + hstep + kstep, voffB);
        PG8_WAIT_V(6); PG8_BAR;
    } else {
        PG8_STAGE(PG8_SB(0, 0), cB, voffB); PG8_STAGE(PG8_SA(0, 0), cA, voffA); PG8_STAGE(PG8_SB(0, 1), cB + hstep, voffB); PG8_STAGE(PG8_SA(0, 1), cA + hstep, voffA);
        if (wr == 1) PG8_BAR;
        PG8_WAIT_V(4); PG8_BAR;
        PG8_STAGE(PG8_SB(1, 0), cB + kstep, voffB); PG8_STAGE(PG8_SA(1, 0), cA + kstep, voffA); PG8_STAGE(PG8_SB(1, 1), cB + hstep + kstep, voffB);
        PG8_WAIT_V(6); PG8_BAR;
    }
    for (;;) {
        const bool has_next = S.next(ui + 1, nxt);
        const char* nA = has_next ? (const char*)g.A + (size_t)nxt.pm * tstep : cA; const char* nB = has_next ? (const char*)g.Bt + (size_t)nxt.pn * tstep : cB;
        for (int t = 0; t < nt; t += 2) {
            const bool last = (t == nt - 2);
            const char* a1 = cA + (size_t)(t + 1) * kstep;
            const char* a2 = last ? nA : cA + (size_t)(t + 2) * kstep; const char* b2 = last ? nB : cB + (size_t)(t + 2) * kstep;
            const char* a3 = a2 + kstep; const char* b3 = b2 + kstep;
            if (last && has_next) S.a_ready(nxt);
            if constexpr (SP2) {
            PG8_LDB(B0, 0, 0); PG8_LDB(B1, 0, 1); PG8_SCHED; PG8_LDA(At, 0, 0); PG8_STAGE(PG8_SA(1, 1), a1 + hstep, voffA);
            PG8_WAIT_V(8); PG8_WAIT_L(0); PG8_BAR; PG8_MMA(0, 0, At, B0); PG8_MMA(0, 1, At, B1); PG8_BAR; PG8_SCHED;
            PG8_LDA(At, 0, 1); PG8_STAGE(PG8_SB(0, 0), b2, voffB); PG8_STAGE(PG8_SB(0, 1), b2 + hstep, voffB); PG8_STAGE(PG8_SA(0, 0), a2, voffA);
            PG8_WAIT_V(8); PG8_WAIT_L(0); PG8_BAR; PG8_MMA(1, 0, At, B0); PG8_MMA(1, 1, At, B1); PG8_BAR; PG8_SCHED;
            PG8_LDB(B0, 1, 0); PG8_LDB(B1, 1, 1); PG8_SCHED; PG8_LDA(At, 1, 0); PG8_STAGE(PG8_SA(0, 1), a2 + hstep, voffA);
            PG8_WAIT_V(8); PG8_WAIT_L(0); PG8_BAR; PG8_MMA(0, 0, At, B0); PG8_MMA(0, 1, At, B1); PG8_BAR; PG8_SCHED;
            PG8_LDA(At, 1, 1); PG8_STAGE(PG8_SB(1, 0), b3, voffB); PG8_STAGE(PG8_SB(1, 1), b3 + hstep, voffB); PG8_STAGE(PG8_SA(1, 0), a3, voffA);
            PG8_WAIT_V(8); PG8_WAIT_L(0); PG8_BAR; PG8_MMA(1, 0, At, B0); PG8_MMA(1, 1, At, B1); PG8_BAR; PG8_SCHED;
            } else {
            PG8_LDB(B0, 0, 0); PG8_SCHED; PG8_LDA(At, 0, 0); PG8_STAGE(PG8_SA(1, 1), a1 + hstep, voffA);
            PG8_WAIT_L(8); PG8_BAR; PG8_WAIT_L(0); PG8_MMA(0, 0, At, B0); PG8_BAR; PG8_SCHED;
            PG8_LDB(B1, 0, 1); PG8_STAGE(PG8_SB(0, 0), b2, voffB);
            PG8_BAR; PG8_WAIT_L(0); PG8_MMA(0, 1, At, B1); PG8_BAR;
            PG8_LDA(At, 0, 1); PG8_STAGE(PG8_SA(0, 0), a2, voffA);
            PG8_BAR; PG8_WAIT_L(0); PG8_MMA(1, 0, At, B0); PG8_BAR; PG8_SCHED;
            PG8_STAGE(PG8_SB(0, 1), b2 + hstep, voffB);
            PG8_WAIT_V(6); PG8_BAR; PG8_MMA(1, 1, At, B1); PG8_BAR;
            PG8_LDB(B0, 1, 0); PG8_SCHED; PG8_LDA(At, 1, 0); PG8_STAGE(PG8_SA(0, 1), a2 + hstep, voffA);
            PG8_WAIT_L(8); PG8_BAR; PG8_WAIT_L(0); PG8_MMA(0, 0, At, B0); PG8_BAR; PG8_SCHED;
            PG8_LDB(B1, 1, 1); PG8_STAGE(PG8_SB(1, 0), b3, voffB);
            PG8_BAR; PG8_WAIT_L(0); PG8_MMA(0, 1, At, B1); PG8_BAR;
            PG8_LDA(At, 1, 1); PG8_STAGE(PG8_SA(1, 0), a3, voffA);
            PG8_BAR; PG8_WAIT_L(0); PG8_MMA(1, 0, At, B0); PG8_BAR; PG8_SCHED;
            PG8_STAGE(PG8_SB(1, 1), b3 + hstep, voffB);
            PG8_WAIT_V(6); PG8_BAR; PG8_MMA(1, 1, At, B1); PG8_BAR;
            }
        }
        if constexpr (ALIGN_EPI) { if (wr == 0) PG8_BAR; }
        if constexpr (!Epi::AFTER_DRAIN) { E(acc, cur, wr, wc, fr, fq); S.done(cur); }
        if (!has_next) break;
#pragma unroll
        for (int a = 0; a < 2; ++a)
#pragma unroll
            for (int b = 0; b < 2; ++b)
#pragma unroll
                for (int m = 0; m < 4; ++m)
#pragma unroll
                    for (int n = 0; n < 2; ++n) acc[a][b][m][n] = (f32x4){0.f, 0.f, 0.f, 0.f};
        cur = nxt; cA = nA; cB = nB; ++ui;
        if constexpr (ALIGN_EPI) { if (wr == 1) PG8_BAR; }
    }
    PG8_WAIT_V(0);
    if constexpr (!ALIGN_EPI) { if (wr == 0) PG8_BAR; }
    PG8_BAR;
    if constexpr (Epi::AFTER_DRAIN) { E.fused(acc, cur, wr, wc, fr, fq, lds, wid, lane); S.done(cur); }
#undef PG8_SA
#undef PG8_SB
#undef PG8_STAGE
#undef PG8_LDA
#undef PG8_LDB
#undef PG8_MMA
#undef PG8_WAIT_V
#undef PG8_WAIT_L
#undef PG8_BAR
#undef PG8_SCHED
}
}
#ifndef PG8_SP2
#define PG8_SP2 true
#endif
#ifndef PG8_ALIGN
#define PG8_ALIGN true
#endif
constexpr int NWAVES = 8;
constexpr int DM = 4096, NB = 4, SEQ = 4096, CTXL = 256, DEPTH = 4;
constexpr int M_LAT = NB * SEQ, M_CTX = NB * CTXL, MT = M_LAT + M_CTX;
constexpr int HEADS = 16, QKD = 192, NOPE = 128, ROPED = 64, VDIM = 128, Q_LORA = 1536, KV_LORA = 512;
constexpr int E_CQ = 0, E_CKV = 1536, E_KPE = 2048, E_GM = 2112, E_QH = 4160, E_FF = 6208, E_FB = 8256, E_IH = 10304, E_GH = 12352, E_END = 14400, E_PAD = 14592;
constexpr int O_Q = 0, O_K = 4096, O_V = 8192, O_G = 16384, O_END = 24576;
constexpr int NQ = HEADS * QKD, NKV = HEADS * 256;
constexpr float EPS = 1e-6f;
constexpr int MODW = 3 * DM;
constexpr int KCH = 32;
constexpr size_t al256(size_t x) { return (x + 255) / 256 * 256; }
constexpr size_t WS_CTL = 0, CTL_ZERO_BYTES = 1u << 20;
constexpr size_t WS_MODP = CTL_ZERO_BYTES;
constexpr size_t WS_MOD  = WS_MODP + al256((size_t)KCH * 4 * 5 * MODW * 4);
constexpr size_t WS_LB   = WS_MOD + al256((size_t)4 * 5 * MODW * 4);
constexpr size_t WS_WINE = WS_LB + al256((size_t)2 * 2 * 2048 * 4);
constexpr size_t WS_WUQ  = WS_WINE + (size_t)2 * E_PAD * DM * 2;
constexpr size_t WS_WUKV = WS_WUQ + (size_t)2 * NQ * Q_LORA * 2;
constexpr size_t WS_WOE  = WS_WUKV + (size_t)2 * NKV * KV_LORA * 2;
constexpr size_t WS_WINO = WS_WOE + (size_t)2 * DM * DM * 2;
constexpr size_t WS_WOO  = WS_WINO + (size_t)2 * O_END * DM * 2;
constexpr size_t WS_XS   = WS_WOO + (size_t)2 * DM * 8192 * 2;
constexpr size_t WS_H    = WS_XS + (size_t)MT * DM * 4;
constexpr size_t WS_P    = WS_H + (size_t)MT * DM * 2;
constexpr size_t WS_U    = WS_P + (size_t)MT * O_END * 2;
constexpr size_t WS_CQN  = WS_U;
constexpr size_t WS_CKVN = WS_CQN + (size_t)MT * Q_LORA * 2;
constexpr size_t WS_QF   = WS_CKVN + (size_t)MT * KV_LORA * 2;
constexpr size_t WS_KV   = WS_QF + (size_t)MT * NQ * 2;
constexpr size_t WS_KF   = WS_KV + (size_t)MT * NKV * 2;
constexpr size_t WS_OFE  = WS_KF + (size_t)MT * NQ * 2;
constexpr size_t WS_OBE  = WS_OFE + (size_t)MT * 2048 * 2;
constexpr size_t WS_UE_END = WS_OBE + (size_t)MT * 2048 * 2;
constexpr size_t WS_OFO  = WS_U;
constexpr size_t WS_OBO  = WS_OFO + (size_t)MT * 8192 * 2;
constexpr size_t WS_UO_END = WS_OBO + (size_t)MT * 8192 * 2;
constexpr size_t WS_A    = WS_UE_END > WS_UO_END ? WS_UE_END : WS_UO_END;
constexpr size_t WS_END  = WS_A + (size_t)MT * 8192 * 2;
constexpr int CW_BAR = 4096;
constexpr int LDS_BYTES = 163840 - 1024;
constexpr int MISC_OFF = LDS_BYTES - 256;
#define LAS __attribute__((address_space(3)))
typedef unsigned short bf16;
typedef unsigned v4u __attribute__((ext_vector_type(4)));
typedef unsigned v2u __attribute__((ext_vector_type(2)));
typedef float f32x4 __attribute__((ext_vector_type(4)));
typedef float f32x16 __attribute__((ext_vector_type(16)));
typedef short bf16x8 __attribute__((ext_vector_type(8)));
typedef short s16x4 __attribute__((ext_vector_type(4)));
#define DI __device__ __forceinline__
typedef __bf16 bf2_t __attribute__((ext_vector_type(2)));
typedef float f32x2_t __attribute__((ext_vector_type(2)));
DI unsigned pk2(float lo, float hi) { const f32x2_t v = {lo, hi}; return __builtin_bit_cast(unsigned, __builtin_convertvector(v, bf2_t)); }
DI unsigned f2bf(float f) { return (unsigned)__builtin_bit_cast(unsigned short, (__bf16)f); }
DI float bflo(unsigned w) { return __uint_as_float(w << 16); }
DI float bfhi(unsigned w) { return __uint_as_float(w & 0xffff0000u); }
DI float bf2f(bf16 v) { return __uint_as_float(((unsigned)v) << 16); }
DI float bperm(int srclane, float v) { return __int_as_float(__builtin_amdgcn_ds_bpermute(srclane << 2, __float_as_int(v))); }
DI float wave_sum(float v, int lane) {
#pragma unroll
    for (int o = 1; o < 64; o <<= 1) v += bperm(lane ^ o, v);
    return v;
}
DI float siluf(float x) { return x / (1.0f + __expf(-x)); }
#define MFMA16(a, b, c) __builtin_amdgcn_mfma_f32_16x16x32_bf16((a), (b), (c), 0, 0, 0)
#define MFMA32(a, b, c) __builtin_amdgcn_mfma_f32_32x32x16_bf16((a), (b), (c), 0, 0, 0)
DI int crow(int r, int hi) { return (r & 3) + 8 * (r >> 2) + 4 * hi; }
DI unsigned img_off(unsigned row, unsigned ch) { return 256u * row + 16u * (ch ^ (((row & 3u) << 2) | ((row >> 2) & 3u))); }
DI unsigned tr32_addr(unsigned lane, unsigned k0, unsigned c, unsigned t) {
    const unsigned h = lane >> 5, blk = (lane >> 4) & 1u, q = (lane & 15u) >> 2, p = lane & 3u;
    return img_off(k0 + 8 * h + 4 * t + q, 4 * c + 2 * blk + (p >> 1)) + 8 * (p & 1u);
}
DI unsigned tr16_addr(unsigned lane, unsigned k0, unsigned c, unsigned t) {
    const unsigned g = lane >> 4, q = (lane & 15u) >> 2, p = lane & 3u;
    return img_off(k0 + 8 * g + 4 * t + q, 2 * c + (p >> 1)) + 8 * (p & 1u);
}
DI s16x4 tr_issue(unsigned lds_addr) { s16x4 r; asm volatile("ds_read_b64_tr_b16 %0, %1" : "=&v"(r) : "v"(lds_addr) : "memory"); return r; }
#define LDS_WAIT_PIN() do { asm volatile("s_waitcnt lgkmcnt(0)" ::: "memory"); __builtin_amdgcn_sched_barrier(0); } while (0)
#define CAT8(L, H) (bf16x8){L[0], L[1], L[2], L[3], H[0], H[1], H[2], H[3]}
DI unsigned cvtpk(float lo, float hi) { unsigned r; asm volatile("v_cvt_pk_bf16_f32 %0, %1, %2" : "=v"(r) : "v"(lo), "v"(hi)); return r; }

static_assert(WS_END <= (size_t)3221225472ull, "workspace map must fit 4 x the largest tensor (3 GiB)");
#define XB_TMO      128
#define XB_XCNT(j)  (256  + 64 * (j))
#define XB_XSUB(j)  (1280 + 64 * (j))
#define XB_XGEN(j)  (2304 + 64 * (j))
#define XB_TOP      3328
#define XB_TOPGEN   3392
#define XCD_BAR_WORDS 3456
#define XB_SPIN_CAP (1u << 18)

__device__ __forceinline__ unsigned xb_ld(unsigned* p)              { return __hip_atomic_load(p, __ATOMIC_RELAXED, __HIP_MEMORY_SCOPE_AGENT); }
__device__ __forceinline__ unsigned xb_add(unsigned* p, unsigned v) { return __hip_atomic_fetch_add(p, v, __ATOMIC_RELAXED, __HIP_MEMORY_SCOPE_AGENT); }
__device__ __forceinline__ unsigned xb_xcc_id() { return (unsigned)__builtin_amdgcn_s_getreg((3 << 11) | 20) & 0xFu; }
#define XB_SPIN(cond, bar) do { unsigned _sp = 0; while (cond) { __builtin_amdgcn_s_sleep(1); \
    if ((++_sp & 255u) == 0u) { if (xb_ld(&(bar)[XB_TMO])) break; if (_sp > XB_SPIN_CAP) { atomicAdd(&(bar)[XB_TMO], 1u); break; } } } } while (0)

struct XcdBarrier {
    unsigned* bar; unsigned x;
    volatile LAS unsigned* st;
};

__device__ __forceinline__ XcdBarrier xcd_barrier_post(unsigned* bar, volatile LAS unsigned* st) {
    XcdBarrier b; b.bar = bar; b.x = xb_xcc_id(); b.st = st;
    if (threadIdx.x == 0) (void)xb_add(&bar[XB_XCNT(b.x)], 1u);
    return b;
}
__device__ __forceinline__ void xcd_barrier_complete(unsigned* bar, unsigned x, unsigned& nloc, unsigned& nx) {
    const unsigned G = gridDim.x * gridDim.y * gridDim.z;
    unsigned sum, cnt, mine, sp = 0u;
    for (;;) {
        sum = 0u; cnt = 0u; mine = 0u;
#pragma unroll
        for (unsigned j = 0; j < 16; ++j) { const unsigned c = xb_ld(&bar[XB_XCNT(j)]); sum += c; cnt += (c > 0u) ? 1u : 0u; mine = (j == x) ? c : mine; }
        if (sum == G) break;
        __builtin_amdgcn_s_sleep(1);
        if ((++sp & 255u) == 0u) { if (xb_ld(&bar[XB_TMO])) break; if (sp > XB_SPIN_CAP) { atomicAdd(&bar[XB_TMO], 1u); break; } }
    }
    nloc = mine > 0u ? mine : 1u; nx = cnt > 0u ? cnt : 1u;
}

__device__ __forceinline__ void xcd_barrier(const XcdBarrier& b) {
    asm volatile("s_waitcnt vmcnt(0)" ::: "memory");
    __syncthreads();
    if (threadIdx.x == 0) {
        unsigned* bar = b.bar;
        __builtin_amdgcn_s_waitcnt(0);
        unsigned nloc = b.st[0], nx = b.st[1];
        if (nloc == 0u) { xcd_barrier_complete(bar, b.x, nloc, nx); b.st[0] = nloc; b.st[1] = nx; }
        const unsigned old = xb_add(&bar[XB_XSUB(b.x)], 1u);
        const unsigned gen = old / nloc;
        if (old + 1u == (gen + 1u) * nloc) {
            __builtin_amdgcn_fence(__ATOMIC_RELEASE, "agent");
            asm volatile("s_waitcnt vmcnt(0)" ::: "memory");
            const unsigned og = xb_add(&bar[XB_TOP], 1u);
            const unsigned tg = og / nx;
            if (og + 1u == (tg + 1u) * nx) xb_add(&bar[XB_TOPGEN], 1u);
            else XB_SPIN(xb_ld(&bar[XB_TOPGEN]) == tg, bar);
            __builtin_amdgcn_fence(__ATOMIC_ACQUIRE, "agent");
            xb_add(&bar[XB_XGEN(b.x)], 1u);
            asm volatile("s_waitcnt vmcnt(0)" ::: "memory");
        } else {
            XB_SPIN(xb_ld(&bar[XB_XGEN(b.x)]) == gen, bar);
            __builtin_amdgcn_fence(__ATOMIC_ACQUIRE, "agent");
            asm volatile("s_waitcnt vmcnt(0)" ::: "memory");
        }
    }
    __syncthreads();
}
struct Frame {
    LAS unsigned char* lds;
    int tid, lane, wave, vcu, G;
    unsigned char* ws;
    const float *x, *c, *ctx, *c_ctx, *mod_w, *mod_b, *norm_gain, *even_w_in, *q_a_gain, *kv_a_gain, *w_uq, *w_ukv, *q_norm_gain, *k_norm_gain, *hg_lb, *hg_norm_gain, *even_w_out, *odd_w_in, *ret_decay, *odd_w_out;
    float* out;
};
#define WSP(T, off) ((T*)(F.ws + (off)))
DI const float* ld_ptr(const LAS unsigned* tbl, int k) { const unsigned lo = __builtin_amdgcn_readfirstlane(tbl[2 * k]), hi = __builtin_amdgcn_readfirstlane(tbl[2 * k + 1]); return (const float*)(uintptr_t)(((unsigned long long)hi << 32) | lo); }
#define LOADPTRS(F) do { const LAS unsigned* t_ = (const LAS unsigned*)((F).lds + MISC_OFF + 64); \
    (F).x = ld_ptr(t_, 0); (F).c = ld_ptr(t_, 1); (F).ctx = ld_ptr(t_, 2); (F).c_ctx = ld_ptr(t_, 3); (F).mod_w = ld_ptr(t_, 4); (F).mod_b = ld_ptr(t_, 5); (F).norm_gain = ld_ptr(t_, 6); (F).even_w_in = ld_ptr(t_, 7); \
    (F).q_a_gain = ld_ptr(t_, 8); (F).kv_a_gain = ld_ptr(t_, 9); (F).w_uq = ld_ptr(t_, 10); (F).w_ukv = ld_ptr(t_, 11); (F).q_norm_gain = ld_ptr(t_, 12); (F).k_norm_gain = ld_ptr(t_, 13); (F).hg_lb = ld_ptr(t_, 14); \
    (F).hg_norm_gain = ld_ptr(t_, 15); (F).even_w_out = ld_ptr(t_, 16); (F).odd_w_in = ld_ptr(t_, 17); (F).ret_decay = ld_ptr(t_, 18); (F).odd_w_out = ld_ptr(t_, 19); } while (0)

DI void p0_transpose_item(const float* W, int K, int N, bf16* WT, LAS float* scr, int item, int lane) {
    const int nblk = N / 32, kb = item / nblk, nb = item % nblk, k0 = 64 * kb, n0 = 32 * nb;
    float tv[32];
#pragma unroll
    for (int i = 0; i < 32; ++i) tv[i] = W[(size_t)(k0 + 2 * i + (lane >> 5)) * N + n0 + (lane & 31)];
#pragma unroll
    for (int i = 0; i < 32; ++i) scr[(2 * i + (lane >> 5)) * 33 + (lane & 31)] = tv[i];
    asm volatile("s_waitcnt lgkmcnt(0)" ::: "memory");
    const int c = lane & 7;
#pragma unroll
    for (int j = 0; j < 4; ++j) { const int n = (lane >> 3) + 8 * j; const LAS float* s = scr + (8 * c) * 33 + n;
        v4u o; o.x = pk2(s[0 * 33], s[1 * 33]); o.y = pk2(s[2 * 33], s[3 * 33]); o.z = pk2(s[4 * 33], s[5 * 33]); o.w = pk2(s[6 * 33], s[7 * 33]);
        *(v4u*)(WT + (size_t)(n0 + n) * K + k0 + 8 * c) = o; }
    asm volatile("s_waitcnt lgkmcnt(0)" ::: "memory");
}
DI void ph_prologue(Frame& F) {
    LAS float* scr = (LAS float*)(F.lds + F.wave * 16384);
    const int gw = F.vcu * NWAVES + F.wave, NGW = F.G * NWAVES;
    constexpr int I_WINE = (DM / 64) * (E_END / 32), I_WUQ = (Q_LORA / 64) * (NQ / 32), I_WUKV = (KV_LORA / 64) * (NKV / 32), I_WOE = (DM / 64) * (DM / 32),
                  I_WINO = (DM / 64) * (O_END / 32), I_WOO = (8192 / 64) * (DM / 32);
    constexpr int I_PER = I_WINE + I_WUQ + I_WUKV + I_WOE + I_WINO + I_WOO;
    for (int it = gw; it < 2 * I_PER; it += NGW) {
        const int i = it / I_PER; int r = it % I_PER;
        if (r < I_WINE) { p0_transpose_item(F.even_w_in + (size_t)i * DM * E_END, DM, E_END, WSP(bf16, WS_WINE) + (size_t)i * E_PAD * DM, scr, r, F.lane); continue; } r -= I_WINE;
        if (r < I_WUQ) { p0_transpose_item(F.w_uq + (size_t)i * Q_LORA * NQ, Q_LORA, NQ, WSP(bf16, WS_WUQ) + (size_t)i * NQ * Q_LORA, scr, r, F.lane); continue; } r -= I_WUQ;
        if (r < I_WUKV) { p0_transpose_item(F.w_ukv + (size_t)i * KV_LORA * NKV, KV_LORA, NKV, WSP(bf16, WS_WUKV) + (size_t)i * NKV * KV_LORA, scr, r, F.lane); continue; } r -= I_WUKV;
        if (r < I_WOE) { p0_transpose_item(F.even_w_out + (size_t)i * DM * DM, DM, DM, WSP(bf16, WS_WOE) + (size_t)i * DM * DM, scr, r, F.lane); continue; } r -= I_WOE;
        if (r < I_WINO) { p0_transpose_item(F.odd_w_in + (size_t)i * DM * O_END, DM, O_END, WSP(bf16, WS_WINO) + (size_t)i * O_END * DM, scr, r, F.lane); continue; } r -= I_WINO;
        p0_transpose_item(F.odd_w_out + (size_t)i * 8192 * DM, 8192, DM, WSP(bf16, WS_WOO) + (size_t)i * DM * 8192, scr, r, F.lane);
    }
    { const size_t n16 = (size_t)(E_PAD - E_END) * DM * 2 / 16;
      for (size_t j = (size_t)blockIdx.x * 512 + F.tid; j < 2 * n16; j += (size_t)F.G * 512) { const size_t i = j / n16, o = j % n16;
          *((v4u*)(WSP(bf16, WS_WINE) + (i * E_PAD + E_END) * DM) + o) = (v4u){0u, 0u, 0u, 0u}; } }
    __syncthreads();
    LAS float* tab = (LAS float*)F.lds;
    for (int j = F.tid; j < 5 * DM; j += 512) { const int r = j >> 12, k = j & 4095; const float v = r < 4 ? F.c[r * DM + k] : F.c_ctx[k]; tab[j] = v / (1.0f + __expf(-v)); }
    __syncthreads();
    constexpr int NT = MODW / 256, KC = DM / KCH;
    float* modp = WSP(float, WS_MODP);
    for (int it = gw; it < 4 * NT * KCH; it += NGW) {
        const int kc = it % KCH, nt = (it / KCH) % NT, l = it / (KCH * NT);
        const float* W = F.mod_w + ((size_t)l * DM + (size_t)kc * KC) * MODW + nt * 256 + F.lane * 4;
        f32x4 acc[5];
#pragma unroll
        for (int r = 0; r < 5; ++r) acc[r] = (f32x4){0.f, 0.f, 0.f, 0.f};
#pragma unroll 8
        for (int k = 0; k < KC; ++k) { const f32x4 w = *(const f32x4*)(W + (size_t)k * MODW);
#pragma unroll
            for (int r = 0; r < 5; ++r) { const float s = tab[r * DM + kc * KC + k]; acc[r] += w * s; } }
#pragma unroll
        for (int r = 0; r < 5; ++r) *(f32x4*)(modp + ((size_t)(kc * 4 + l) * 5 + r) * MODW + nt * 256 + F.lane * 4) = acc[r];
    }
}
DI void ph_finalize(Frame& F) {
    const float* modp = WSP(float, WS_MODP); float* mod = WSP(float, WS_MOD);
    for (int j = blockIdx.x * 512 + F.tid; j < 4 * 5 * MODW / 4; j += F.G * 512) {
        const int n4 = j % (MODW / 4), lr = j / (MODW / 4), l = lr / 5;
        f32x4 s = *(const f32x4*)(F.mod_b + (size_t)l * MODW + n4 * 4);
        for (int kc = 0; kc < KCH; ++kc) s += *(const f32x4*)(modp + ((size_t)kc * 20 + lr) * MODW + n4 * 4);
        *(f32x4*)(mod + (size_t)lr * MODW + n4 * 4) = s;
    }
    float* lb = WSP(float, WS_LB);
    for (int j = blockIdx.x * 512 + F.tid; j < 2 * 2048; j += F.G * 512) {
        const float a0 = F.hg_lb[j], a1 = F.hg_lb[2 * 2048 + j], m = fmaxf(a0, a1), e0 = expf(a0 - m), e1 = expf(a1 - m);
        lb[j] = 0.f; lb[2 * 2048 + j] = e1 / (e0 + e1);
    }
}
DI void ph_ada_in(Frame& F, int l, const float* xl, const float* xc) {
    const int gw = F.vcu * NWAVES + F.wave, NGW = F.G * NWAVES;
    const float* gain = F.norm_gain + (size_t)l * DM; bf16* H = WSP(bf16, WS_H);
    for (int row = gw; row < MT; row += NGW) {
        const float* src = row < M_LAT ? xl + (size_t)row * DM : xc + (size_t)(row - M_LAT) * DM;
        const int seg = row < M_LAT ? (row >> 12) : 4;
        const float* md = WSP(float, WS_MOD) + ((size_t)l * 5 + seg) * MODW;
        f32x4 v[16]; float ss = 0.f;
#pragma unroll
        for (int j = 0; j < 16; ++j) { v[j] = *((const f32x4*)src + F.lane + 64 * j); ss += (v[j].x * v[j].x + v[j].y * v[j].y) + (v[j].z * v[j].z + v[j].w * v[j].w); }
        const float rinv = rsqrtf(wave_sum(ss, F.lane) * (1.0f / DM) + EPS);
#pragma unroll
        for (int j = 0; j < 16; ++j) { const int c4 = F.lane + 64 * j;
            const f32x4 g = *((const f32x4*)gain + c4), sh = *((const f32x4*)md + c4), sc = *((const f32x4*)(md + DM) + c4);
            const f32x4 y = v[j] * rinv * g * (sc + 1.0f) + sh;
            v2u o; o.x = pk2(y.x, y.y); o.y = pk2(y.z, y.w); *((v2u*)(H + (size_t)row * DM) + c4) = o; }
    }
}
DI void ph_lora_norm(Frame& F, int i) {
    const int gw = F.vcu * NWAVES + F.wave, NGW = F.G * NWAVES;
    const bf16* P = WSP(bf16, WS_P); bf16* CQN = WSP(bf16, WS_CQN); bf16* CKVN = WSP(bf16, WS_CKVN);
    const float* qg = F.q_a_gain + (size_t)i * Q_LORA; const float* kg = F.kv_a_gain + (size_t)i * KV_LORA;
    for (int row = gw; row < MT; row += NGW) {
        const bf16* pr = P + (size_t)row * E_PAD;
        v4u a[3]; float ss = 0.f;
#pragma unroll
        for (int j = 0; j < 3; ++j) { a[j] = *((const v4u*)(pr + E_CQ) + F.lane + 64 * j);
#pragma unroll
            for (int e = 0; e < 4; ++e) { const float lo = bflo(a[j][e]), hi = bfhi(a[j][e]); ss += lo * lo + hi * hi; } }
        const float rq = rsqrtf(wave_sum(ss, F.lane) * (1.0f / Q_LORA) + EPS);
#pragma unroll
        for (int j = 0; j < 3; ++j) { const int c8 = F.lane + 64 * j; const f32x4 g0 = *((const f32x4*)qg + 2 * c8), g1 = *((const f32x4*)qg + 2 * c8 + 1); v4u o;
            o.x = pk2(bflo(a[j].x) * rq * g0.x, bfhi(a[j].x) * rq * g0.y); o.y = pk2(bflo(a[j].y) * rq * g0.z, bfhi(a[j].y) * rq * g0.w);
            o.z = pk2(bflo(a[j].z) * rq * g1.x, bfhi(a[j].z) * rq * g1.y); o.w = pk2(bflo(a[j].w) * rq * g1.z, bfhi(a[j].w) * rq * g1.w);
            *((v4u*)(CQN + (size_t)row * Q_LORA) + c8) = o; }
        const v4u b = *((const v4u*)(pr + E_CKV) + F.lane); float s2 = 0.f;
#pragma unroll
        for (int e = 0; e < 4; ++e) { const float lo = bflo(b[e]), hi = bfhi(b[e]); s2 += lo * lo + hi * hi; }
        const float rk = rsqrtf(wave_sum(s2, F.lane) * (1.0f / KV_LORA) + EPS);
        { const f32x4 g0 = *((const f32x4*)kg + 2 * F.lane), g1 = *((const f32x4*)kg + 2 * F.lane + 1); v4u o;
          o.x = pk2(bflo(b.x) * rk * g0.x, bfhi(b.x) * rk * g0.y); o.y = pk2(bflo(b.y) * rk * g0.z, bfhi(b.y) * rk * g0.w);
          o.z = pk2(bflo(b.z) * rk * g1.x, bfhi(b.z) * rk * g1.y); o.w = pk2(bflo(b.w) * rk * g1.z, bfhi(b.w) * rk * g1.w);
          *((v4u*)(CKVN + (size_t)row * KV_LORA) + F.lane) = o; }
    }
}
DI void ph_qk_norm_rope(Frame& F, int i) {
    const int gw = F.vcu * NWAVES + F.wave, NGW = F.G * NWAVES;
    bf16* QF = WSP(bf16, WS_QF); const bf16* KV = WSP(bf16, WS_KV); bf16* KF = WSP(bf16, WS_KF); const bf16* P = WSP(bf16, WS_P);
    const float* qg = F.q_norm_gain + (size_t)i * QKD; const float* kg = F.k_norm_gain + (size_t)i * QKD;
    const int h = F.lane >> 2, part = F.lane & 3;
    float inv[8];
#pragma unroll
    for (int j = 0; j < 8; ++j) inv[j] = exp2f(-(float)(8 * (part & 1) + j) * (13.287712379549449f / 16.0f));
    constexpr float QSCL = 0.07216878364870322f * 1.4426950408889634f;
    for (int row = gw; row < MT; row += NGW) {
        const bool lat = row < M_LAT; const int t = row & 4095; const float prow = (float)(t >> 6), pcol = (float)(t & 63);
        float cs[2][8], sn[2][8];
        if (lat) {
#pragma unroll
            for (int j = 0; j < 8; ++j) { sincosf(prow * inv[j], &sn[0][j], &cs[0][j]); sincosf(pcol * inv[j], &sn[1][j], &cs[1][j]); }
        }
#pragma unroll
        for (int which = 0; which < 2; ++which) {
            float v[6][8]; float ss = 0.f;
#pragma unroll
            for (int ii = 0; ii < 6; ++ii) { const int c = part + 4 * ii; v4u w;
                if (which == 0) w = *(const v4u*)(QF + (size_t)row * NQ + h * QKD + 8 * c);
                else if (ii < 4) w = *(const v4u*)(KV + (size_t)row * NKV + h * 256 + 8 * c);
                else w = *(const v4u*)(P + (size_t)row * E_PAD + E_KPE + 8 * (c - 16));
#pragma unroll
                for (int e = 0; e < 4; ++e) { v[ii][2 * e] = bflo(w[e]); v[ii][2 * e + 1] = bfhi(w[e]); ss += v[ii][2 * e] * v[ii][2 * e] + v[ii][2 * e + 1] * v[ii][2 * e + 1]; } }
            ss += bperm(F.lane ^ 1, ss); ss += bperm(F.lane ^ 2, ss);
            const float rn = rsqrtf(ss * (1.0f / QKD) + EPS); const float* gg = which == 0 ? qg : kg;
#pragma unroll
            for (int ii = 0; ii < 6; ++ii) { const int c = part + 4 * ii;
#pragma unroll
                for (int e = 0; e < 8; ++e) v[ii][e] = v[ii][e] * rn * gg[8 * c + e]; }
            if (lat) {
#pragma unroll
                for (int hf = 0; hf < 2; ++hf) {
#pragma unroll
                    for (int e = 0; e < 8; ++e) { const float m = v[4 + hf][e], o = bperm(F.lane ^ 2, m);
                        v[4 + hf][e] = (part < 2) ? (m * cs[hf][e] - o * sn[hf][e]) : (o * sn[hf][e] + m * cs[hf][e]); } }
            }
            const float scl = which == 0 ? QSCL : 1.0f;
#pragma unroll
            for (int ii = 0; ii < 6; ++ii) { const int c = part + 4 * ii; v4u o;
#pragma unroll
                for (int e = 0; e < 4; ++e) o[e] = pk2(v[ii][2 * e] * scl, v[ii][2 * e + 1] * scl);
                if (which == 0) *(v4u*)(QF + (size_t)row * NQ + h * QKD + 8 * c) = o; else *(v4u*)(KF + (size_t)row * NQ + h * QKD + 8 * c) = o; }
        }
    }
}
DI void ph_hg_merge(Frame& F, int i) {
    const int gw = F.vcu * NWAVES + F.wave, NGW = F.G * NWAVES;
    const bf16* OFp = WSP(bf16, WS_OFE); const bf16* OBp = WSP(bf16, WS_OBE); const bf16* P = WSP(bf16, WS_P); bf16* A = WSP(bf16, WS_A);
    const float* hgg = F.hg_norm_gain + (size_t)i * 128; const int h = F.lane >> 2, part = F.lane & 3;
    for (int row = gw; row < MT; row += NGW) {
        const size_t o0 = (size_t)row * 2048 + h * 128 + part * 32; f32x4 v[8]; float ss = 0.f;
#pragma unroll
        for (int j = 0; j < 4; ++j) { const v4u a = *((const v4u*)(OFp + o0) + j), b = *((const v4u*)(OBp + o0) + j);
            v[2 * j] = (f32x4){bflo(a.x) + bflo(b.x), bfhi(a.x) + bfhi(b.x), bflo(a.y) + bflo(b.y), bfhi(a.y) + bfhi(b.y)};
            v[2 * j + 1] = (f32x4){bflo(a.z) + bflo(b.z), bfhi(a.z) + bfhi(b.z), bflo(a.w) + bflo(b.w), bfhi(a.w) + bfhi(b.w)}; }
#pragma unroll
        for (int j = 0; j < 8; ++j) ss += (v[j].x * v[j].x + v[j].y * v[j].y) + (v[j].z * v[j].z + v[j].w * v[j].w);
        ss += bperm(F.lane ^ 1, ss); ss += bperm(F.lane ^ 2, ss);
        const float rn = rsqrtf(ss * (1.0f / 128) + EPS);
        const bf16* gp = P + (size_t)row * E_PAD + E_GH + h * 128 + part * 32; bf16* ap = A + (size_t)row * DM + 2048 + h * 128 + part * 32;
#pragma unroll
        for (int j = 0; j < 4; ++j) { const v4u g = *((const v4u*)gp + j); const f32x4 a = v[2 * j], b = v[2 * j + 1];
            const f32x4 g0 = *((const f32x4*)(hgg + part * 32) + 2 * j), g1 = *((const f32x4*)(hgg + part * 32) + 2 * j + 1); v4u o;
            o.x = pk2(a.x * rn * g0.x * siluf(bflo(g.x)), a.y * rn * g0.y * siluf(bfhi(g.x))); o.y = pk2(a.z * rn * g0.z * siluf(bflo(g.y)), a.w * rn * g0.w * siluf(bfhi(g.y)));
            o.z = pk2(b.x * rn * g1.x * siluf(bflo(g.z)), b.y * rn * g1.y * siluf(bfhi(g.z))); o.w = pk2(b.z * rn * g1.z * siluf(bflo(g.w)), b.w * rn * g1.w * siluf(bfhi(g.w)));
            *((v4u*)ap + j) = o; }
    }
}
DI void ph_ret_rope(Frame& F) {
    const int gw = F.vcu * NWAVES + F.wave, NGW = F.G * NWAVES; bf16* P = WSP(bf16, WS_P);
    const int hsub = F.lane >> 4, i0 = 8 * (F.lane & 15);
    float inv[8];
#pragma unroll
    for (int j = 0; j < 8; ++j) inv[j] = 1.0f / powf(10000.0f, (float)(i0 + j) * (1.0f / 127.0f));
    for (int row = gw; row < MT; row += NGW) {
        const bool lat = row < M_LAT; const float pos = (float)(row & 4095);
        float cs[8], sn[8];
#pragma unroll
        for (int j = 0; j < 8; ++j) { if (lat) sincosf(pos * inv[j], &sn[j], &cs[j]); else { cs[j] = 1.f; sn[j] = 0.f; } }
#pragma unroll
        for (int which = 0; which < 2; ++which) {
            const float scl = which ? 0.0625f : 1.0f;
#pragma unroll
            for (int it = 0; it < 4; ++it) { const int h = 4 * it + hsub; bf16* p1 = P + (size_t)row * O_END + (which ? O_K : O_Q) + h * 256 + i0; bf16* p2 = p1 + 128;
                const v4u a = *(const v4u*)p1, b = *(const v4u*)p2; v4u oa, ob;
#pragma unroll
                for (int e = 0; e < 4; ++e) { const float x1l = bflo(a[e]), x1h = bfhi(a[e]), x2l = bflo(b[e]), x2h = bfhi(b[e]);
                    oa[e] = pk2((x1l * cs[2 * e] - x2l * sn[2 * e]) * scl, (x1h * cs[2 * e + 1] - x2h * sn[2 * e + 1]) * scl);
                    ob[e] = pk2((x1l * sn[2 * e] + x2l * cs[2 * e]) * scl, (x1h * sn[2 * e + 1] + x2h * cs[2 * e + 1]) * scl); }
                *(v4u*)p1 = oa; *(v4u*)p2 = ob; }
        }
    }
}
DI void ph_ret_merge(Frame& F, int li) {
    const int gw = F.vcu * NWAVES + F.wave, NGW = F.G * NWAVES;
    const bf16* OFp = WSP(bf16, WS_OFO); const bf16* OBp = WSP(bf16, WS_OBO); const bf16* P = WSP(bf16, WS_P); bf16* A = WSP(bf16, WS_A);
    LAS float* l2t = (LAS float*)F.lds;
    if (F.tid < 32) { const float dl = F.ret_decay[(size_t)li * 32 + F.tid]; l2t[F.tid] = -log1pf(expf(-dl)) * 1.4426950408889634f; }
    __syncthreads();
    for (int row = gw; row < MT; row += NGW) {
        const float j = (float)(row & 63);
#pragma unroll 4
        for (int h = 0; h < 16; ++h) { const size_t o0 = (size_t)row * 8192 + h * 512 + F.lane * 8;
            const float sf = __builtin_amdgcn_exp2f((j - 63.0f) * l2t[h]), sb = __builtin_amdgcn_exp2f(-j * l2t[16 + h]);
            const v4u fa = *(const v4u*)(OFp + o0), fb = *(const v4u*)(OBp + o0);
            const f32x4 a = (f32x4){bflo(fa.x) * sf + bflo(fb.x) * sb, bfhi(fa.x) * sf + bfhi(fb.x) * sb, bflo(fa.y) * sf + bflo(fb.y) * sb, bfhi(fa.y) * sf + bfhi(fb.y) * sb};
            const f32x4 b = (f32x4){bflo(fa.z) * sf + bflo(fb.z) * sb, bfhi(fa.z) * sf + bfhi(fb.z) * sb, bflo(fa.w) * sf + bflo(fb.w) * sb, bfhi(fa.w) * sf + bfhi(fb.w) * sb};
            const float ss = (a.x * a.x + a.y * a.y) + (a.z * a.z + a.w * a.w) + (b.x * b.x + b.y * b.y) + (b.z * b.z + b.w * b.w);
            const float rn = rsqrtf(wave_sum(ss, F.lane) * (1.0f / 512) + EPS);
            const v4u g = *(const v4u*)(P + (size_t)row * O_END + O_G + h * 512 + F.lane * 8); v4u o;
            o.x = pk2(a.x * rn * siluf(bflo(g.x)), a.y * rn * siluf(bfhi(g.x))); o.y = pk2(a.z * rn * siluf(bflo(g.y)), a.w * rn * siluf(bfhi(g.y)));
            o.z = pk2(b.x * rn * siluf(bflo(g.z)), b.y * rn * siluf(bfhi(g.z))); o.w = pk2(b.z * rn * siluf(bflo(g.w)), b.w * rn * siluf(bfhi(g.w)));
            *(v4u*)(A + (size_t)row * 8192 + h * 512 + F.lane * 8) = o; }
    }
}
namespace att {
constexpr int KP = 400;
constexpr int VB = 64 * 128 * 2, KB = 64 * KP;
constexpr int OFF_V = 0, OFF_K = 2 * VB, OFF_WS = OFF_K + 2 * KB;
constexpr float THR2 = 11.5f;
DI int v_st(int k, int c) { const int kk = (k & ~0xC) | ((k & 4) << 1) | ((k & 8) >> 1); return ((kk >> 3) * 4 + (c >> 5)) * 512 + ((kk & 7) * 32 + (c & 31)) * 2; }
DI int v_rd_base(int lane) { return ((lane & 3) << 3) | (((lane >> 2) & 3) << 6) | (((lane >> 4) & 1) << 5) | (((lane >> 5) & 1) << 8); }
constexpr int v_rd_off(int d0, int ks, int half) { return d0 * 512 + ks * 4096 + half * 2048; }
template <int OFF> DI s16x4 tr_read(int vb) { s16x4 r; asm volatile("ds_read_b64_tr_b16 %0, %1 offset:%2" : "=&v"(r) : "v"(vb), "i"(OFF) : "memory"); return r; }
template <int D0> DI void pv_one(f32x16& od, int vb, bf16x8 pa0, bf16x8 pa1, bf16x8 pa2, bf16x8 pa3) {
    const s16x4 l0 = tr_read<v_rd_off(D0, 0, 0)>(vb), h0 = tr_read<v_rd_off(D0, 0, 1)>(vb), l1 = tr_read<v_rd_off(D0, 1, 0)>(vb), h1 = tr_read<v_rd_off(D0, 1, 1)>(vb);
    const s16x4 l2 = tr_read<v_rd_off(D0, 2, 0)>(vb), h2 = tr_read<v_rd_off(D0, 2, 1)>(vb), l3 = tr_read<v_rd_off(D0, 3, 0)>(vb), h3 = tr_read<v_rd_off(D0, 3, 1)>(vb);
    LDS_WAIT_PIN();
    od = MFMA32(pa0, CAT8(l0, h0), od); od = MFMA32(pa1, CAT8(l1, h1), od); od = MFMA32(pa2, CAT8(l2, h2), od); od = MFMA32(pa3, CAT8(l3, h3), od);
}
DI void unit(Frame& F, int h, int qrow0, int klat0, int nlat, int kctx0, int NT, int ldp) {
    const int tid = F.tid, wid = F.wave, lane = F.lane, r32 = lane & 31, hi = lane >> 5;
    const bf16* QF = WSP(bf16, WS_QF); const bf16* KF = WSP(bf16, WS_KF); const bf16* KV = WSP(bf16, WS_KV); const bf16* P = WSP(bf16, WS_P); bf16* A = WSP(bf16, WS_A);
    LAS unsigned char* Vl = F.lds + OFF_V; LAS unsigned char* Kl = F.lds + OFF_K;
    LAS float* wsl = (LAS float*)(F.lds + OFF_WS) + wid * 64; LAS float* li_l = wsl; LAS float* al_l = wsl + 32;
    float m_reg = -1e30f, l_reg = 0.f; f32x16 o[4];
#pragma unroll
    for (int d = 0; d < 4; ++d)
#pragma unroll
        for (int r = 0; r < 16; ++r) o[d][r] = 0.f;
    bf16x8 qr[12];
    { const bf16* Qw = QF + (size_t)(qrow0 + wid * 32 + r32) * NQ + h * QKD + hi * 8;
#pragma unroll
      for (int d0 = 0; d0 < 12; ++d0) qr[d0] = *(const bf16x8*)(Qw + d0 * 16); }
    int krow[3], kch[3];
#pragma unroll
    for (int i = 0; i < 3; ++i) { const int idx = tid + 512 * i; krow[i] = idx / 24; kch[i] = idx % 24; }
    const int vrow0 = tid >> 4, vc = (tid & 15) * 8;
    v4u sk[3], sv[2];
    const int vb0 = (int)(uintptr_t)Vl + v_rd_base(lane);
#define KEYROW(kt) ((kt) < nlat ? klat0 + 64 * (kt) : kctx0 + 64 * ((kt) - nlat))
#define SLOAD(kt) do { const int kr_ = KEYROW(kt); _Pragma("unroll") for (int i = 0; i < 3; ++i) sk[i] = *(const v4u*)(KF + (size_t)(kr_ + krow[i]) * NQ + h * QKD + kch[i] * 8); \
        _Pragma("unroll") for (int i = 0; i < 2; ++i) sv[i] = *(const v4u*)(KV + (size_t)(kr_ + vrow0 + 32 * i) * NKV + h * 256 + 128 + vc); } while (0)
#define SWRITE(b) do { _Pragma("unroll") for (int i = 0; i < 3; ++i) *(LAS v4u*)(Kl + (b) * KB + krow[i] * KP + kch[i] * 16) = sk[i]; \
        _Pragma("unroll") for (int i = 0; i < 2; ++i) *(LAS v4u*)(Vl + (b) * VB + v_st(vrow0 + 32 * i, vc)) = sv[i]; } while (0)
    SLOAD(0); SWRITE(0);
    if (NT > 1) SLOAD(1);
    __syncthreads();
    for (int j = 0; j < NT; ++j) {
        const int buf = j & 1;
        f32x16 p0, p1;
#pragma unroll
        for (int r = 0; r < 16; ++r) { p0[r] = 0.f; p1[r] = 0.f; }
        { const LAS unsigned char* Ks = Kl + buf * KB;
#pragma unroll
          for (int d0 = 0; d0 < 12; ++d0) { const int cb = (d0 * 16 + hi * 8) * 2;
              const bf16x8 b0 = *(const LAS bf16x8*)(Ks + r32 * KP + cb), b1 = *(const LAS bf16x8*)(Ks + (32 + r32) * KP + cb);
              p0 = MFMA32(b0, qr[d0], p0); p1 = MFMA32(b1, qr[d0], p1); } }
        float pmax = p0[0];
#pragma unroll
        for (int r = 1; r < 16; ++r) pmax = fmaxf(pmax, p0[r]);
#pragma unroll
        for (int r = 0; r < 16; ++r) pmax = fmaxf(pmax, p1[r]);
        { auto rr = __builtin_amdgcn_permlane32_swap(__float_as_uint(pmax), __float_as_uint(pmax), false, false); pmax = fmaxf(__uint_as_float(rr[0]), __uint_as_float(rr[1])); }
        float mn, alpha;
        if (__all(pmax - m_reg <= THR2)) { mn = m_reg; alpha = 1.f; }
        else { mn = fmaxf(m_reg, pmax); alpha = __builtin_amdgcn_exp2f(m_reg - mn); m_reg = mn; }
        float ps = 0.f;
#pragma unroll
        for (int r = 0; r < 16; ++r) { p0[r] = __builtin_amdgcn_exp2f(p0[r] - mn); p1[r] = __builtin_amdgcn_exp2f(p1[r] - mn); ps += p0[r] + p1[r]; }
        { auto rr = __builtin_amdgcn_permlane32_swap(__float_as_uint(ps), __float_as_uint(ps), false, false); ps = __uint_as_float(rr[0]) + __uint_as_float(rr[1]); }
        l_reg = l_reg * alpha + ps;
        bf16x8 pa0, pa1, pa2, pa3;
#define PK4(Pv, BASE, OUT) do { unsigned a0 = cvtpk(Pv[BASE + 0], Pv[BASE + 1]), a1 = cvtpk(Pv[BASE + 2], Pv[BASE + 3]); \
        unsigned b0_ = cvtpk(Pv[BASE + 4], Pv[BASE + 5]), b1_ = cvtpk(Pv[BASE + 6], Pv[BASE + 7]); \
        auto r0 = __builtin_amdgcn_permlane32_swap(a0, b0_, false, false); auto r1 = __builtin_amdgcn_permlane32_swap(a1, b1_, false, false); \
        v4u w = {r0[0], r1[0], r0[1], r1[1]}; OUT = __builtin_bit_cast(bf16x8, w); } while (0)
        PK4(p0, 0, pa0); PK4(p0, 8, pa1); PK4(p1, 0, pa2); PK4(p1, 8, pa3);
#undef PK4
        if (__any(alpha < 1.f)) { if (hi == 0) al_l[r32] = alpha; asm volatile("s_waitcnt lgkmcnt(0)" ::: "memory");
#pragma unroll
            for (int r = 0; r < 16; ++r) { const float a = al_l[crow(r, hi)];
#pragma unroll
                for (int d = 0; d < 4; ++d) o[d][r] *= a; } }
        if (j + 1 < NT) SWRITE(buf ^ 1);
        if (j + 2 < NT) SLOAD(j + 2);
        { const int vb = vb0 + buf * VB;
          pv_one<0>(o[0], vb, pa0, pa1, pa2, pa3); pv_one<1>(o[1], vb, pa0, pa1, pa2, pa3); pv_one<2>(o[2], vb, pa0, pa1, pa2, pa3); pv_one<3>(o[3], vb, pa0, pa1, pa2, pa3); }
        __syncthreads();
    }
#undef SLOAD
#undef SWRITE
#undef KEYROW
    if (hi == 0) li_l[r32] = l_reg; asm volatile("s_waitcnt lgkmcnt(0)" ::: "memory");
#pragma unroll
    for (int r = 0; r < 16; ++r) { const int orow = crow(r, hi); const float rl = __builtin_amdgcn_rcpf(li_l[orow]); const size_t grow = (size_t)(qrow0 + wid * 32 + orow);
#pragma unroll
        for (int d0 = 0; d0 < 4; ++d0) { const int col = h * 128 + d0 * 32 + r32; const float g = bf2f(P[grow * ldp + E_GM + col]);
            A[grow * DM + col] = (bf16)f2bf(o[d0][r] * rl * siluf(g)); } }
    __syncthreads();
}
}
namespace hg {
constexpr int OFF_QP = 0, OFF_KP = 8192, OFF_QS = 16384, OFF_KH = 24576, OFF_V = 32768, OFF_A = 40960, OFF_E = 45056, OFF_SB = 49152, SB_BYTES = 32768;
constexpr int NCH = 8 + 128;
DI int row_of(int b, int dir, int cidx, int i) {
    if (cidx < 8) { const int pos = cidx * 32 + i; return M_LAT + b * CTXL + (dir ? CTXL - 1 - pos : pos); }
    const int pos = (cidx - 8) * 32 + i; return b * SEQ + (dir ? SEQ - 1 - pos : pos);
}
DI void unit(Frame& F, int li, int b, int h, int dir) {
    const int wid = F.wave, lane = F.lane, p = lane & 31, chalf = lane >> 5, ch = 2 * wid + chalf;
    const bf16* P = WSP(bf16, WS_P); bf16* OUT = dir ? WSP(bf16, WS_OBE) : WSP(bf16, WS_OFE);
    LAS unsigned char* L = F.lds;
    float lbv[8];
    { const float* lbp = WSP(float, WS_LB) + ((size_t)li * 2 + dir) * 2048 + h * 128 + ch * 8;
#pragma unroll
      for (int j = 0; j < 8; ++j) lbv[j] = lbp[j]; }
    const int fcol = (dir ? E_FB : E_FF) + h * 128 + ch * 8, qcol = E_QH + h * 128 + ch * 8, vcol = E_IH + h * 128 + ch * 8;
    f32x16 accS[2];
#pragma unroll
    for (int i = 0; i < 2; ++i)
#pragma unroll
        for (int r = 0; r < 16; ++r) accS[i][r] = 0.f;
    for (int j = F.tid; j < SB_BYTES / 16; j += 512) *((LAS v4u*)(L + OFF_SB) + j) = (v4u){0u, 0u, 0u, 0u};
    v4u rq, rf, rv;
    { const size_t ro = (size_t)row_of(b, dir, 0, p) * E_PAD; rq = *(const v4u*)(P + ro + qcol); rf = *(const v4u*)(P + ro + fcol); rv = *(const v4u*)(P + ro + vcol); }
    __syncthreads();
    for (int cidx = 0; cidx < NCH; ++cidx) {
        const int cur = cidx & 1;
        LAS unsigned char* SBc = L + OFF_SB + cur * SB_BYTES; LAS unsigned char* SBn = L + OFF_SB + (cur ^ 1) * SB_BYTES;
        const v4u cq = rq, cf = rf, cv = rv;
        if (cidx + 1 < NCH) { const size_t ro = (size_t)row_of(b, dir, cidx + 1, p) * E_PAD; rq = *(const v4u*)(P + ro + qcol); rf = *(const v4u*)(P + ro + fcol); rv = *(const v4u*)(P + ro + vcol); }
        {
            float bq[8], key[8], bb[8];
#pragma unroll
            for (int e = 0; e < 4; ++e) { bq[2 * e] = bflo(cq[e]); bq[2 * e + 1] = bfhi(cq[e]); }
#pragma unroll
            for (int e = 0; e < 8; ++e) { const float f = (e & 1) ? bfhi(cf[e >> 1]) : bflo(cf[e >> 1]);
                const float sp = 1.0f / (1.0f + __expf(-f)), sn = 1.0f / (1.0f + __expf(f));
                const float g = lbv[e] + (1.0f - lbv[e]) * sp; key[e] = (1.0f - lbv[e]) * sn; bb[e] = fmaxf(__log2f(g), -120.0f); }
#pragma unroll
            for (int d = 1; d < 32; d <<= 1) {
#pragma unroll
                for (int e = 0; e < 8; ++e) { const float y = bperm(lane - d, bb[e]); if (p >= d) bb[e] += y; } }
            v4u oqp, okp, oqs, okh; float qp[8], kp[8], qs[8], kh[8];
#pragma unroll
            for (int e = 0; e < 8; ++e) { const float c = bperm((lane & 32) + 15, bb[e]), bl = bperm((lane & 32) + 31, bb[e]);
                const float e1 = __builtin_amdgcn_exp2f(bb[e] - c), e2 = __builtin_amdgcn_exp2f(c - bb[e]), ec = __builtin_amdgcn_exp2f(c), ebc = __builtin_amdgcn_exp2f(bl - c);
                qp[e] = bq[e] * e1; kp[e] = key[e] * e2; qs[e] = qp[e] * ec; kh[e] = kp[e] * ebc;
                if (p == 31) *(LAS float*)(L + OFF_E + (ch * 8 + e) * 4) = __builtin_amdgcn_exp2f(bl); }
#pragma unroll
            for (int e = 0; e < 4; ++e) { oqp[e] = pk2(qp[2 * e], qp[2 * e + 1]); okp[e] = pk2(kp[2 * e], kp[2 * e + 1]); oqs[e] = pk2(qs[2 * e], qs[2 * e + 1]); okh[e] = pk2(kh[2 * e], kh[2 * e + 1]); }
            const unsigned off = img_off(p, ch);
            *(LAS v4u*)(L + OFF_QP + off) = oqp; *(LAS v4u*)(L + OFF_KP + off) = okp; *(LAS v4u*)(L + OFF_QS + off) = oqs; *(LAS v4u*)(L + OFF_KH + off) = okh; *(LAS v4u*)(L + OFF_V + off) = cv;
        }
        __syncthreads();
        if (wid < 4) { const int mi = wid >> 1, ni = wid & 1; f32x4 acc = {0.f, 0.f, 0.f, 0.f};
#pragma unroll
            for (int ks = 0; ks < 4; ++ks) { const bf16x8 a = *(const LAS bf16x8*)(L + OFF_QP + img_off(mi * 16 + (lane & 15), 4 * ks + (lane >> 4)));
                const bf16x8 bfr = *(const LAS bf16x8*)(L + OFF_KP + img_off(ni * 16 + (lane & 15), 4 * ks + (lane >> 4))); acc = MFMA16(a, bfr, acc); }
#pragma unroll
            for (int r = 0; r < 4; ++r) { const int t = mi * 16 + 4 * (lane >> 4) + r, s = ni * 16 + (lane & 15);
                *(LAS bf16*)(L + OFF_A + t * 80 + s * 2) = (bf16)f2bf(t >= s ? acc[r] : 0.f); } }
        __syncthreads();
        {
            const unsigned vbase = (unsigned)(uintptr_t)(L + OFF_V), kbase = (unsigned)(uintptr_t)(L + OFF_KH);
            const s16x4 v0 = tr_issue(vbase + tr16_addr(lane, 0, wid, 0)), v1 = tr_issue(vbase + tr16_addr(lane, 0, wid, 1));
            const int mk = wid >> 1, nv0 = 2 * (wid & 1);
            s16x4 ka[2][2], vb[2][2][2];
#pragma unroll
            for (int ks = 0; ks < 2; ++ks) { ka[ks][0] = tr_issue(kbase + tr32_addr(lane, 16 * ks, mk, 0)); ka[ks][1] = tr_issue(kbase + tr32_addr(lane, 16 * ks, mk, 1));
#pragma unroll
                for (int nvi = 0; nvi < 2; ++nvi) { vb[nvi][ks][0] = tr_issue(vbase + tr32_addr(lane, 16 * ks, nv0 + nvi, 0)); vb[nvi][ks][1] = tr_issue(vbase + tr32_addr(lane, 16 * ks, nv0 + nvi, 1)); } }
            LDS_WAIT_PIN();
            const bf16x8 vfr = CAT8(v0, v1);
            f32x4 accO[2];
#pragma unroll
            for (int mi = 0; mi < 2; ++mi) { accO[mi] = (f32x4){0.f, 0.f, 0.f, 0.f};
                const bf16x8 afr = *(const LAS bf16x8*)(L + OFF_A + (mi * 16 + (lane & 15)) * 80 + (lane >> 4) * 16);
                accO[mi] = MFMA16(afr, vfr, accO[mi]);
#pragma unroll
                for (int ks = 0; ks < 4; ++ks) { const bf16x8 qf = *(const LAS bf16x8*)(L + OFF_QS + img_off(mi * 16 + (lane & 15), 4 * ks + (lane >> 4)));
                    const bf16x8 sf = *(const LAS bf16x8*)(SBc + img_off(16 * wid + (lane & 15), 4 * ks + (lane >> 4))); accO[mi] = MFMA16(qf, sf, accO[mi]); } }
#pragma unroll
            for (int mi = 0; mi < 2; ++mi)
#pragma unroll
                for (int r = 0; r < 4; ++r) { const int t = mi * 16 + 4 * (lane >> 4) + r;
                    OUT[(size_t)row_of(b, dir, cidx, t) * 2048 + h * 128 + 16 * wid + (lane & 15)] = (bf16)f2bf(accO[mi][r]); }
            const int hi = lane >> 5;
#pragma unroll
            for (int nvi = 0; nvi < 2; ++nvi) {
#pragma unroll
                for (int g = 0; g < 4; ++g) { const f32x4 ev = *(const LAS f32x4*)(L + OFF_E + (32 * mk + 8 * g + 4 * hi) * 4);
#pragma unroll
                    for (int j = 0; j < 4; ++j) accS[nvi][4 * g + j] *= ev[j]; }
#pragma unroll
                for (int ks = 0; ks < 2; ++ks) accS[nvi] = MFMA32(CAT8(ka[ks][0], ka[ks][1]), CAT8(vb[nvi][ks][0], vb[nvi][ks][1]), accS[nvi]);
#pragma unroll
                for (int g = 0; g < 4; ++g) { v2u w; w.x = pk2(accS[nvi][4 * g], accS[nvi][4 * g + 1]); w.y = pk2(accS[nvi][4 * g + 2], accS[nvi][4 * g + 3]);
                    *(LAS v2u*)(SBn + img_off(32 * (nv0 + nvi) + (lane & 31), 4 * mk + g) + 8 * hi) = w; }
            }
        }
        __syncthreads();
    }
}
}
namespace rt {
constexpr int QP = 528, SBP = 528, PP = 144;
constexpr int OFF_Q = 0, OFF_K = OFF_Q + 64 * QP, OFF_V = OFF_K + 32768, OFF_P = OFF_V + 16384, OFF_SB = OFF_P + 64 * PP, LDS_END = OFF_SB + 128 * SBP;
static_assert(LDS_END <= MISC_OFF, "retention LDS map");
constexpr int NCH = 4 + 64;
template <int OFF> DI s16x4 tr_off(unsigned base) { s16x4 r; asm volatile("ds_read_b64_tr_b16 %0, %1 offset:%2" : "=&v"(r) : "v"(base), "i"(OFF) : "memory"); return r; }
DI void unit(Frame& F, int li, int b, int h, int dir, int vs) {
    const int tid = F.tid, wid = F.wave, lane0 = F.lane;
    const bf16* P = WSP(bf16, WS_P); bf16* OUT = dir ? WSP(bf16, WS_OBO) : WSP(bf16, WS_OFO);
    LAS unsigned char* L = F.lds;
    const float dl = F.ret_decay[((size_t)li * 2 + dir) * 16 + h];
    const float l2g = -log1pf(expf(-dl)) * 1.4426950408889634f;
    const float g64 = exp2f(64.0f * l2g);
    f32x16 accS[4];
#pragma unroll
    for (int i = 0; i < 4; ++i)
#pragma unroll
        for (int r = 0; r < 16; ++r) accS[i][r] = 0.f;
    const int qrow = tid >> 5, qc = tid & 31, vrow = tid >> 4, vc = tid & 15;
    unsigned gq[4], gv[2]; float vw[2];
#pragma unroll
    for (int i = 0; i < 4; ++i) { const int r = qrow + 16 * i; gq[i] = (unsigned)(((dir ? 63 - r : r) * O_END + qc * 8) * 2); }
#pragma unroll
    for (int i = 0; i < 2; ++i) { const int r = vrow + 32 * i; gv[i] = (unsigned)(((dir ? 63 - r : r) * O_END + vc * 8) * 2); vw[i] = exp2f((float)(63 - r) * l2g); }
    const unsigned lq = OFF_Q + qrow * QP + qc * 16, lk = OFF_K + (qc >> 4) * 16384 + img_off(qrow, qc & 15), lv = OFF_V + img_off(vrow, vc);
    v4u sq[4], sk[4], sv[2];
#define ROWLO(ci) ((ci) < 4 ? M_LAT + b * CTXL + (dir ? CTXL - 64 - (ci) * 64 : (ci) * 64) : b * SEQ + (dir ? SEQ - 64 - ((ci) - 4) * 64 : ((ci) - 4) * 64))
#define RLOAD(ci) do { const char* pb_ = (const char*)(P + (size_t)ROWLO(ci) * O_END + h * 256); const char* pv_ = (const char*)(P + (size_t)ROWLO(ci) * O_END + O_V + h * 512 + vs * 128); \
        _Pragma("unroll") for (int i = 0; i < 4; ++i) { sq[i] = *(const v4u*)(pb_ + gq[i]); sk[i] = *(const v4u*)(pb_ + O_K * 2 + gq[i]); } \
        _Pragma("unroll") for (int i = 0; i < 2; ++i) sv[i] = *(const v4u*)(pv_ + gv[i]); } while (0)
    RLOAD(0);
    const int nv = wid & 3, mk0 = 4 * (wid >> 2), mt = wid >> 2;
    if (tid < 256) { const int blk = tid >> 7, e = tid & 127, t = 32 * blk + (e >> 3), s0 = 32 * blk + 16 + 2 * (e & 7); *(LAS unsigned*)(L + OFF_P + t * PP + s0 * 2) = 0u; }
    for (int cidx = 0; cidx < NCH; ++cidx) {
        int lane = lane0; asm volatile("" : "+v"(lane));
        const int r32 = lane & 31, hi = lane >> 5;
#pragma unroll
        for (int i = 0; i < 4; ++i) { *(LAS v4u*)(L + lq + i * 16 * QP) = sq[i]; *(LAS v4u*)(L + lk + i * 4096) = sk[i]; }
#pragma unroll
        for (int i = 0; i < 2; ++i) { v4u o;
#pragma unroll
            for (int e = 0; e < 4; ++e) o[e] = pk2(bflo(sv[i][e]) * vw[i], bfhi(sv[i][e]) * vw[i]);
            *(LAS v4u*)(L + lv + i * 8192) = o; }
        if (cidx + 1 < NCH) RLOAD(cidx + 1);
        __syncthreads();
        {
#pragma unroll
            for (int rep = 0; rep < 2; ++rep) { const int tl = wid + 8 * rep;
                if (tl < 10) { const int mi = tl >= 6 ? 3 : (tl >= 3 ? 2 : (tl >= 1 ? 1 : 0)), ni = tl - (mi * (mi + 1)) / 2; f32x4 acc = {0.f, 0.f, 0.f, 0.f};
                    const unsigned qa = OFF_Q + (mi * 16 + (lane & 15)) * QP + (lane >> 4) * 16;
                    const unsigned krow = ni * 16 + (lane & 15), ksw = ((krow & 3u) << 2) | ((krow >> 2) & 3u), kb = OFF_K + 256u * krow;
#pragma unroll
                    for (int ks = 0; ks < 8; ++ks) { const bf16x8 a = *(const LAS bf16x8*)(L + qa + ks * 64);
                        const bf16x8 bfr = *(const LAS bf16x8*)(L + kb + (ks >> 2) * 16384 + 16u * ((unsigned)(4 * (ks & 3) + (lane >> 4)) ^ ksw)); acc = MFMA16(a, bfr, acc); }
                    const int tq = 4 * (lane >> 4), sc = lane & 15;
#pragma unroll
                    for (int r = 0; r < 4; ++r) { const float v = (mi != ni || tq + r >= sc) ? acc[r] : 0.f;
                        *(LAS bf16*)(L + OFF_P + (mi * 16 + tq + r) * PP + (ni * 16 + sc) * 2) = (bf16)f2bf(v); } } }
            const unsigned sbw = OFF_SB + (32 * nv + r32) * SBP + 8 * hi;
#pragma unroll
            for (int i = 0; i < 4; ++i) {
#pragma unroll
                for (int r = 0; r < 16; ++r) accS[i][r] *= g64;
#pragma unroll
                for (int g = 0; g < 4; ++g) { v2u w; w.x = pk2(accS[i][4 * g], accS[i][4 * g + 1]); w.y = pk2(accS[i][4 * g + 2], accS[i][4 * g + 3]);
                    *(LAS v2u*)(L + sbw + (mk0 + i) * 64 + g * 16) = w; } } }
        __syncthreads();
        {
            const unsigned lbase = (unsigned)(uintptr_t)L;
            const unsigned q4 = (lane & 15) >> 2, p4 = lane & 3, blk = (lane >> 4) & 1;
            unsigned vbase[2], kbase[4][2];
#pragma unroll
            for (int t = 0; t < 2; ++t) { const unsigned row = 8 * hi + 4 * t + q4, sw = (q4 << 2) | ((2 * hi + t) & 3u);
                vbase[t] = lbase + OFF_V + 256u * row + 16u * ((unsigned)(4 * nv + 2 * blk + (p4 >> 1)) ^ sw) + 8 * (p4 & 1);
#pragma unroll
                for (int c = 0; c < 4; ++c) kbase[c][t] = lbase + OFF_K + (mk0 >> 2) * 16384 + 256u * row + 16u * ((unsigned)(4 * c + 2 * blk + (p4 >> 1)) ^ sw) + 8 * (p4 & 1); }
            s16x4 vf[4][2];
            vf[0][0] = tr_off<0>(vbase[0]); vf[0][1] = tr_off<0>(vbase[1]); vf[1][0] = tr_off<4096>(vbase[0]); vf[1][1] = tr_off<4096>(vbase[1]);
            vf[2][0] = tr_off<8192>(vbase[0]); vf[2][1] = tr_off<8192>(vbase[1]); vf[3][0] = tr_off<12288>(vbase[0]); vf[3][1] = tr_off<12288>(vbase[1]);
            LDS_WAIT_PIN();
            f32x16 accO;
#pragma unroll
            for (int r = 0; r < 16; ++r) accO[r] = 0.f;
            const unsigned pa = OFF_P + (32 * mt + r32) * PP + 16 * hi, qa = OFF_Q + (32 * mt + r32) * QP + 16 * hi, sa = OFF_SB + (32 * nv + r32) * SBP + 16 * hi;
#pragma unroll
            for (int ks = 0; ks < 4; ++ks) { if (ks < 2 || mt == 1) { const bf16x8 pf = *(const LAS bf16x8*)(L + pa + ks * 32); accO = MFMA32(pf, CAT8(vf[ks][0], vf[ks][1]), accO); } }
#pragma unroll
            for (int kg = 0; kg < 4; ++kg) {
#pragma unroll
                for (int kk = 0; kk < 4; ++kk) { const int ks = 4 * kg + kk;
                    const bf16x8 qf = *(const LAS bf16x8*)(L + qa + ks * 32); const bf16x8 sf = *(const LAS bf16x8*)(L + sa + ks * 32); accO = MFMA32(qf, sf, accO); }
                asm volatile("" ::: "memory"); }
            { bf16* ob = OUT + (size_t)ROWLO(cidx) * 8192 + h * 512 + vs * 128 + 32 * nv;
              const int tl0 = 32 * mt + 4 * hi; const unsigned o0 = (unsigned)(((dir ? 63 - tl0 : tl0) * 8192 + r32) * 2); const int sgn = dir ? -16384 : 16384;
#pragma unroll
              for (int r = 0; r < 16; ++r) *(bf16*)((char*)ob + (o0 + (unsigned)(sgn * ((r & 3) + 8 * (r >> 2))))) = (bf16)f2bf(accO[r]); }
#pragma unroll
            for (int i = 0; i < 4; ++i) { s16x4 kf[4][2];
                kf[0][0] = tr_off<0>(kbase[i][0]); kf[0][1] = tr_off<0>(kbase[i][1]); kf[1][0] = tr_off<4096>(kbase[i][0]); kf[1][1] = tr_off<4096>(kbase[i][1]);
                kf[2][0] = tr_off<8192>(kbase[i][0]); kf[2][1] = tr_off<8192>(kbase[i][1]); kf[3][0] = tr_off<12288>(kbase[i][0]); kf[3][1] = tr_off<12288>(kbase[i][1]);
                LDS_WAIT_PIN();
#pragma unroll
                for (int ks = 0; ks < 4; ++ks) accS[i] = MFMA32(CAT8(kf[ks][0], kf[ks][1]), CAT8(vf[ks][0], vf[ks][1]), accS[i]); }
        }
        __syncthreads();
    }
#undef RLOAD
#undef ROWLO
}
}
#ifndef MK_MULTI
#define MK_MULTI 0
#endif
constexpr int N_PHASES = 2 + 2 * 14;
struct Args { const float* in[20]; float* out; unsigned char* ws; int ph_lo, ph_hi; };
__global__ void __launch_bounds__(NWAVES * 64, 2) fwd_kernel(Args args) {
    extern __shared__ __attribute__((aligned(16))) unsigned char lds_raw[];
    Frame F0;
    F0.lds = (LAS unsigned char*)lds_raw;
    F0.tid = threadIdx.x; F0.lane = F0.tid & 63; F0.wave = __builtin_amdgcn_readfirstlane(F0.tid >> 6);
    F0.G = gridDim.x; { const int bx = blockIdx.x; F0.vcu = (F0.G % 8 == 0) ? (bx % 8) * (F0.G / 8) + bx / 8 : bx; }
    F0.ws = args.ws; F0.out = args.out;
    LAS unsigned* MISC = (LAS unsigned*)(F0.lds + MISC_OFF);
    if (F0.tid < 16) MISC[F0.tid] = 0u;
    if (F0.tid < 20) { const unsigned long long pv = (unsigned long long)(uintptr_t)args.in[F0.tid]; MISC[16 + 2 * F0.tid] = (unsigned)pv; MISC[17 + 2 * F0.tid] = (unsigned)(pv >> 32); }
    __syncthreads();
    unsigned* ctl = (unsigned*)(F0.ws + WS_CTL);
    if (!MK_MULTI) (void)xcd_barrier_post(ctl + CW_BAR, (volatile LAS unsigned*)(MISC + 8));
#define GRID_BAR() do { XcdBarrier b_; b_.bar = (unsigned*)(F0.ws + WS_CTL) + CW_BAR; b_.x = xb_xcc_id(); b_.st = (volatile LAS unsigned*)(F0.lds + MISC_OFF + 32); xcd_barrier(b_); } while (0)
    const int lo = args.ph_lo, hi = args.ph_hi;
    int ph = 0;
#ifndef PHASE_MASK
#define PHASE_MASK 0xFFFFFFFFu
#endif
#ifndef RT_REPS
#define RT_REPS 1
#endif
#ifndef REP_MASK
#define REP_MASK 0u
#endif
#define PH_BEGIN(kind) if ((((PHASE_MASK) >> (kind)) & 1u) && lo <= ph && ph < hi) for (int rep_ = 0; rep_ < ((((REP_MASK) >> (kind)) & 1u) ? 2 : 1); ++rep_) { if (rep_) __syncthreads(); Frame F = F0; { int t_ = F0.tid; asm volatile("" : "+v"(t_)); F.tid = t_; F.lane = t_ & 63; F.wave = __builtin_amdgcn_readfirstlane(t_ >> 6); } LOADPTRS(F);
#define PH_END   } if (!MK_MULTI && lo <= ph && ph + 1 < hi) GRID_BAR(); ++ph;
#define PH_END_NOBAR }

    PH_BEGIN(0) ph_prologue(F); PH_END
    PH_BEGIN(1) ph_finalize(F); PH_END
    float* XS = (float*)(F0.ws + WS_XS);
    { constexpr int L2 = 0;
        { const int l = 2 * L2, i = L2;
          const bool first = (L2 == 0);
          PH_BEGIN(2) ph_ada_in(F, l, first ? F.x : XS, first ? F.ctx : XS + (size_t)M_LAT * DM); PH_END
          PH_BEGIN(3) { pg8::Gemm g{WSP(pg8::bf16_t, WS_H), WSP(pg8::bf16_t, WS_WINE) + (size_t)i * E_PAD * DM, MT, E_PAD, DM}; pg8::StaticOrder S; S.init(MT, E_PAD, F.G, (int)blockIdx.x);
                     pg8::EpiBf16 E{WSP(pg8::bf16_t, WS_P), E_PAD}; pg8::gemm_phase<pg8::EpiBf16, pg8::StaticOrder, PG8_ALIGN, PG8_SP2>(F.lds, g, S, E); } PH_END
          PH_BEGIN(4) ph_lora_norm(F, i); PH_END
          PH_BEGIN(5) { { pg8::Gemm g{WSP(pg8::bf16_t, WS_CQN), WSP(pg8::bf16_t, WS_WUQ) + (size_t)i * NQ * Q_LORA, MT, NQ, Q_LORA}; pg8::StaticOrder S; S.init(MT, NQ, F.G, (int)blockIdx.x);
                       pg8::EpiBf16 E{WSP(pg8::bf16_t, WS_QF), NQ}; pg8::gemm_phase<pg8::EpiBf16, pg8::StaticOrder, PG8_ALIGN, PG8_SP2>(F.lds, g, S, E); } __syncthreads(); } PH_END_NOBAR
          PH_BEGIN(16) { { pg8::Gemm g{WSP(pg8::bf16_t, WS_CKVN), WSP(pg8::bf16_t, WS_WUKV) + (size_t)i * NKV * KV_LORA, MT, NKV, KV_LORA}; pg8::StaticOrder S; S.init(MT, NKV, F.G, (int)blockIdx.x);
                       pg8::EpiBf16 E{WSP(pg8::bf16_t, WS_KV), NKV}; pg8::gemm_phase<pg8::EpiBf16, pg8::StaticOrder, PG8_ALIGN, PG8_SP2>(F.lds, g, S, E); } } PH_END
          PH_BEGIN(6) ph_qk_norm_rope(F, i); PH_END
          PH_BEGIN(17) { for (int s = 0; s < 128; ++s) if ((64 + s) % F.G == F.vcu) { hg::unit(F, i, s >> 5, (s >> 1) & 15, s & 1); __syncthreads(); } } PH_END_NOBAR
          PH_BEGIN(7) {
#ifndef NO_ATT
              for (int u = F.vcu; u < 1088; u += F.G) {
                  if (u < 1024) { const int b = u >> 8, h = (u >> 4) & 15, qb = u & 15; att::unit(F, h, b * SEQ + qb * 256, b * SEQ, 64, M_LAT + b * CTXL, 68, E_PAD); }
                  else { const int v = u - 1024, b = v >> 4, h = v & 15; att::unit(F, h, M_LAT + b * CTXL, 0, 0, M_LAT + b * CTXL, 4, E_PAD); } }
#endif
              } PH_END
          PH_BEGIN(8) ph_hg_merge(F, i); PH_END
          PH_BEGIN(9) { pg8::Gemm g{WSP(pg8::bf16_t, WS_A), WSP(pg8::bf16_t, WS_WOE) + (size_t)i * DM * DM, MT, DM, DM}; pg8::StaticOrder S; S.init(MT, DM, F.G, (int)blockIdx.x);
                     pg8::EpiRes E{first ? F.x : XS, first ? F.ctx : XS + (size_t)M_LAT * DM, XS, XS + (size_t)M_LAT * DM, WSP(float, WS_MOD) + (size_t)l * 5 * MODW + 2 * DM};
                     pg8::gemm_phase<pg8::EpiRes, pg8::StaticOrder, PG8_ALIGN, PG8_SP2>(F.lds, g, S, E); } PH_END
        }
        { const int l = 2 * L2 + 1, i = L2; const bool last = (L2 == 1);
          PH_BEGIN(10) ph_ada_in(F, l, XS, XS + (size_t)M_LAT * DM); PH_END
          PH_BEGIN(11) { pg8::Gemm g{WSP(pg8::bf16_t, WS_H), WSP(pg8::bf16_t, WS_WINO) + (size_t)i * O_END * DM, MT, O_END, DM}; pg8::StaticOrder S; S.init(MT, O_END, F.G, (int)blockIdx.x);
                     pg8::EpiBf16 E{WSP(pg8::bf16_t, WS_P), O_END}; pg8::gemm_phase<pg8::EpiBf16, pg8::StaticOrder, PG8_ALIGN, PG8_SP2>(F.lds, g, S, E); } PH_END
          PH_BEGIN(12) ph_ret_rope(F); PH_END
          PH_BEGIN(13) { for (int u0 = F.vcu; u0 < 512 * RT_REPS; u0 += F.G) { const int u = u0 & 511; rt::unit(F, i, u >> 7, (u >> 3) & 15, (u >> 2) & 1, u & 3); __syncthreads(); } } PH_END
          PH_BEGIN(14) ph_ret_merge(F, i); PH_END
          PH_BEGIN(15) { const int M = last ? M_LAT : MT; pg8::Gemm g{WSP(pg8::bf16_t, WS_A), WSP(pg8::bf16_t, WS_WOO) + (size_t)i * DM * 8192, M, DM, 8192}; pg8::StaticOrder S; S.init(M, DM, F.G, (int)blockIdx.x);
                     pg8::EpiRes E{XS, XS + (size_t)M_LAT * DM, last ? F.out : XS, XS + (size_t)M_LAT * DM, WSP(float, WS_MOD) + (size_t)l * 5 * MODW + 2 * DM};
                     pg8::gemm_phase<pg8::EpiRes, pg8::StaticOrder, PG8_ALIGN, PG8_SP2>(F.lds, g, S, E); } PH_END
        }
    }
    { constexpr int L2 = 1;
        { const int l = 2 * L2, i = L2;
          const bool first = (L2 == 0);
          PH_BEGIN(2) ph_ada_in(F, l, first ? F.x : XS, first ? F.ctx : XS + (size_t)M_LAT * DM); PH_END
          PH_BEGIN(3) { pg8::Gemm g{WSP(pg8::bf16_t, WS_H), WSP(pg8::bf16_t, WS_WINE) + (size_t)i * E_PAD * DM, MT, E_PAD, DM}; pg8::StaticOrder S; S.init(MT, E_PAD, F.G, (int)blockIdx.x);
                     pg8::EpiBf16 E{WSP(pg8::bf16_t, WS_P), E_PAD}; pg8::gemm_phase<pg8::EpiBf16, pg8::StaticOrder, PG8_ALIGN, PG8_SP2>(F.lds, g, S, E); } PH_END
          PH_BEGIN(4) ph_lora_norm(F, i); PH_END
          PH_BEGIN(5) { { pg8::Gemm g{WSP(pg8::bf16_t, WS_CQN), WSP(pg8::bf16_t, WS_WUQ) + (size_t)i * NQ * Q_LORA, MT, NQ, Q_LORA}; pg8::StaticOrder S; S.init(MT, NQ, F.G, (int)blockIdx.x);
                       pg8::EpiBf16 E{WSP(pg8::bf16_t, WS_QF), NQ}; pg8::gemm_phase<pg8::EpiBf16, pg8::StaticOrder, PG8_ALIGN, PG8_SP2>(F.lds, g, S, E); } __syncthreads(); } PH_END_NOBAR
          PH_BEGIN(16) { { pg8::Gemm g{WSP(pg8::bf16_t, WS_CKVN), WSP(pg8::bf16_t, WS_WUKV) + (size_t)i * NKV * KV_LORA, MT, NKV, KV_LORA}; pg8::StaticOrder S; S.init(MT, NKV, F.G, (int)blockIdx.x);
                       pg8::EpiBf16 E{WSP(pg8::bf16_t, WS_KV), NKV}; pg8::gemm_phase<pg8::EpiBf16, pg8::StaticOrder, PG8_ALIGN, PG8_SP2>(F.lds, g, S, E); } } PH_END
          PH_BEGIN(6) ph_qk_norm_rope(F, i); PH_END
          PH_BEGIN(17) { for (int s = 0; s < 128; ++s) if ((64 + s) % F.G == F.vcu) { hg::unit(F, i, s >> 5, (s >> 1) & 15, s & 1); __syncthreads(); } } PH_END_NOBAR
          PH_BEGIN(7) {
#ifndef NO_ATT
              for (int u = F.vcu; u < 1088; u += F.G) {
                  if (u < 1024) { const int b = u >> 8, h = (u >> 4) & 15, qb = u & 15; att::unit(F, h, b * SEQ + qb * 256, b * SEQ, 64, M_LAT + b * CTXL, 68, E_PAD); }
                  else { const int v = u - 1024, b = v >> 4, h = v & 15; att::unit(F, h, M_LAT + b * CTXL, 0, 0, M_LAT + b * CTXL, 4, E_PAD); } }
#endif
              } PH_END
          PH_BEGIN(8) ph_hg_merge(F, i); PH_END
          PH_BEGIN(9) { pg8::Gemm g{WSP(pg8::bf16_t, WS_A), WSP(pg8::bf16_t, WS_WOE) + (size_t)i * DM * DM, MT, DM, DM}; pg8::StaticOrder S; S.init(MT, DM, F.G, (int)blockIdx.x);
                     pg8::EpiRes E{first ? F.x : XS, first ? F.ctx : XS + (size_t)M_LAT * DM, XS, XS + (size_t)M_LAT * DM, WSP(float, WS_MOD) + (size_t)l * 5 * MODW + 2 * DM};
                     pg8::gemm_phase<pg8::EpiRes, pg8::StaticOrder, PG8_ALIGN, PG8_SP2>(F.lds, g, S, E); } PH_END
        }
        { const int l = 2 * L2 + 1, i = L2; const bool last = (L2 == 1);
          PH_BEGIN(10) ph_ada_in(F, l, XS, XS + (size_t)M_LAT * DM); PH_END
          PH_BEGIN(11) { pg8::Gemm g{WSP(pg8::bf16_t, WS_H), WSP(pg8::bf16_t, WS_WINO) + (size_t)i * O_END * DM, MT, O_END, DM}; pg8::StaticOrder S; S.init(MT, O_END, F.G, (int)blockIdx.x);
                     pg8::EpiBf16 E{WSP(pg8::bf16_t, WS_P), O_END}; pg8::gemm_phase<pg8::EpiBf16, pg8::StaticOrder, PG8_ALIGN, PG8_SP2>(F.lds, g, S, E); } PH_END
          PH_BEGIN(12) ph_ret_rope(F); PH_END
          PH_BEGIN(13) { for (int u0 = F.vcu; u0 < 512 * RT_REPS; u0 += F.G) { const int u = u0 & 511; rt::unit(F, i, u >> 7, (u >> 3) & 15, (u >> 2) & 1, u & 3); __syncthreads(); } } PH_END
          PH_BEGIN(14) ph_ret_merge(F, i); PH_END
          PH_BEGIN(15) { const int M = last ? M_LAT : MT; pg8::Gemm g{WSP(pg8::bf16_t, WS_A), WSP(pg8::bf16_t, WS_WOO) + (size_t)i * DM * 8192, M, DM, 8192}; pg8::StaticOrder S; S.init(M, DM, F.G, (int)blockIdx.x);
                     pg8::EpiRes E{XS, XS + (size_t)M_LAT * DM, last ? F.out : XS, XS + (size_t)M_LAT * DM, WSP(float, WS_MOD) + (size_t)l * 5 * MODW + 2 * DM};
                     pg8::gemm_phase<pg8::EpiRes, pg8::StaticOrder, PG8_ALIGN, PG8_SP2>(F.lds, g, S, E); } PH_END
        }
    }
#undef PH_BEGIN
#undef PH_END
}

extern "C" void kernel_launch(void* const* d_in, const int* in_sizes, int n_in, void* d_out, int out_size, void* d_ws, size_t ws_size, hipStream_t stream) {
    static int grid = 0;
    if (grid == 0) {
        if (n_in != 20 || in_sizes[0] != M_LAT * DM || out_size != M_LAT * DM || ws_size < WS_END) {
            fprintf(stderr, "kernel_launch: shape mismatch (n_in %d, in0 %d, out %d, ws %zu need %zu); nothing launched\n", n_in, n_in > 0 ? in_sizes[0] : -1, out_size, ws_size, (size_t)WS_END); grid = -1; return; }
        int dev = 0, cus = 0, per_cu = 0;
        if (hipGetDevice(&dev) != hipSuccess || hipDeviceGetAttribute(&cus, hipDeviceAttributeMultiprocessorCount, dev) != hipSuccess) { grid = -1; return; }
        if (hipFuncSetAttribute((const void*)fwd_kernel, hipFuncAttributeMaxDynamicSharedMemorySize, LDS_BYTES) != hipSuccess) { fprintf(stderr, "kernel_launch: hipFuncSetAttribute failed\n"); grid = -1; return; }
        if (hipOccupancyMaxActiveBlocksPerMultiprocessor(&per_cu, (const void*)fwd_kernel, NWAVES * 64, LDS_BYTES) != hipSuccess || per_cu < 1) { fprintf(stderr, "kernel_launch: occupancy query says %d\n", per_cu); }
        (void)hipGetLastError();
        grid = cus;
    }
    if (grid < 0) return;
    if (hipMemsetAsync((char*)d_ws + WS_CTL, 0, CTL_ZERO_BYTES, stream) != hipSuccess) return;
    Args a{};
    for (int i = 0; i < 20; ++i) a.in[i] = (const float*)d_in[i];
    a.out = (float*)d_out; a.ws = (unsigned char*)d_ws;
#if MK_MULTI
#ifndef DBG_HI
#define DBG_HI N_PHASES
#endif
#ifndef DBG_LO
#define DBG_LO 0
#endif
    for (int p = DBG_LO; p < DBG_HI; ++p) { a.ph_lo = p; a.ph_hi = p + 1; hipLaunchKernelGGL(fwd_kernel, dim3(grid), dim3(NWAVES * 64), LDS_BYTES, stream, a); }
#else
    a.ph_lo = 0; a.ph_hi = N_PHASES; hipLaunchKernelGGL(fwd_kernel, dim3(grid), dim3(NWAVES * 64), LDS_BYTES, stream, a);
#endif
    const hipError_t le = hipPeekAtLastError();
    if (le != hipSuccess) fprintf(stderr, "kernel_launch: launch failed: %s\n", hipGetErrorName(le));
}
```

```cpp
#include <hip/hip_runtime.h>
#include <cstdio>
#include <cstdint>
namespace pg8 {
#define PG8_LAS __attribute__((address_space(3)))
typedef unsigned short bf16_t;
typedef short bf16x8 __attribute__((ext_vector_type(8)));
typedef float f32x4 __attribute__((ext_vector_type(4)));
typedef unsigned u32x4 __attribute__((ext_vector_type(4)));
constexpr int BM = 256, BK = 64, HALF = 128, HTB = HALF * BK * 2  , STAGE_BYTES = 8 * HTB, NXCD = 8, WGM = 8;

__host__ __device__ __forceinline__ int lds_byte(int r, int c) { const int st = (r >> 4) * 2 + (c >> 5), rr = r & 15, cc = c & 31, ob = rr * 64 + cc * 2; return st * 1024 + (ob ^ (((ob >> 9) & 1) << 5)); }
__host__ __device__ __forceinline__ void stage_rc(int b, int& R, int& C) { const int st = b / 1024, sb = b % 1024, swz = sb ^ (((sb >> 9) & 1) << 5); R = (st >> 1) * 16 + swz / 64; C = (st & 1) * 32 + (swz % 64) / 2; }
__host__ __device__ __forceinline__ int perm32(int rho) { const int n = rho >> 4, i = rho & 15; return 8 * (i >> 2) + 4 * n + (i & 3); }

struct Unit { int pm, pn; };
struct Gemm { const bf16_t* A; const bf16_t* Bt; int M, N, K; };

struct StaticOrder {
    int nM, nN, nwg, G, c;
    __host__ __device__ void init(int M, int N, int G_, int c_) { nM = M / BM; nN = N / BM; nwg = nM * nN; G = G_; c = c_; }
    __host__ __device__ bool next(int i, Unit& u) const {
        const long L = (long)i * G + c; if (L >= nwg) return false;
        int wgid = (int)L; { const int q = nwg / NXCD, r = nwg % NXCD, xcd = wgid % NXCD, off = wgid / NXCD; wgid = (xcd < r ? xcd * (q + 1) : r * (q + 1) + (xcd - r) * q) + off; }
        const int nig = WGM * nN, gid = wgid / nig, fm = gid * WGM, gsz = (nM - fm) < WGM ? (nM - fm) : WGM;
        u.pm = fm + ((wgid % nig) % gsz); u.pn = (wgid % nig) / gsz; return true;
    }
    __device__ __forceinline__ void a_ready(const Unit&) const {}
    __device__ __forceinline__ void done(const Unit&) const {}
};
__device__ __forceinline__ unsigned cvt_pk_bf16(float lo, float hi) { unsigned r; asm volatile("v_cvt_pk_bf16_f32 %0, %1, %2" : "=v"(r) : "v"(lo), "v"(hi)); return r; }
struct EpiBf16 {
    static constexpr bool PERM = true, AFTER_DRAIN = false;
    bf16_t* O; int ldc;
    __device__ __forceinline__ void operator()(const f32x4 (&acc)[2][2][4][2], const Unit& u, int wr, int wc, int fr, int fq) const {
        const int row0 = u.pm * BM + wr * 64 + fr; const int col0 = u.pn * BM + wc * 32 + 8 * fq;
#pragma unroll
        for (int ai = 0; ai < 2; ++ai)
#pragma unroll
            for (int m = 0; m < 4; ++m) { bf16_t* rowp = O + (size_t)(row0 + ai * HALF + m * 16) * ldc + col0;
#pragma unroll
                for (int bj = 0; bj < 2; ++bj) { const f32x4 v0 = acc[ai][bj][m][0], v1 = acc[ai][bj][m][1];
                    u32x4 w; w.x = cvt_pk_bf16(v0[0], v0[1]); w.y = cvt_pk_bf16(v0[2], v0[3]); w.z = cvt_pk_bf16(v1[0], v1[1]); w.w = cvt_pk_bf16(v1[2], v1[3]);
                    *(u32x4*)(rowp + bj * HALF) = w; } }
    }
};
struct EpiRes {
    static constexpr bool PERM = false, AFTER_DRAIN = false;
    const float* res_lat; const float* res_ctx; float* out_lat; float* out_ctx; const float* gate_base;
    __device__ __forceinline__ void operator()(const f32x4 (&acc)[2][2][4][2], const Unit& u, int wr, int wc, int fr, int fq) const {
        const bool isctx = u.pm >= 64; const int seg = isctx ? 4 : (u.pm >> 4);
        const int lrow0 = (isctx ? (u.pm - 64) : u.pm) * BM + wr * 64 + fr, col0 = u.pn * BM + wc * 32 + 4 * fq;
        const float* res = isctx ? res_ctx : res_lat; float* out = isctx ? out_ctx : out_lat; const float* gate = gate_base + (size_t)seg * 12288;
        f32x4 gv[2][2];
#pragma unroll
        for (int bj = 0; bj < 2; ++bj)
#pragma unroll
            for (int n = 0; n < 2; ++n) gv[bj][n] = *(const f32x4*)(gate + col0 + bj * HALF + n * 16);
#pragma unroll
        for (int ai = 0; ai < 2; ++ai)
#pragma unroll
            for (int m = 0; m < 4; ++m) { const size_t off = (size_t)(lrow0 + ai * HALF + m * 16) * 4096 + col0;
#pragma unroll
                for (int bj = 0; bj < 2; ++bj)
#pragma unroll
                    for (int n = 0; n < 2; ++n) { const f32x4 r = *(const f32x4*)(res + off + bj * HALF + n * 16);
                        *(f32x4*)(out + off + bj * HALF + n * 16) = r + gv[bj][n] * acc[ai][bj][m][n]; }
                asm volatile("" ::: "memory"); }
    }
};

template <class Epi, class Sched, bool ALIGN_EPI = false, bool SP2 = false>
__device__ __forceinline__ void gemm_phase(PG8_LAS unsigned char* lds, const Gemm g, const Sched& S, const Epi& E) {
    int tid = threadIdx.x; asm volatile("" : "+v"(tid));
    const int wid = __builtin_amdgcn_readfirstlane(tid >> 6), lane = tid & 63, wr = wid >> 2, wc = wid & 3, fr = lane & 15, fq = lane >> 4;
    const int K = g.K, nt = K / BK;
    unsigned voffA[2], voffB[2];
#pragma unroll
    for (int i = 0; i < 2; ++i) { int R, C; stage_rc(tid * 16 + i * 8192, R, C); const int Rb = Epi::PERM ? ((R & ~31) + perm32(R & 31)) : R;
        voffA[i] = (unsigned)(R * K + C) * 2u; voffB[i] = (unsigned)(Rb * K + C) * 2u; }
    const size_t kstep = (size_t)(BK * 2);
    const size_t hstep = (size_t)HALF * K * 2;
    const size_t tstep = 2 * hstep;
    const unsigned ldsw = (unsigned)wid * 1024u;
    const int aoff = lds_byte(wr * 64 + fr, fq * 8), boff = lds_byte(wc * 32 + fr, fq * 8);
#define PG8_SA(b, h) (((b) * 2 + (h)) * HTB)
#define PG8_SB(b, h) ((4 + (b) * 2 + (h)) * HTB)
#define PG8_STAGE(bufoff, gbase, voff) do { _Pragma("unroll") for (int _i = 0; _i < 2; ++_i) \
        __builtin_amdgcn_global_load_lds((const unsigned*)((const char*)(gbase) + (voff)[_i]), (PG8_LAS unsigned*)(lds + (bufoff) + ldsw + _i * 8192), 16, 0, 0); } while (0)
#define PG8_LDA(dst, b, h) do { _Pragma("unroll") for (int m = 0; m < 4; ++m) _Pragma("unroll") for (int k = 0; k < 2; ++k) dst[m][k] = *(const PG8_LAS bf16x8*)(lds + PG8_SA(b, h) + aoff + m * 2048 + k * 1024); } while (0)
#define PG8_LDB(dst, b, h) do { _Pragma("unroll") for (int n = 0; n < 2; ++n) _Pragma("unroll") for (int k = 0; k < 2; ++k) dst[n][k] = *(const PG8_LAS bf16x8*)(lds + PG8_SB(b, h) + boff + n * 2048 + k * 1024); } while (0)
#define PG8_MMA(ai, bj, At, Bt) do { __builtin_amdgcn_s_setprio(1); _Pragma("unroll") for (int m = 0; m < 4; ++m) _Pragma("unroll") for (int n = 0; n < 2; ++n) _Pragma("unroll") for (int k = 0; k < 2; ++k) \
        acc[ai][bj][m][n] = __builtin_amdgcn_mfma_f32_16x16x32_bf16(Bt[n][k], At[m][k], acc[ai][bj][m][n], 0, 0, 0); __builtin_amdgcn_s_setprio(0); } while (0)
#define PG8_WAIT_V(n) asm volatile("s_waitcnt vmcnt(" #n ")" ::: "memory")
#define PG8_WAIT_L(n) asm volatile("s_waitcnt lgkmcnt(" #n ")" ::: "memory")
#define PG8_BAR __builtin_amdgcn_s_barrier()
#define PG8_SCHED __builtin_amdgcn_sched_barrier(0)
    Unit cur, nxt; int ui = 0;
    if (!S.next(0, cur)) return;
    f32x4 acc[2][2][4][2];
#pragma unroll
    for (int a = 0; a < 2; ++a)
#pragma unroll
        for (int b = 0; b < 2; ++b)
#pragma unroll
            for (int m = 0; m < 4; ++m)
#pragma unroll
                for (int n = 0; n < 2; ++n) acc[a][b][m][n] = (f32x4){0.f, 0.f, 0.f, 0.f};
    bf16x8 At[4][2], B0[2][2], B1[2][2];
    const char* cA = (const char*)g.A + (size_t)cur.pm * tstep; const char* cB = (const char*)g.Bt + (size_t)cur.pn * tstep;
    S.a_ready(cur);
    if constexpr (SP2) {
        PG8_STAGE(PG8_SB(0, 0), cB, voffB); PG8_STAGE(PG8_SB(0, 1), cB + hstep, voffB); PG8_STAGE(PG8_SA(0, 0), cA, voffA); PG8_STAGE(PG8_SA(0, 1), cA + hstep, voffA);
        if (wr == 1) PG8_BAR;
        PG8_WAIT_V(2); PG8_BAR;
        PG8_STAGE(PG8_SB(1, 0), cB + kstep, voffB); PG8_STAGE(PG8_SA(1, 0), cA + kstep, voffA); PG8_STAGE(PG8_SB(1, 1), cB + hstep + kstep, voffB);
        PG8_WAIT_V(6); PG8_BAR;
    } else {
        PG8_STAGE(PG8_SB(0, 0), cB, voffB); PG8_STAGE(PG8_SA(0, 0), cA, voffA); PG8_STAGE(PG8_SB(0, 1), cB + hstep, voffB); PG8_STAGE(PG8_SA(0, 1), cA + hstep, voffA);
        if (wr == 1) PG8_BAR;
        PG8_WAIT_V(4); PG8_BAR;
        PG8_STAGE(PG8_SB(1, 0), cB + kstep, voffB); PG8_STAGE(PG8_SA(1, 0), cA + kstep, voffA); PG8_STAGE(PG8_SB(1, 1), cB + hstep + kstep, voffB);
        PG8_WAIT_V(6); PG8_BAR;
    }
    for (;;) {
        const bool has_next = S.next(ui + 1, nxt);
        const char* nA = has_next ? (const char*)g.A + (size_t)nxt.pm * tstep : cA; const char* nB = has_next ? (const char*)g.Bt + (size_t)nxt.pn * tstep : cB;
        for (int t = 0; t < nt; t += 2) {
            const bool last = (t == nt - 2);
            const char* a1 = cA + (size_t)(t + 1) * kstep;
            const char* a2 = last ? nA : cA + (size_t)(t + 2) * kstep; const char* b2 = last ? nB : cB + (size_t)(t + 2) * kstep;
            const char* a3 = a2 + kstep; const char* b3 = b2 + kstep;
            if (last && has_next) S.a_ready(nxt);
            if constexpr (SP2) {
            PG8_LDB(B0, 0, 0); PG8_LDB(B1, 0, 1); PG8_SCHED; PG8_LDA(At, 0, 0); PG8_STAGE(PG8_SA(1, 1), a1 + hstep, voffA);
            PG8_WAIT_V(8); PG8_WAIT_L(0); PG8_BAR; PG8_MMA(0, 0, At, B0); PG8_MMA(0, 1, At, B1); PG8_BAR; PG8_SCHED;
            PG8_LDA(At, 0, 1); PG8_STAGE(PG8_SB(0, 0), b2, voffB); PG8_STAGE(PG8_SB(0, 1), b2 + hstep, voffB); PG8_STAGE(PG8_SA(0, 0), a2, voffA);
            PG8_WAIT_V(8); PG8_WAIT_L(0); PG8_BAR; PG8_MMA(1, 0, At, B0); PG8_MMA(1, 1, At, B1); PG8_BAR; PG8_SCHED;
            PG8_LDB(B0, 1, 0); PG8_LDB(B1, 1, 1); PG8_SCHED; PG8_LDA(At, 1, 0); PG8_STAGE(PG8_SA(0, 1), a2 + hstep, voffA);
            PG8_WAIT_V(8); PG8_WAIT_L(0); PG8_BAR; PG8_MMA(0, 0, At, B0); PG8_MMA(0, 1, At, B1); PG8_BAR; PG8_SCHED;
            PG8_LDA(At, 1, 1); PG8_STAGE(PG8_SB(1, 0), b3, voffB); PG8_STAGE(PG8_SB(1, 1), b3 + hstep, voffB); PG8_STAGE(PG8_SA(1, 0), a3, voffA);
            PG8_WAIT_V(8); PG8_WAIT_L(0); PG8_BAR; PG8_MMA(1, 0, At, B0); PG8_MMA(1, 1, At, B1); PG8_BAR; PG8_SCHED;
            } else {
            PG8_LDB(B0, 0, 0); PG8_SCHED; PG8_LDA(At, 0, 0); PG8_STAGE(PG8_SA(1, 1), a1 + hstep, voffA);
            PG8_WAIT_L(8); PG8_BAR; PG8_WAIT_L(0); PG8_MMA(0, 0, At, B0); PG8_BAR; PG8_SCHED;
            PG8_LDB(B1, 0, 1); PG8_STAGE(PG8_SB(0, 0), b2, voffB);
            PG8_BAR; PG8_WAIT_L(0); PG8_MMA(0, 1, At, B1); PG8_BAR;
            PG8_LDA(At, 0, 1); PG8_STAGE(PG8_SA(0, 0), a2, voffA);
            PG8_BAR; PG8_WAIT_L(0); PG8_MMA(1, 0, At, B0); PG8_BAR; PG8_SCHED;
            PG8_STAGE(PG8_SB(0, 1), b2 + hstep, voffB);
            PG8_WAIT_V(6); PG8_BAR; PG8_MMA(1, 1, At, B1); PG8_BAR;
            PG8_LDB(B0, 1, 0); PG8_SCHED; PG8_LDA(At, 1, 0); PG8_STAGE(PG8_SA(0, 1), a2 + hstep, voffA);
            PG8_WAIT_L(8); PG8_BAR; PG8_WAIT_L(0); PG8_MMA(0, 0, At, B0); PG8_BAR; PG8_SCHED;
            PG8_LDB(B1, 1, 1); PG8_STAGE(PG8_SB(1, 0), b3, voffB);
            PG8_BAR; PG8_WAIT_L(0); PG8_MMA(0, 1, At, B1); PG8_BAR;
            PG8_LDA(At, 1, 1); PG8_STAGE(PG8_SA(1, 0), a3, voffA);
            PG8_BAR; PG8_WAIT_L(0); PG8_MMA(1, 0, At, B0); PG8_BAR; PG8_SCHED;
            PG8_STAGE(PG8_SB(1, 1), b3 + hstep, voffB);
            PG8_WAIT_V(6); PG8_BAR; PG8_MMA(1, 1, At, B1); PG8_BAR;
            }
        }
        if constexpr (ALIGN_EPI) { if (wr == 0) PG8_BAR; }
        if constexpr (!Epi::AFTER_DRAIN) { E(acc, cur, wr, wc, fr, fq); S.done(cur); }
        if (!has_next) break;
#pragma unroll
        for (int a = 0; a < 2; ++a)
#pragma unroll
            for (int b = 0; b < 2; ++b)
#pragma unroll
                for (int m = 0; m < 4; ++m)
#pragma unroll
                    for (int n = 0; n < 2; ++n) acc[a][b][m][n] = (f32x4){0.f, 0.f, 0.f, 0.f};
        cur = nxt; cA = nA; cB = nB; ++ui;
        if constexpr (ALIGN_EPI) { if (wr == 1) PG8_BAR; }
    }
    PG8_WAIT_V(0);
    if constexpr (!ALIGN_EPI) { if (wr == 0) PG8_BAR; }
    PG8_BAR;
    if constexpr (Epi::AFTER_DRAIN) { E.fused(acc, cur, wr, wc, fr, fq, lds, wid, lane); S.done(cur); }
#undef PG8_SA
#undef PG8_SB
#undef PG8_STAGE
#undef PG8_LDA
#undef PG8_LDB
#undef PG8_MMA
#undef PG8_WAIT_V
#undef PG8_WAIT_L
#undef PG8_BAR
#undef PG8_SCHED
}
}
#ifndef PG8_SP2
#define PG8_SP2 true
#endif
#ifndef PG8_ALIGN
#define PG8_ALIGN true
#endif
constexpr int NWAVES = 8;
constexpr int DM = 4096, NB = 4, SEQ = 4096, CTXL = 256, DEPTH = 4;
constexpr int M_LAT = NB * SEQ, M_CTX = NB * CTXL, MT = M_LAT + M_CTX;
constexpr int HEADS = 16, QKD = 192, NOPE = 128, ROPED = 64, VDIM = 128, Q_LORA = 1536, KV_LORA = 512;
constexpr int E_CQ = 0, E_CKV = 1536, E_KPE = 2048, E_GM = 2112, E_QH = 4160, E_FF = 6208, E_FB = 8256, E_IH = 10304, E_GH = 12352, E_END = 14400, E_PAD = 14592;
constexpr int O_Q = 0, O_K = 4096, O_V = 8192, O_G = 16384, O_END = 24576;
constexpr int NQ = HEADS * QKD, NKV = HEADS * 256;
constexpr float EPS = 1e-6f;
constexpr int MODW = 3 * DM;
constexpr int KCH = 32;
constexpr size_t al256(size_t x) { return (x + 255) / 256 * 256; }
constexpr size_t WS_CTL = 0, CTL_ZERO_BYTES = 1u << 20;
constexpr size_t WS_MODP = CTL_ZERO_BYTES;
constexpr size_t WS_MOD  = WS_MODP + al256((size_t)KCH * 4 * 5 * MODW * 4);
constexpr size_t WS_LB   = WS_MOD + al256((size_t)4 * 5 * MODW * 4);
constexpr size_t WS_WINE = WS_LB + al256((size_t)2 * 2 * 2048 * 4);
constexpr size_t WS_WUQ  = WS_WINE + (size_t)2 * E_PAD * DM * 2;
constexpr size_t WS_WUKV = WS_WUQ + (size_t)2 * NQ * Q_LORA * 2;
constexpr size_t WS_WOE  = WS_WUKV + (size_t)2 * NKV * KV_LORA * 2;
constexpr size_t WS_WINO = WS_WOE + (size_t)2 * DM * DM * 2;
constexpr size_t WS_WOO  = WS_WINO + (size_t)2 * O_END * DM * 2;
constexpr size_t WS_XS   = WS_WOO + (size_t)2 * DM * 8192 * 2;
constexpr size_t WS_H    = WS_XS + (size_t)MT * DM * 4;
constexpr size_t WS_P    = WS_H + (size_t)MT * DM * 2;
constexpr size_t WS_U    = WS_P + (size_t)MT * O_END * 2;
constexpr size_t WS_CQN  = WS_U;
constexpr size_t WS_CKVN = WS_CQN + (size_t)MT * Q_LORA * 2;
constexpr size_t WS_QF   = WS_CKVN + (size_t)MT * KV_LORA * 2;
constexpr size_t WS_KV   = WS_QF + (size_t)MT * NQ * 2;
constexpr size_t WS_KF   = WS_KV + (size_t)MT * NKV * 2;
constexpr size_t WS_OFE  = WS_KF + (size_t)MT * NQ * 2;
constexpr size_t WS_OBE  = WS_OFE + (size_t)MT * 2048 * 2;
constexpr size_t WS_UE_END = WS_OBE + (size_t)MT * 2048 * 2;
constexpr size_t WS_OFO  = WS_U;
constexpr size_t WS_OBO  = WS_OFO + (size_t)MT * 8192 * 2;
constexpr size_t WS_UO_END = WS_OBO + (size_t)MT * 8192 * 2;
constexpr size_t WS_A    = WS_UE_END > WS_UO_END ? WS_UE_END : WS_UO_END;
constexpr size_t WS_END  = WS_A + (size_t)MT * 8192 * 2;
constexpr int CW_BAR = 4096;
constexpr int LDS_BYTES = 163840 - 1024;
constexpr int MISC_OFF = LDS_BYTES - 256;
#define LAS __attribute__((address_space(3)))
typedef unsigned short bf16;
typedef unsigned v4u __attribute__((ext_vector_type(4)));
typedef unsigned v2u __attribute__((ext_vector_type(2)));
typedef float f32x4 __attribute__((ext_vector_type(4)));
typedef float f32x16 __attribute__((ext_vector_type(16)));
typedef short bf16x8 __attribute__((ext_vector_type(8)));
typedef short s16x4 __attribute__((ext_vector_type(4)));
#define DI __device__ __forceinline__
typedef __bf16 bf2_t __attribute__((ext_vector_type(2)));
typedef float f32x2_t __attribute__((ext_vector_type(2)));
DI unsigned pk2(float lo, float hi) { const f32x2_t v = {lo, hi}; return __builtin_bit_cast(unsigned, __builtin_convertvector(v, bf2_t)); }
DI unsigned f2bf(float f) { return (unsigned)__builtin_bit_cast(unsigned short, (__bf16)f); }
DI float bflo(unsigned w) { return __uint_as_float(w << 16); }
DI float bfhi(unsigned w) { return __uint_as_float(w & 0xffff0000u); }
DI float bf2f(bf16 v) { return __uint_as_float(((unsigned)v) << 16); }
DI float bperm(int srclane, float v) { return __int_as_float(__builtin_amdgcn_ds_bpermute(srclane << 2, __float_as_int(v))); }
DI float wave_sum(float v, int lane) {
#pragma unroll
    for (int o = 1; o < 64; o <<= 1) v += bperm(lane ^ o, v);
    return v;
}
DI float siluf(float x) { return x / (1.0f + __expf(-x)); }
#define MFMA16(a, b, c) __builtin_amdgcn_mfma_f32_16x16x32_bf16((a), (b), (c), 0, 0, 0)
#define MFMA32(a, b, c) __builtin_amdgcn_mfma_f32_32x32x16_bf16((a), (b), (c), 0, 0, 0)
DI int crow(int r, int hi) { return (r & 3) + 8 * (r >> 2) + 4 * hi; }
DI unsigned img_off(unsigned row, unsigned ch) { return 256u * row + 16u * (ch ^ (((row & 3u) << 2) | ((row >> 2) & 3u))); }
DI unsigned tr32_addr(unsigned lane, unsigned k0, unsigned c, unsigned t) {
    const unsigned h = lane >> 5, blk = (lane >> 4) & 1u, q = (lane & 15u) >> 2, p = lane & 3u;
    return img_off(k0 + 8 * h + 4 * t + q, 4 * c + 2 * blk + (p >> 1)) + 8 * (p & 1u);
}
DI unsigned tr16_addr(unsigned lane, unsigned k0, unsigned c, unsigned t) {
    const unsigned g = lane >> 4, q = (lane & 15u) >> 2, p = lane & 3u;
    return img_off(k0 + 8 * g + 4 * t + q, 2 * c + (p >> 1)) + 8 * (p & 1u);
}
DI s16x4 tr_issue(unsigned lds_addr) { s16x4 r; asm volatile("ds_read_b64_tr_b16 %0, %1" : "=&v"(r) : "v"(lds_addr) : "memory"); return r; }
#define LDS_WAIT_PIN() do { asm volatile("s_waitcnt lgkmcnt(0)" ::: "memory"); __builtin_amdgcn_sched_barrier(0); } while (0)
#define CAT8(L, H) (bf16x8){L[0], L[1], L[2], L[3], H[0], H[1], H[2], H[3]}
DI unsigned cvtpk(float lo, float hi) { unsigned r; asm volatile("v_cvt_pk_bf16_f32 %0, %1, %2" : "=v"(r) : "v"(lo), "v"(hi)); return r; }

static_assert(WS_END <= (size_t)3221225472ull, "workspace map must fit 4 x the largest tensor (3 GiB)");
#define XB_TMO      128
#define XB_XCNT(j)  (256  + 64 * (j))
#define XB_XSUB(j)  (1280 + 64 * (j))
#define XB_XGEN(j)  (2304 + 64 * (j))
#define XB_TOP      3328
#define XB_TOPGEN   3392
#define XCD_BAR_WORDS 3456
#define XB_SPIN_CAP (1u << 18)

__device__ __forceinline__ unsigned xb_ld(unsigned* p)              { return __hip_atomic_load(p, __ATOMIC_RELAXED, __HIP_MEMORY_SCOPE_AGENT); }
__device__ __forceinline__ unsigned xb_add(unsigned* p, unsigned v) { return __hip_atomic_fetch_add(p, v, __ATOMIC_RELAXED, __HIP_MEMORY_SCOPE_AGENT); }
__device__ __forceinline__ unsigned xb_xcc_id() { return (unsigned)__builtin_amdgcn_s_getreg((3 << 11) | 20) & 0xFu; }
#define XB_SPIN(cond, bar) do { unsigned _sp = 0; while (cond) { __builtin_amdgcn_s_sleep(1); \
    if ((++_sp & 255u) == 0u) { if (xb_ld(&(bar)[XB_TMO])) break; if (_sp > XB_SPIN_CAP) { atomicAdd(&(bar)[XB_TMO], 1u); break; } } } } while (0)

struct XcdBarrier {
    unsigned* bar; unsigned x;
    volatile LAS unsigned* st;
};

__device__ __forceinline__ XcdBarrier xcd_barrier_post(unsigned* bar, volatile LAS unsigned* st) {
    XcdBarrier b; b.bar = bar; b.x = xb_xcc_id(); b.st = st;
    if (threadIdx.x == 0) (void)xb_add(&bar[XB_XCNT(b.x)], 1u);
    return b;
}
__device__ __forceinline__ void xcd_barrier_complete(unsigned* bar, unsigned x, unsigned& nloc, unsigned& nx) {
    const unsigned G = gridDim.x * gridDim.y * gridDim.z;
    unsigned sum, cnt, mine, sp = 0u;
    for (;;) {
        sum = 0u; cnt = 0u; mine = 0u;
#pragma unroll
        for (unsigned j = 0; j < 16; ++j) { const unsigned c = xb_ld(&bar[XB_XCNT(j)]); sum += c; cnt += (c > 0u) ? 1u : 0u; mine = (j == x) ? c : mine; }
        if (sum == G) break;
        __builtin_amdgcn_s_sleep(1);
        if ((++sp & 255u) == 0u) { if (xb_ld(&bar[XB_TMO])) break; if (sp > XB_SPIN_CAP) { atomicAdd(&bar[XB_TMO], 1u); break; } }
    }
    nloc = mine > 0u ? mine : 1u; nx = cnt > 0u ? cnt : 1u;
}

__device__ __forceinline__ void xcd_barrier(const XcdBarrier& b) {
    asm volatile("s_waitcnt vmcnt(0)" ::: "memory");
    __syncthreads();
    if (threadIdx.x == 0) {
        unsigned* bar = b.bar;
        __builtin_amdgcn_s_waitcnt(0);
        unsigned nloc = b.st[0], nx = b.st[1];
        if (nloc == 0u) { xcd_barrier_complete(bar, b.x, nloc, nx); b.st[0] = nloc; b.st[1] = nx; }
        const unsigned old = xb_add(&bar[XB_XSUB(b.x)], 1u);
        const unsigned gen = old / nloc;
        if (old + 1u == (gen + 1u) * nloc) {
            __builtin_amdgcn_fence(__ATOMIC_RELEASE, "agent");
            asm volatile("s_waitcnt vmcnt(0)" ::: "memory");
            const unsigned og = xb_add(&bar[XB_TOP], 1u);
            const unsigned tg = og / nx;
            if (og + 1u == (tg + 1u) * nx) xb_add(&bar[XB_TOPGEN], 1u);
            else XB_SPIN(xb_ld(&bar[XB_TOPGEN]) == tg, bar);
            __builtin_amdgcn_fence(__ATOMIC_ACQUIRE, "agent");
            xb_add(&bar[XB_XGEN(b.x)], 1u);
            asm volatile("s_waitcnt vmcnt(0)" ::: "memory");
        } else {
            XB_SPIN(xb_ld(&bar[XB_XGEN(b.x)]) == gen, bar);
            __builtin_amdgcn_fence(__ATOMIC_ACQUIRE, "agent");
            asm volatile("s_waitcnt vmcnt(0)" ::: "memory");
        }
    }
    __syncthreads();
}
struct Frame {
    LAS unsigned char* lds;
    int tid, lane, wave, vcu, G;
    unsigned char* ws;
    const float *x, *c, *ctx, *c_ctx, *mod_w, *mod_b, *norm_gain, *even_w_in, *q_a_gain, *kv_a_gain, *w_uq, *w_ukv, *q_norm_gain, *k_norm_gain, *hg_lb, *hg_norm_gain, *even_w_out, *odd_w_in, *ret_decay, *odd_w_out;
    float* out;
};
#define WSP(T, off) ((T*)(F.ws + (off)))
DI const float* ld_ptr(const LAS unsigned* tbl, int k) { const unsigned lo = __builtin_amdgcn_readfirstlane(tbl[2 * k]), hi = __builtin_amdgcn_readfirstlane(tbl[2 * k + 1]); return (const float*)(uintptr_t)(((unsigned long long)hi << 32) | lo); }
#define LOADPTRS(F) do { const LAS unsigned* t_ = (const LAS unsigned*)((F).lds + MISC_OFF + 64); \
    (F).x = ld_ptr(t_, 0); (F).c = ld_ptr(t_, 1); (F).ctx = ld_ptr(t_, 2); (F).c_ctx = ld_ptr(t_, 3); (F).mod_w = ld_ptr(t_, 4); (F).mod_b = ld_ptr(t_, 5); (F).norm_gain = ld_ptr(t_, 6); (F).even_w_in = ld_ptr(t_, 7); \
    (F).q_a_gain = ld_ptr(t_, 8); (F).kv_a_gain = ld_ptr(t_, 9); (F).w_uq = ld_ptr(t_, 10); (F).w_ukv = ld_ptr(t_, 11); (F).q_norm_gain = ld_ptr(t_, 12); (F).k_norm_gain = ld_ptr(t_, 13); (F).hg_lb = ld_ptr(t_, 14); \
    (F).hg_norm_gain = ld_ptr(t_, 15); (F).even_w_out = ld_ptr(t_, 16); (F).odd_w_in = ld_ptr(t_, 17); (F).ret_decay = ld_ptr(t_, 18); (F).odd_w_out = ld_ptr(t_, 19); } while (0)

DI void p0_transpose_item(const float* W, int K, int N, bf16* WT, LAS float* scr, int item, int lane) {
    const int nblk = N / 32, kb = item / nblk, nb = item % nblk, k0 = 64 * kb, n0 = 32 * nb;
    float tv[32];
#pragma unroll
    for (int i = 0; i < 32; ++i) tv[i] = W[(size_t)(k0 + 2 * i + (lane >> 5)) * N + n0 + (lane & 31)];
#pragma unroll
    for (int i = 0; i < 32; ++i) scr[(2 * i + (lane >> 5)) * 33 + (lane & 31)] = tv[i];
    asm volatile("s_waitcnt lgkmcnt(0)" ::: "memory");
    const int c = lane & 7;
#pragma unroll
    for (int j = 0; j < 4; ++j) { const int n = (lane >> 3) + 8 * j; const LAS float* s = scr + (8 * c) * 33 + n;
        v4u o; o.x = pk2(s[0 * 33], s[1 * 33]); o.y = pk2(s[2 * 33], s[3 * 33]); o.z = pk2(s[4 * 33], s[5 * 33]); o.w = pk2(s[6 * 33], s[7 * 33]);
        *(v4u*)(WT + (size_t)(n0 + n) * K + k0 + 8 * c) = o; }
    asm volatile("s_waitcnt lgkmcnt(0)" ::: "memory");
}
DI void ph_prologue(Frame& F) {
    LAS float* scr = (LAS float*)(F.lds + F.wave * 16384);
    const int gw = F.vcu * NWAVES + F.wave, NGW = F.G * NWAVES;
    constexpr int I_WINE = (DM / 64) * (E_END / 32), I_WUQ = (Q_LORA / 64) * (NQ / 32), I_WUKV = (KV_LORA / 64) * (NKV / 32), I_WOE = (DM / 64) * (DM / 32),
                  I_WINO = (DM / 64) * (O_END / 32), I_WOO = (8192 / 64) * (DM / 32);
    constexpr int I_PER = I_WINE + I_WUQ + I_WUKV + I_WOE + I_WINO + I_WOO;
    for (int it = gw; it < 2 * I_PER; it += NGW) {
        const int i = it / I_PER; int r = it % I_PER;
        if (r < I_WINE) { p0_transpose_item(F.even_w_in + (size_t)i * DM * E_END, DM, E_END, WSP(bf16, WS_WINE) + (size_t)i * E_PAD * DM, scr, r, F.lane); continue; } r -= I_WINE;
        if (r < I_WUQ) { p0_transpose_item(F.w_uq + (size_t)i * Q_LORA * NQ, Q_LORA, NQ, WSP(bf16, WS_WUQ) + (size_t)i * NQ * Q_LORA, scr, r, F.lane); continue; } r -= I_WUQ;
        if (r < I_WUKV) { p0_transpose_item(F.w_ukv + (size_t)i * KV_LORA * NKV, KV_LORA, NKV, WSP(bf16, WS_WUKV) + (size_t)i * NKV * KV_LORA, scr, r, F.lane); continue; } r -= I_WUKV;
        if (r < I_WOE) { p0_transpose_item(F.even_w_out + (size_t)i * DM * DM, DM, DM, WSP(bf16, WS_WOE) + (size_t)i * DM * DM, scr, r, F.lane); continue; } r -= I_WOE;
        if (r < I_WINO) { p0_transpose_item(F.odd_w_in + (size_t)i * DM * O_END, DM, O_END, WSP(bf16, WS_WINO) + (size_t)i * O_END * DM, scr, r, F.lane); continue; } r -= I_WINO;
        p0_transpose_item(F.odd_w_out + (size_t)i * 8192 * DM, 8192, DM, WSP(bf16, WS_WOO) + (size_t)i * DM * 8192, scr, r, F.lane);
    }
    { const size_t n16 = (size_t)(E_PAD - E_END) * DM * 2 / 16;
      for (size_t j = (size_t)blockIdx.x * 512 + F.tid; j < 2 * n16; j += (size_t)F.G * 512) { const size_t i = j / n16, o = j % n16;
          *((v4u*)(WSP(bf16, WS_WINE) + (i * E_PAD + E_END) * DM) + o) = (v4u){0u, 0u, 0u, 0u}; } }
    __syncthreads();
    LAS float* tab = (LAS float*)F.lds;
    for (int j = F.tid; j < 5 * DM; j += 512) { const int r = j >> 12, k = j & 4095; const float v = r < 4 ? F.c[r * DM + k] : F.c_ctx[k]; tab[j] = v / (1.0f + __expf(-v)); }
    __syncthreads();
    constexpr int NT = MODW / 256, KC = DM / KCH;
    float* modp = WSP(float, WS_MODP);
    for (int it = gw; it < 4 * NT * KCH; it += NGW) {
        const int kc = it % KCH, nt = (it / KCH) % NT, l = it / (KCH * NT);
        const float* W = F.mod_w + ((size_t)l * DM + (size_t)kc * KC) * MODW + nt * 256 + F.lane * 4;
        f32x4 acc[5];
#pragma unroll
        for (int r = 0; r < 5; ++r) acc[r] = (f32x4){0.f, 0.f, 0.f, 0.f};
#pragma unroll 8
        for (int k = 0; k < KC; ++k) { const f32x4 w = *(const f32x4*)(W + (size_t)k * MODW);
#pragma unroll
            for (int r = 0; r < 5; ++r) { const float s = tab[r * DM + kc * KC + k]; acc[r] += w * s; } }
#pragma unroll
        for (int r = 0; r < 5; ++r) *(f32x4*)(modp + ((size_t)(kc * 4 + l) * 5 + r) * MODW + nt * 256 + F.lane * 4) = acc[r];
    }
}
DI void ph_finalize(Frame& F) {
    const float* modp = WSP(float, WS_MODP); float* mod = WSP(float, WS_MOD);
    for (int j = blockIdx.x * 512 + F.tid; j < 4 * 5 * MODW / 4; j += F.G * 512) {
        const int n4 = j % (MODW / 4), lr = j / (MODW / 4), l = lr / 5;
        f32x4 s = *(const f32x4*)(F.mod_b + (size_t)l * MODW + n4 * 4);
        for (int kc = 0; kc < KCH; ++kc) s += *(const f32x4*)(modp + ((size_t)kc * 20 + lr) * MODW + n4 * 4);
        *(f32x4*)(mod + (size_t)lr * MODW + n4 * 4) = s;
    }
    float* lb = WSP(float, WS_LB);
    for (int j = blockIdx.x * 512 + F.tid; j < 2 * 2048; j += F.G * 512) {
        const float a0 = F.hg_lb[j], a1 = F.hg_lb[2 * 2048 + j], m = fmaxf(a0, a1), e0 = expf(a0 - m), e1 = expf(a1 - m);
        lb[j] = 0.f; lb[2 * 2048 + j] = e1 / (e0 + e1);
    }
}
DI void ph_ada_in(Frame& F, int l, const float* xl, const float* xc) {
    const int gw = F.vcu * NWAVES + F.wave, NGW = F.G * NWAVES;
    const float* gain = F.norm_gain + (size_t)l * DM; bf16* H = WSP(bf16, WS_H);
    for (int row = gw; row < MT; row += NGW) {
        const float* src = row < M_LAT ? xl + (size_t)row * DM : xc + (size_t)(row - M_LAT) * DM;
        const int seg = row < M_LAT ? (row >> 12) : 4;
        const float* md = WSP(float, WS_MOD) + ((size_t)l * 5 + seg) * MODW;
        f32x4 v[16]; float ss = 0.f;
#pragma unroll
        for (int j = 0; j < 16; ++j) { v[j] = *((const f32x4*)src + F.lane + 64 * j); ss += (v[j].x * v[j].x + v[j].y * v[j].y) + (v[j].z * v[j].z + v[j].w * v[j].w); }
        const float rinv = rsqrtf(wave_sum(ss, F.lane) * (1.0f / DM) + EPS);
#pragma unroll
        for (int j = 0; j < 16; ++j) { const int c4 = F.lane + 64 * j;
            const f32x4 g = *((const f32x4*)gain + c4), sh = *((const f32x4*)md + c4), sc = *((const f32x4*)(md + DM) + c4);
            const f32x4 y = v[j] * rinv * g * (sc + 1.0f) + sh;
            v2u o; o.x = pk2(y.x, y.y); o.y = pk2(y.z, y.w); *((v2u*)(H + (size_t)row * DM) + c4) = o; }
    }
}
DI void ph_lora_norm(Frame& F, int i) {
    const int gw = F.vcu * NWAVES + F.wave, NGW = F.G * NWAVES;
    const bf16* P = WSP(bf16, WS_P); bf16* CQN = WSP(bf16, WS_CQN); bf16* CKVN = WSP(bf16, WS_CKVN);
    const float* qg = F.q_a_gain + (size_t)i * Q_LORA; const float* kg = F.kv_a_gain + (size_t)i * KV_LORA;
    for (int row = gw; row < MT; row += NGW) {
        const bf16* pr = P + (size_t)row * E_PAD;
        v4u a[3]; float ss = 0.f;
#pragma unroll
        for (int j = 0; j < 3; ++j) { a[j] = *((const v4u*)(pr + E_CQ) + F.lane + 64 * j);
#pragma unroll
            for (int e = 0; e < 4; ++e) { const float lo = bflo(a[j][e]), hi = bfhi(a[j][e]); ss += lo * lo + hi * hi; } }
        const float rq = rsqrtf(wave_sum(ss, F.lane) * (1.0f / Q_LORA) + EPS);
#pragma unroll
        for (int j = 0; j < 3; ++j) { const int c8 = F.lane + 64 * j; const f32x4 g0 = *((const f32x4*)qg + 2 * c8), g1 = *((const f32x4*)qg + 2 * c8 + 1); v4u o;
            o.x = pk2(bflo(a[j].x) * rq * g0.x, bfhi(a[j].x) * rq * g0.y); o.y = pk2(bflo(a[j].y) * rq * g0.z, bfhi(a[j].y) * rq * g0.w);
            o.z = pk2(bflo(a[j].z) * rq * g1.x, bfhi(a[j].z) * rq * g1.y); o.w = pk2(bflo(a[j].w) * rq * g1.z, bfhi(a[j].w) * rq * g1.w);
            *((v4u*)(CQN + (size_t)row * Q_LORA) + c8) = o; }
        const v4u b = *((const v4u*)(pr + E_CKV) + F.lane); float s2 = 0.f;
#pragma unroll
        for (int e = 0; e < 4; ++e) { const float lo = bflo(b[e]), hi = bfhi(b[e]); s2 += lo * lo + hi * hi; }
        const float rk = rsqrtf(wave_sum(s2, F.lane) * (1.0f / KV_LORA) + EPS);
        { const f32x4 g0 = *((const f32x4*)kg + 2 * F.lane), g1 = *((const f32x4*)kg + 2 * F.lane + 1); v4u o;
          o.x = pk2(bflo(b.x) * rk * g0.x, bfhi(b.x) * rk * g0.y); o.y = pk2(bflo(b.y) * rk * g0.z, bfhi(b.y) * rk * g0.w);
          o.z = pk2(bflo(b.z) * rk * g1.x, bfhi(b.z) * rk * g1.y); o.w = pk2(bflo(b.w) * rk * g1.z, bfhi(b.w) * rk * g1.w);
          *((v4u*)(CKVN + (size_t)row * KV_LORA) + F.lane) = o; }
    }
}
DI void ph_qk_norm_rope(Frame& F, int i) {
    const int gw = F.vcu * NWAVES + F.wave, NGW = F.G * NWAVES;
    bf16* QF = WSP(bf16, WS_QF); const bf16* KV = WSP(bf16, WS_KV); bf16* KF = WSP(bf16, WS_KF); const bf16* P = WSP(bf16, WS_P);
    const float* qg = F.q_norm_gain + (size_t)i * QKD; const float* kg = F.k_norm_gain + (size_t)i * QKD;
    const int h = F.lane >> 2, part = F.lane & 3;
    float inv[8];
#pragma unroll
    for (int j = 0; j < 8; ++j) inv[j] = exp2f(-(float)(8 * (part & 1) + j) * (13.287712379549449f / 16.0f));
    constexpr float QSCL = 0.07216878364870322f * 1.4426950408889634f;
    for (int row = gw; row < MT; row += NGW) {
        const bool lat = row < M_LAT; const int t = row & 4095; const float prow = (float)(t >> 6), pcol = (float)(t & 63);
        float cs[2][8], sn[2][8];
        if (lat) {
#pragma unroll
            for (int j = 0; j < 8; ++j) { sincosf(prow * inv[j], &sn[0][j], &cs[0][j]); sincosf(pcol * inv[j], &sn[1][j], &cs[1][j]); }
        }
#pragma unroll
        for (int which = 0; which < 2; ++which) {
            float v[6][8]; float ss = 0.f;
#pragma unroll
            for (int ii = 0; ii < 6; ++ii) { const int c = part + 4 * ii; v4u w;
                if (which == 0) w = *(const v4u*)(QF + (size_t)row * NQ + h * QKD + 8 * c);
                else if (ii < 4) w = *(const v4u*)(KV + (size_t)row * NKV + h * 256 + 8 * c);
                else w = *(const v4u*)(P + (size_t)row * E_PAD + E_KPE + 8 * (c - 16));
#pragma unroll
                for (int e = 0; e < 4; ++e) { v[ii][2 * e] = bflo(w[e]); v[ii][2 * e + 1] = bfhi(w[e]); ss += v[ii][2 * e] * v[ii][2 * e] + v[ii][2 * e + 1] * v[ii][2 * e + 1]; } }
            ss += bperm(F.lane ^ 1, ss); ss += bperm(F.lane ^ 2, ss);
            const float rn = rsqrtf(ss * (1.0f / QKD) + EPS); const float* gg = which == 0 ? qg : kg;
#pragma unroll
            for (int ii = 0; ii < 6; ++ii) { const int c = part + 4 * ii;
#pragma unroll
                for (int e = 0; e < 8; ++e) v[ii][e] = v[ii][e] * rn * gg[8 * c + e]; }
            if (lat) {
#pragma unroll
                for (int hf = 0; hf < 2; ++hf) {
#pragma unroll
                    for (int e = 0; e < 8; ++e) { const float m = v[4 + hf][e], o = bperm(F.lane ^ 2, m);
                        v[4 + hf][e] = (part < 2) ? (m * cs[hf][e] - o * sn[hf][e]) : (o * sn[hf][e] + m * cs[hf][e]); } }
            }
            const float scl = which == 0 ? QSCL : 1.0f;
#pragma unroll
            for (int ii = 0; ii < 6; ++ii) { const int c = part + 4 * ii; v4u o;
#pragma unroll
                for (int e = 0; e < 4; ++e) o[e] = pk2(v[ii][2 * e] * scl, v[ii][2 * e + 1] * scl);
                if (which == 0) *(v4u*)(QF + (size_t)row * NQ + h * QKD + 8 * c) = o; else *(v4u*)(KF + (size_t)row * NQ + h * QKD + 8 * c) = o; }
        }
    }
}
DI void ph_hg_merge(Frame& F, int i) {
    const int gw = F.vcu * NWAVES + F.wave, NGW = F.G * NWAVES;
    const bf16* OFp = WSP(bf16, WS_OFE); const bf16* OBp = WSP(bf16, WS_OBE); const bf16* P = WSP(bf16, WS_P); bf16* A = WSP(bf16, WS_A);
    const float* hgg = F.hg_norm_gain + (size_t)i * 128; const int h = F.lane >> 2, part = F.lane & 3;
    for (int row = gw; row < MT; row += NGW) {
        const size_t o0 = (size_t)row * 2048 + h * 128 + part * 32; f32x4 v[8]; float ss = 0.f;
#pragma unroll
        for (int j = 0; j < 4; ++j) { const v4u a = *((const v4u*)(OFp + o0) + j), b = *((const v4u*)(OBp + o0) + j);
            v[2 * j] = (f32x4){bflo(a.x) + bflo(b.x), bfhi(a.x) + bfhi(b.x), bflo(a.y) + bflo(b.y), bfhi(a.y) + bfhi(b.y)};
            v[2 * j + 1] = (f32x4){bflo(a.z) + bflo(b.z), bfhi(a.z) + bfhi(b.z), bflo(a.w) + bflo(b.w), bfhi(a.w) + bfhi(b.w)}; }
#pragma unroll
        for (int j = 0; j < 8; ++j) ss += (v[j].x * v[j].x + v[j].y * v[j].y) + (v[j].z * v[j].z + v[j].w * v[j].w);
        ss += bperm(F.lane ^ 1, ss); ss += bperm(F.lane ^ 2, ss);
        const float rn = rsqrtf(ss * (1.0f / 128) + EPS);
        const bf16* gp = P + (size_t)row * E_PAD + E_GH + h * 128 + part * 32; bf16* ap = A + (size_t)row * DM + 2048 + h * 128 + part * 32;
#pragma unroll
        for (int j = 0; j < 4; ++j) { const v4u g = *((const v4u*)gp + j); const f32x4 a = v[2 * j], b = v[2 * j + 1];
            const f32x4 g0 = *((const f32x4*)(hgg + part * 32) + 2 * j), g1 = *((const f32x4*)(hgg + part * 32) + 2 * j + 1); v4u o;
            o.x = pk2(a.x * rn * g0.x * siluf(bflo(g.x)), a.y * rn * g0.y * siluf(bfhi(g.x))); o.y = pk2(a.z * rn * g0.z * siluf(bflo(g.y)), a.w * rn * g0.w * siluf(bfhi(g.y)));
            o.z = pk2(b.x * rn * g1.x * siluf(bflo(g.z)), b.y * rn * g1.y * siluf(bfhi(g.z))); o.w = pk2(b.z * rn * g1.z * siluf(bflo(g.w)), b.w * rn * g1.w * siluf(bfhi(g.w)));
            *((v4u*)ap + j) = o; }
    }
}
DI void ph_ret_rope(Frame& F) {
    const int gw = F.vcu * NWAVES + F.wave, NGW = F.G * NWAVES; bf16* P = WSP(bf16, WS_P);
    const int hsub = F.lane >> 4, i0 = 8 * (F.lane & 15);
    float inv[8];
#pragma unroll
    for (int j = 0; j < 8; ++j) inv[j] = 1.0f / powf(10000.0f, (float)(i0 + j) * (1.0f / 127.0f));
    for (int row = gw; row < MT; row += NGW) {
        const bool lat = row < M_LAT; const float pos = (float)(row & 4095);
        float cs[8], sn[8];
#pragma unroll
        for (int j = 0; j < 8; ++j) { if (lat) sincosf(pos * inv[j], &sn[j], &cs[j]); else { cs[j] = 1.f; sn[j] = 0.f; } }
#pragma unroll
        for (int which = 0; which < 2; ++which) {
            const float scl = which ? 0.0625f : 1.0f;
#pragma unroll
            for (int it = 0; it < 4; ++it) { const int h = 4 * it + hsub; bf16* p1 = P + (size_t)row * O_END + (which ? O_K : O_Q) + h * 256 + i0; bf16* p2 = p1 + 128;
                const v4u a = *(const v4u*)p1, b = *(const v4u*)p2; v4u oa, ob;
#pragma unroll
                for (int e = 0; e < 4; ++e) { const float x1l = bflo(a[e]), x1h = bfhi(a[e]), x2l = bflo(b[e]), x2h = bfhi(b[e]);
                    oa[e] = pk2((x1l * cs[2 * e] - x2l * sn[2 * e]) * scl, (x1h * cs[2 * e + 1] - x2h * sn[2 * e + 1]) * scl);
                    ob[e] = pk2((x1l * sn[2 * e] + x2l * cs[2 * e]) * scl, (x1h * sn[2 * e + 1] + x2h * cs[2 * e + 1]) * scl); }
                *(v4u*)p1 = oa; *(v4u*)p2 = ob; }
        }
    }
}
DI void ph_ret_merge(Frame& F, int li) {
    const int gw = F.vcu * NWAVES + F.wave, NGW = F.G * NWAVES;
    const bf16* OFp = WSP(bf16, WS_OFO); const bf16* OBp = WSP(bf16, WS_OBO); const bf16* P = WSP(bf16, WS_P); bf16* A = WSP(bf16, WS_A);
    LAS float* l2t = (LAS float*)F.lds;
    if (F.tid < 32) { const float dl = F.ret_decay[(size_t)li * 32 + F.tid]; l2t[F.tid] = -log1pf(expf(-dl)) * 1.4426950408889634f; }
    __syncthreads();
    for (int row = gw; row < MT; row += NGW) {
        const float j = (float)(row & 63);
#pragma unroll 4
        for (int h = 0; h < 16; ++h) { const size_t o0 = (size_t)row * 8192 + h * 512 + F.lane * 8;
            const float sf = __builtin_amdgcn_exp2f((j - 63.0f) * l2t[h]), sb = __builtin_amdgcn_exp2f(-j * l2t[16 + h]);
            const v4u fa = *(const v4u*)(OFp + o0), fb = *(const v4u*)(OBp + o0);
            const f32x4 a = (f32x4){bflo(fa.x) * sf + bflo(fb.x) * sb, bfhi(fa.x) * sf + bfhi(fb.x) * sb, bflo(fa.y) * sf + bflo(fb.y) * sb, bfhi(fa.y) * sf + bfhi(fb.y) * sb};
            const f32x4 b = (f32x4){bflo(fa.z) * sf + bflo(fb.z) * sb, bfhi(fa.z) * sf + bfhi(fb.z) * sb, bflo(fa.w) * sf + bflo(fb.w) * sb, bfhi(fa.w) * sf + bfhi(fb.w) * sb};
            const float ss = (a.x * a.x + a.y * a.y) + (a.z * a.z + a.w * a.w) + (b.x * b.x + b.y * b.y) + (b.z * b.z + b.w * b.w);
            const float rn = rsqrtf(wave_sum(ss, F.lane) * (1.0f / 512) + EPS);
            const v4u g = *(const v4u*)(P + (size_t)row * O_END + O_G + h * 512 + F.lane * 8); v4u o;
            o.x = pk2(a.x * rn * siluf(bflo(g.x)), a.y * rn * siluf(bfhi(g.x))); o.y = pk2(a.z * rn * siluf(bflo(g.y)), a.w * rn * siluf(bfhi(g.y)));
            o.z = pk2(b.x * rn * siluf(bflo(g.z)), b.y * rn * siluf(bfhi(g.z))); o.w = pk2(b.z * rn * siluf(bflo(g.w)), b.w * rn * siluf(bfhi(g.w)));
            *(v4u*)(A + (size_t)row * 8192 + h * 512 + F.lane * 8) = o; }
    }
}
namespace att {
constexpr int KP = 400;
constexpr int VB = 64 * 128 * 2, KB = 64 * KP;
constexpr int OFF_V = 0, OFF_K = 2 * VB, OFF_WS = OFF_K + 2 * KB;
constexpr float THR2 = 11.5f;
DI int v_st(int k, int c) { const int kk = (k & ~0xC) | ((k & 4) << 1) | ((k & 8) >> 1); return ((kk >> 3) * 4 + (c >> 5)) * 512 + ((kk & 7) * 32 + (c & 31)) * 2; }
DI int v_rd_base(int lane) { return ((lane & 3) << 3) | (((lane >> 2) & 3) << 6) | (((lane >> 4) & 1) << 5) | (((lane >> 5) & 1) << 8); }
constexpr int v_rd_off(int d0, int ks, int half) { return d0 * 512 + ks * 4096 + half * 2048; }
template <int OFF> DI s16x4 tr_read(int vb) { s16x4 r; asm volatile("ds_read_b64_tr_b16 %0, %1 offset:%2" : "=&v"(r) : "v"(vb), "i"(OFF) : "memory"); return r; }
template <int D0> DI void pv_one(f32x16& od, int vb, bf16x8 pa0, bf16x8 pa1, bf16x8 pa2, bf16x8 pa3) {
    const s16x4 l0 = tr_read<v_rd_off(D0, 0, 0)>(vb), h0 = tr_read<v_rd_off(D0, 0, 1)>(vb), l1 = tr_read<v_rd_off(D0, 1, 0)>(vb), h1 = tr_read<v_rd_off(D0, 1, 1)>(vb);
    const s16x4 l2 = tr_read<v_rd_off(D0, 2, 0)>(vb), h2 = tr_read<v_rd_off(D0, 2, 1)>(vb), l3 = tr_read<v_rd_off(D0, 3, 0)>(vb), h3 = tr_read<v_rd_off(D0, 3, 1)>(vb);
    LDS_WAIT_PIN();
    od = MFMA32(pa0, CAT8(l0, h0), od); od = MFMA32(pa1, CAT8(l1, h1), od); od = MFMA32(pa2, CAT8(l2, h2), od); od = MFMA32(pa3, CAT8(l3, h3), od);
}
DI void unit(Frame& F, int h, int qrow0, int klat0, int nlat, int kctx0, int NT, int ldp) {
    const int tid = F.tid, wid = F.wave, lane = F.lane, r32 = lane & 31, hi = lane >> 5;
    const bf16* QF = WSP(bf16, WS_QF); const bf16* KF = WSP(bf16, WS_KF); const bf16* KV = WSP(bf16, WS_KV); const bf16* P = WSP(bf16, WS_P); bf16* A = WSP(bf16, WS_A);
    LAS unsigned char* Vl = F.lds + OFF_V; LAS unsigned char* Kl = F.lds + OFF_K;
    LAS float* wsl = (LAS float*)(F.lds + OFF_WS) + wid * 64; LAS float* li_l = wsl; LAS float* al_l = wsl + 32;
    float m_reg = -1e30f, l_reg = 0.f; f32x16 o[4];
#pragma unroll
    for (int d = 0; d < 4; ++d)
#pragma unroll
        for (int r = 0; r < 16; ++r) o[d][r] = 0.f;
    bf16x8 qr[12];
    { const bf16* Qw = QF + (size_t)(qrow0 + wid * 32 + r32) * NQ + h * QKD + hi * 8;
#pragma unroll
      for (int d0 = 0; d0 < 12; ++d0) qr[d0] = *(const bf16x8*)(Qw + d0 * 16); }
    int krow[3], kch[3];
#pragma unroll
    for (int i = 0; i < 3; ++i) { const int idx = tid + 512 * i; krow[i] = idx / 24; kch[i] = idx % 24; }
    const int vrow0 = tid >> 4, vc = (tid & 15) * 8;
    v4u sk[3], sv[2];
    const int vb0 = (int)(uintptr_t)Vl + v_rd_base(lane);
#define KEYROW(kt) ((kt) < nlat ? klat0 + 64 * (kt) : kctx0 + 64 * ((kt) - nlat))
#define SLOAD(kt) do { const int kr_ = KEYROW(kt); _Pragma("unroll") for (int i = 0; i < 3; ++i) sk[i] = *(const v4u*)(KF + (size_t)(kr_ + krow[i]) * NQ + h * QKD + kch[i] * 8); \
        _Pragma("unroll") for (int i = 0; i < 2; ++i) sv[i] = *(const v4u*)(KV + (size_t)(kr_ + vrow0 + 32 * i) * NKV + h * 256 + 128 + vc); } while (0)
#define SWRITE(b) do { _Pragma("unroll") for (int i = 0; i < 3; ++i) *(LAS v4u*)(Kl + (b) * KB + krow[i] * KP + kch[i] * 16) = sk[i]; \
        _Pragma("unroll") for (int i = 0; i < 2; ++i) *(LAS v4u*)(Vl + (b) * VB + v_st(vrow0 + 32 * i, vc)) = sv[i]; } while (0)
    SLOAD(0); SWRITE(0);
    if (NT > 1) SLOAD(1);
    __syncthreads();
    for (int j = 0; j < NT; ++j) {
        const int buf = j & 1;
        f32x16 p0, p1;
#pragma unroll
        for (int r = 0; r < 16; ++r) { p0[r] = 0.f; p1[r] = 0.f; }
        { const LAS unsigned char* Ks = Kl + buf * KB;
#pragma unroll
          for (int d0 = 0; d0 < 12; ++d0) { const int cb = (d0 * 16 + hi * 8) * 2;
              const bf16x8 b0 = *(const LAS bf16x8*)(Ks + r32 * KP + cb), b1 = *(const LAS bf16x8*)(Ks + (32 + r32) * KP + cb);
              p0 = MFMA32(b0, qr[d0], p0); p1 = MFMA32(b1, qr[d0], p1); } }
        float pmax = p0[0];
#pragma unroll
        for (int r = 1; r < 16; ++r) pmax = fmaxf(pmax, p0[r]);
#pragma unroll
        for (int r = 0; r < 16; ++r) pmax = fmaxf(pmax, p1[r]);
        { auto rr = __builtin_amdgcn_permlane32_swap(__float_as_uint(pmax), __float_as_uint(pmax), false, false); pmax = fmaxf(__uint_as_float(rr[0]), __uint_as_float(rr[1])); }
        float mn, alpha;
        if (__all(pmax - m_reg <= THR2)) { mn = m_reg; alpha = 1.f; }
        else { mn = fmaxf(m_reg, pmax); alpha = __builtin_amdgcn_exp2f(m_reg - mn); m_reg = mn; }
        float ps = 0.f;
#pragma unroll
        for (int r = 0; r < 16; ++r) { p0[r] = __builtin_amdgcn_exp2f(p0[r] - mn); p1[r] = __builtin_amdgcn_exp2f(p1[r] - mn); ps += p0[r] + p1[r]; }
        { auto rr = __builtin_amdgcn_permlane32_swap(__float_as_uint(ps), __float_as_uint(ps), false, false); ps = __uint_as_float(rr[0]) + __uint_as_float(rr[1]); }
        l_reg = l_reg * alpha + ps;
        bf16x8 pa0, pa1, pa2, pa3;
#define PK4(Pv, BASE, OUT) do { unsigned a0 = cvtpk(Pv[BASE + 0], Pv[BASE + 1]), a1 = cvtpk(Pv[BASE + 2], Pv[BASE + 3]); \
        unsigned b0_ = cvtpk(Pv[BASE + 4], Pv[BASE + 5]), b1_ = cvtpk(Pv[BASE + 6], Pv[BASE + 7]); \
        auto r0 = __builtin_amdgcn_permlane32_swap(a0, b0_, false, false); auto r1 = __builtin_amdgcn_permlane32_swap(a1, b1_, false, false); \
        v4u w = {r0[0], r1[0], r0[1], r1[1]}; OUT = __builtin_bit_cast(bf16x8, w); } while (0)
        PK4(p0, 0, pa0); PK4(p0, 8, pa1); PK4(p1, 0, pa2); PK4(p1, 8, pa3);
#undef PK4
        if (__any(alpha < 1.f)) { if (hi == 0) al_l[r32] = alpha; asm volatile("s_waitcnt lgkmcnt(0)" ::: "memory");
#pragma unroll
            for (int r = 0; r < 16; ++r) { const float a = al_l[crow(r, hi)];
#pragma unroll
                for (int d = 0; d < 4; ++d) o[d][r] *= a; } }
        if (j + 1 < NT) SWRITE(buf ^ 1);
        if (j + 2 < NT) SLOAD(j + 2);
        { const int vb = vb0 + buf * VB;
          pv_one<0>(o[0], vb, pa0, pa1, pa2, pa3); pv_one<1>(o[1], vb, pa0, pa1, pa2, pa3); pv_one<2>(o[2], vb, pa0, pa1, pa2, pa3); pv_one<3>(o[3], vb, pa0, pa1, pa2, pa3); }
        __syncthreads();
    }
#undef SLOAD
#undef SWRITE
#undef KEYROW
    if (hi == 0) li_l[r32] = l_reg; asm volatile("s_waitcnt lgkmcnt(0)" ::: "memory");
#pragma unroll
    for (int r = 0; r < 16; ++r) { const int orow = crow(r, hi); const float rl = __builtin_amdgcn_rcpf(li_l[orow]); const size_t grow = (size_t)(qrow0 + wid * 32 + orow);
#pragma unroll
        for (int d0 = 0; d0 < 4; ++d0) { const int col = h * 128 + d0 * 32 + r32; const float g = bf2f(P[grow * ldp + E_GM + col]);
            A[grow * DM + col] = (bf16)f2bf(o[d0][r] * rl * siluf(g)); } }
    __syncthreads();
}
}
namespace hg {
constexpr int TP = 272;
constexpr int OFF_QP = 0, OFF_KP = OFF_QP + 32 * TP, OFF_QS = OFF_KP + 32 * TP, OFF_KH = OFF_QS + 32 * TP, OFF_V = OFF_KH + 8192, OFF_A = OFF_V + 8192, OFF_E = OFF_A + 2560, OFF_SB = OFF_E + 512, SB_BYTES = 128 * TP;
static_assert(OFF_SB + 2 * SB_BYTES <= MISC_OFF && OFF_SB % 16 == 0, "hgrn LDS map");
constexpr int NCH = 8 + 128;
template <int OFF> DI s16x4 tr_off(unsigned base) { s16x4 r; asm volatile("ds_read_b64_tr_b16 %0, %1 offset:%2" : "=&v"(r) : "v"(base), "i"(OFF) : "memory"); return r; }
DI float scan32(float x) {
    x += __int_as_float(__builtin_amdgcn_update_dpp(0, __float_as_int(x), 0x111, 0xF, 0xF, false));
    x += __int_as_float(__builtin_amdgcn_update_dpp(0, __float_as_int(x), 0x112, 0xF, 0xF, false));
    x += __int_as_float(__builtin_amdgcn_update_dpp(0, __float_as_int(x), 0x114, 0xF, 0xF, false));
    x += __int_as_float(__builtin_amdgcn_update_dpp(0, __float_as_int(x), 0x118, 0xF, 0xF, false));
    x += __int_as_float(__builtin_amdgcn_update_dpp(0, __float_as_int(x), 0x142, 0xA, 0xF, false));
    return x;
}
DI void unit(Frame& F, int li, int b, int h, int dir) {
    const int wid = F.wave, lane0 = F.lane;
    const bf16* P = WSP(bf16, WS_P); bf16* OUT = dir ? WSP(bf16, WS_OBE) : WSP(bf16, WS_OFE);
    LAS unsigned char* L = F.lds;
    const int p0 = lane0 & 31, ch0 = 2 * wid + (lane0 >> 5);
    float lbv[8], omv[8];
    { const float* lbp = WSP(float, WS_LB) + ((size_t)li * 2 + dir) * 2048 + h * 128 + ch0 * 8;
#pragma unroll
      for (int j = 0; j < 8; ++j) { lbv[j] = lbp[j]; omv[j] = 1.0f - lbv[j]; } }
    const unsigned goff = (unsigned)(((dir ? 31 - p0 : p0) * E_PAD + ch0 * 8) * 2);
    const unsigned lrow = p0 * TP + ch0 * 16, limg = img_off(p0, ch0);
    const int fcol = (dir ? E_FB : E_FF) + h * 128, qcol = E_QH + h * 128, vcol = E_IH + h * 128;
#define ROWLO(ci) ((ci) < 8 ? M_LAT + b * CTXL + (dir ? CTXL - 32 - (ci) * 32 : (ci) * 32) : b * SEQ + (dir ? SEQ - 32 - ((ci) - 8) * 32 : ((ci) - 8) * 32))
#define HLOAD(ci) do { const char* pb_ = (const char*)(P + (size_t)ROWLO(ci) * E_PAD); rq = *(const v4u*)(pb_ + qcol * 2 + goff); rf = *(const v4u*)(pb_ + fcol * 2 + goff); rv = *(const v4u*)(pb_ + vcol * 2 + goff); } while (0)
    f32x16 accS[2];
#pragma unroll
    for (int i = 0; i < 2; ++i)
#pragma unroll
        for (int r = 0; r < 16; ++r) accS[i][r] = 0.f;
    for (int j = F.tid; j < SB_BYTES / 16; j += 512) *((LAS v4u*)(L + OFF_SB) + j) = (v4u){0u, 0u, 0u, 0u};
    v4u rq, rf, rv;
    HLOAD(0);
    __syncthreads();
    for (int cidx = 0; cidx < NCH; ++cidx) {
        int lane = lane0; asm volatile("" : "+v"(lane));
        const int cur = cidx & 1;
        const unsigned SBc = OFF_SB + cur * SB_BYTES, SBn = OFF_SB + (cur ^ 1) * SB_BYTES;
        const v4u cq = rq, cf = rf, cv = rv;
        if (cidx + 1 < NCH) HLOAD(cidx + 1);
        {
            v4u oqp, okp, oqs, okh; float qp[8], kp[8], qs[8], kh[8];
            const bool up = lane >= 32;
#pragma unroll
            for (int e = 0; e < 8; ++e) { const float f = (e & 1) ? bfhi(cf[e >> 1]) : bflo(cf[e >> 1]), q = (e & 1) ? bfhi(cq[e >> 1]) : bflo(cq[e >> 1]);
                const float t = __builtin_amdgcn_exp2f(-1.4426950408889634f * __builtin_fabsf(f)), r = __builtin_amdgcn_rcpf(1.0f + t), tr = t * r;
                const float sp = f >= 0.f ? r : tr, sn = f >= 0.f ? tr : r;
                const float key = omv[e] * sn, g = lbv[e] + omv[e] * sp;
                const float bb = scan32(fmaxf(__builtin_amdgcn_logf(g), -120.0f));
                const float c = up ? __int_as_float(__builtin_amdgcn_readlane(__float_as_int(bb), 47)) : __int_as_float(__builtin_amdgcn_readlane(__float_as_int(bb), 15));
                const float bl = up ? __int_as_float(__builtin_amdgcn_readlane(__float_as_int(bb), 63)) : __int_as_float(__builtin_amdgcn_readlane(__float_as_int(bb), 31));
                const float e1 = __builtin_amdgcn_exp2f(bb - c), e2 = __builtin_amdgcn_exp2f(c - bb), ec = __builtin_amdgcn_exp2f(c), ebc = __builtin_amdgcn_exp2f(bl - c);
                qp[e] = q * e1; kp[e] = key * e2; qs[e] = qp[e] * ec; kh[e] = kp[e] * ebc;
                if ((lane & 31) == 31) *(LAS float*)(L + OFF_E + (ch0 * 8 + e) * 4) = __builtin_amdgcn_exp2f(bl); }
#pragma unroll
            for (int e = 0; e < 4; ++e) { oqp[e] = pk2(qp[2 * e], qp[2 * e + 1]); okp[e] = pk2(kp[2 * e], kp[2 * e + 1]); oqs[e] = pk2(qs[2 * e], qs[2 * e + 1]); okh[e] = pk2(kh[2 * e], kh[2 * e + 1]); }
            *(LAS v4u*)(L + OFF_QP + lrow) = oqp; *(LAS v4u*)(L + OFF_KP + lrow) = okp; *(LAS v4u*)(L + OFF_QS + lrow) = oqs; *(LAS v4u*)(L + OFF_KH + limg) = okh; *(LAS v4u*)(L + OFF_V + limg) = cv;
        }
        __syncthreads();
        if (wid < 3) { const int mi = wid >= 1 ? 1 : 0, ni = wid == 2 ? 1 : 0; f32x4 acc = {0.f, 0.f, 0.f, 0.f};
            const unsigned qa = OFF_QP + (mi * 16 + (lane & 15)) * TP + (lane >> 4) * 16, ka = OFF_KP + (ni * 16 + (lane & 15)) * TP + (lane >> 4) * 16;
#pragma unroll
            for (int ks = 0; ks < 4; ++ks) { const bf16x8 a = *(const LAS bf16x8*)(L + qa + ks * 64); const bf16x8 bfr = *(const LAS bf16x8*)(L + ka + ks * 64); acc = MFMA16(a, bfr, acc); }
            const int tq = 4 * (lane >> 4), sc = lane & 15;
#pragma unroll
            for (int r = 0; r < 4; ++r) { const float v = (mi != ni || tq + r >= sc) ? acc[r] : 0.f; *(LAS bf16*)(L + OFF_A + (mi * 16 + tq + r) * 80 + (ni * 16 + sc) * 2) = (bf16)f2bf(v); } }
        else if (wid == 3 && cidx == 0) { const int t = lane >> 2, s0 = 16 + 4 * (lane & 3); *(LAS v2u*)(L + OFF_A + t * 80 + s0 * 2) = (v2u){0u, 0u}; }
        __syncthreads();
        {
            const unsigned lbase = (unsigned)(uintptr_t)L, hi = lane >> 5, g4 = lane >> 4, q4 = (lane & 15) >> 2, p4 = lane & 3, blk = (lane >> 4) & 1;
            const int mk = wid >> 1, nv0 = 2 * (wid & 1);
            s16x4 v16[2], ka[2][2], vb[2][2][2];
#pragma unroll
            for (int t = 0; t < 2; ++t) { const unsigned row = 8 * g4 + 4 * t + q4; v16[t] = tr_off<0>(lbase + OFF_V + img_off(row, 2 * wid + (p4 >> 1)) + 8 * (p4 & 1)); }
#pragma unroll
            for (int t = 0; t < 2; ++t) { const unsigned row = 8 * hi + 4 * t + q4, sw = (q4 << 2) | ((2 * hi + t) & 3u), lo8 = 8 * (p4 & 1);
                const unsigned kb = lbase + OFF_KH + 256u * row + 16u * ((unsigned)(4 * mk + 2 * blk + (p4 >> 1)) ^ sw) + lo8;
                ka[0][t] = tr_off<0>(kb); ka[1][t] = tr_off<4096>(kb);
#pragma unroll
                for (int nvi = 0; nvi < 2; ++nvi) { const unsigned vbb = lbase + OFF_V + 256u * row + 16u * ((unsigned)(4 * (nv0 + nvi) + 2 * blk + (p4 >> 1)) ^ sw) + lo8;
                    vb[nvi][0][t] = tr_off<0>(vbb); vb[nvi][1][t] = tr_off<4096>(vbb); } }
            LDS_WAIT_PIN();
            const bf16x8 vfr = CAT8(v16[0], v16[1]);
            f32x4 accO[2];
            const unsigned aa = OFF_A + (lane & 15) * 80 + g4 * 16, qa = OFF_QS + (lane & 15) * TP + g4 * 16, sa = SBc + (16 * wid + (lane & 15)) * TP + g4 * 16;
#pragma unroll
            for (int mi = 0; mi < 2; ++mi) { accO[mi] = (f32x4){0.f, 0.f, 0.f, 0.f};
                const bf16x8 afr = *(const LAS bf16x8*)(L + aa + mi * 16 * 80);
                accO[mi] = MFMA16(afr, vfr, accO[mi]);
#pragma unroll
                for (int ks = 0; ks < 4; ++ks) { const bf16x8 qf = *(const LAS bf16x8*)(L + qa + mi * 16 * TP + ks * 64); const bf16x8 sf = *(const LAS bf16x8*)(L + sa + ks * 64); accO[mi] = MFMA16(qf, sf, accO[mi]); } }
            { bf16* ob = OUT + (size_t)ROWLO(cidx) * 2048 + h * 128 + 16 * wid; const int t0 = 4 * g4;
              const unsigned o0 = (unsigned)(((dir ? 31 - t0 : t0) * 2048 + (lane & 15)) * 2); const int sgn = dir ? -4096 : 4096;
#pragma unroll
              for (int mi = 0; mi < 2; ++mi)
#pragma unroll
                  for (int r = 0; r < 4; ++r) *(bf16*)((char*)ob + (o0 + (unsigned)(sgn * (16 * mi + r)))) = (bf16)f2bf(accO[mi][r]); }
            const unsigned sbw = SBn + (lane & 31) * TP + (32 * mk) * 2 + 8 * hi;
#pragma unroll
            for (int nvi = 0; nvi < 2; ++nvi) {
#pragma unroll
                for (int g = 0; g < 4; ++g) { const f32x4 ev = *(const LAS f32x4*)(L + OFF_E + (32 * mk + 8 * g + 4 * hi) * 4);
#pragma unroll
                    for (int j = 0; j < 4; ++j) accS[nvi][4 * g + j] *= ev[j]; }
#pragma unroll
                for (int ks = 0; ks < 2; ++ks) accS[nvi] = MFMA32(CAT8(ka[ks][0], ka[ks][1]), CAT8(vb[nvi][ks][0], vb[nvi][ks][1]), accS[nvi]);
#pragma unroll
                for (int g = 0; g < 4; ++g) { v2u w; w.x = pk2(accS[nvi][4 * g], accS[nvi][4 * g + 1]); w.y = pk2(accS[nvi][4 * g + 2], accS[nvi][4 * g + 3]);
                    *(LAS v2u*)(L + sbw + 32 * (nv0 + nvi) * TP + g * 16) = w; }
            }
        }
        __syncthreads();
    }
#undef HLOAD
#undef ROWLO
}
}
namespace rt {
constexpr int QP = 528, SBP = 528, PP = 144;
constexpr int OFF_Q = 0, OFF_K = OFF_Q + 64 * QP, OFF_V = OFF_K + 32768, OFF_P = OFF_V + 16384, OFF_SB = OFF_P + 64 * PP, LDS_END = OFF_SB + 128 * SBP;
static_assert(LDS_END <= MISC_OFF, "retention LDS map");
constexpr int NCH = 4 + 64;
template <int OFF> DI s16x4 tr_off(unsigned base) { s16x4 r; asm volatile("ds_read_b64_tr_b16 %0, %1 offset:%2" : "=&v"(r) : "v"(base), "i"(OFF) : "memory"); return r; }
DI void unit(Frame& F, int li, int b, int h, int dir, int vs) {
    const int tid = F.tid, wid = F.wave, lane0 = F.lane;
    const bf16* P = WSP(bf16, WS_P); bf16* OUT = dir ? WSP(bf16, WS_OBO) : WSP(bf16, WS_OFO);
    LAS unsigned char* L = F.lds;
    const float dl = F.ret_decay[((size_t)li * 2 + dir) * 16 + h];
    const float l2g = -log1pf(expf(-dl)) * 1.4426950408889634f;
    const float g64 = exp2f(64.0f * l2g);
    f32x16 accS[4];
#pragma unroll
    for (int i = 0; i < 4; ++i)
#pragma unroll
        for (int r = 0; r < 16; ++r) accS[i][r] = 0.f;
    const int qrow = tid >> 5, qc = tid & 31, vrow = tid >> 4, vc = tid & 15;
    unsigned gq[4], gv[2]; float vw[2];
#pragma unroll
    for (int i = 0; i < 4; ++i) { const int r = qrow + 16 * i; gq[i] = (unsigned)(((dir ? 63 - r : r) * O_END + qc * 8) * 2); }
#pragma unroll
    for (int i = 0; i < 2; ++i) { const int r = vrow + 32 * i; gv[i] = (unsigned)(((dir ? 63 - r : r) * O_END + vc * 8) * 2); vw[i] = exp2f((float)(63 - r) * l2g); }
    const unsigned lq = OFF_Q + qrow * QP + qc * 16, lk = OFF_K + (qc >> 4) * 16384 + img_off(qrow, qc & 15), lv = OFF_V + img_off(vrow, vc);
    v4u sq[4], sk[4], sv[2];
#define ROWLO(ci) ((ci) < 4 ? M_LAT + b * CTXL + (dir ? CTXL - 64 - (ci) * 64 : (ci) * 64) : b * SEQ + (dir ? SEQ - 64 - ((ci) - 4) * 64 : ((ci) - 4) * 64))
#define RLOAD(ci) do { const char* pb_ = (const char*)(P + (size_t)ROWLO(ci) * O_END + h * 256); const char* pv_ = (const char*)(P + (size_t)ROWLO(ci) * O_END + O_V + h * 512 + vs * 128); \
        _Pragma("unroll") for (int i = 0; i < 4; ++i) { sq[i] = *(const v4u*)(pb_ + gq[i]); sk[i] = *(const v4u*)(pb_ + O_K * 2 + gq[i]); } \
        _Pragma("unroll") for (int i = 0; i < 2; ++i) sv[i] = *(const v4u*)(pv_ + gv[i]); } while (0)
    RLOAD(0);
    const int nv = wid & 3, mk0 = 4 * (wid >> 2), mt = wid >> 2;
    if (tid < 256) { const int blk = tid >> 7, e = tid & 127, t = 32 * blk + (e >> 3), s0 = 32 * blk + 16 + 2 * (e & 7); *(LAS unsigned*)(L + OFF_P + t * PP + s0 * 2) = 0u; }
    for (int cidx = 0; cidx < NCH; ++cidx) {
        int lane = lane0; asm volatile("" : "+v"(lane));
        const int r32 = lane & 31, hi = lane >> 5;
#pragma unroll
        for (int i = 0; i < 4; ++i) { *(LAS v4u*)(L + lq + i * 16 * QP) = sq[i]; *(LAS v4u*)(L + lk + i * 4096) = sk[i]; }
#pragma unroll
        for (int i = 0; i < 2; ++i) { v4u o;
#pragma unroll
            for (int e = 0; e < 4; ++e) o[e] = pk2(bflo(sv[i][e]) * vw[i], bfhi(sv[i][e]) * vw[i]);
            *(LAS v4u*)(L + lv + i * 8192) = o; }
        if (cidx + 1 < NCH) RLOAD(cidx + 1);
        __syncthreads();
        {
#pragma unroll
            for (int rep = 0; rep < 2; ++rep) { const int tl = wid + 8 * rep;
                if (tl < 10) { const int mi = tl >= 6 ? 3 : (tl >= 3 ? 2 : (tl >= 1 ? 1 : 0)), ni = tl - (mi * (mi + 1)) / 2; f32x4 acc = {0.f, 0.f, 0.f, 0.f};
                    const unsigned qa = OFF_Q + (mi * 16 + (lane & 15)) * QP + (lane >> 4) * 16;
                    const unsigned krow = ni * 16 + (lane & 15), ksw = ((krow & 3u) << 2) | ((krow >> 2) & 3u), kb = OFF_K + 256u * krow;
#pragma unroll
                    for (int ks = 0; ks < 8; ++ks) { const bf16x8 a = *(const LAS bf16x8*)(L + qa + ks * 64);
                        const bf16x8 bfr = *(const LAS bf16x8*)(L + kb + (ks >> 2) * 16384 + 16u * ((unsigned)(4 * (ks & 3) + (lane >> 4)) ^ ksw)); acc = MFMA16(a, bfr, acc); }
                    const int tq = 4 * (lane >> 4), sc = lane & 15;
#pragma unroll
                    for (int r = 0; r < 4; ++r) { const float v = (mi != ni || tq + r >= sc) ? acc[r] : 0.f;
                        *(LAS bf16*)(L + OFF_P + (mi * 16 + tq + r) * PP + (ni * 16 + sc) * 2) = (bf16)f2bf(v); } } }
            const unsigned sbw = OFF_SB + (32 * nv + r32) * SBP + 8 * hi;
#pragma unroll
            for (int i = 0; i < 4; ++i) {
#pragma unroll
                for (int r = 0; r < 16; ++r) accS[i][r] *= g64;
#pragma unroll
                for (int g = 0; g < 4; ++g) { v2u w; w.x = pk2(accS[i][4 * g], accS[i][4 * g + 1]); w.y = pk2(accS[i][4 * g + 2], accS[i][4 * g + 3]);
                    *(LAS v2u*)(L + sbw + (mk0 + i) * 64 + g * 16) = w; } } }
        __syncthreads();
        {
            const unsigned lbase = (unsigned)(uintptr_t)L;
            const unsigned q4 = (lane & 15) >> 2, p4 = lane & 3, blk = (lane >> 4) & 1;
            unsigned vbase[2], kbase[4][2];
#pragma unroll
            for (int t = 0; t < 2; ++t) { const unsigned row = 8 * hi + 4 * t + q4, sw = (q4 << 2) | ((2 * hi + t) & 3u);
                vbase[t] = lbase + OFF_V + 256u * row + 16u * ((unsigned)(4 * nv + 2 * blk + (p4 >> 1)) ^ sw) + 8 * (p4 & 1);
#pragma unroll
                for (int c = 0; c < 4; ++c) kbase[c][t] = lbase + OFF_K + (mk0 >> 2) * 16384 + 256u * row + 16u * ((unsigned)(4 * c + 2 * blk + (p4 >> 1)) ^ sw) + 8 * (p4 & 1); }
            s16x4 vf[4][2];
            vf[0][0] = tr_off<0>(vbase[0]); vf[0][1] = tr_off<0>(vbase[1]); vf[1][0] = tr_off<4096>(vbase[0]); vf[1][1] = tr_off<4096>(vbase[1]);
            vf[2][0] = tr_off<8192>(vbase[0]); vf[2][1] = tr_off<8192>(vbase[1]); vf[3][0] = tr_off<12288>(vbase[0]); vf[3][1] = tr_off<12288>(vbase[1]);
            LDS_WAIT_PIN();
            f32x16 accO;
#pragma unroll
            for (int r = 0; r < 16; ++r) accO[r] = 0.f;
            const unsigned pa = OFF_P + (32 * mt + r32) * PP + 16 * hi, qa = OFF_Q + (32 * mt + r32) * QP + 16 * hi, sa = OFF_SB + (32 * nv + r32) * SBP + 16 * hi;
#pragma unroll
            for (int ks = 0; ks < 4; ++ks) { if (ks < 2 || mt == 1) { const bf16x8 pf = *(const LAS bf16x8*)(L + pa + ks * 32); accO = MFMA32(pf, CAT8(vf[ks][0], vf[ks][1]), accO); } }
#pragma unroll
            for (int kg = 0; kg < 4; ++kg) {
#pragma unroll
                for (int kk = 0; kk < 4; ++kk) { const int ks = 4 * kg + kk;
                    const bf16x8 qf = *(const LAS bf16x8*)(L + qa + ks * 32); const bf16x8 sf = *(const LAS bf16x8*)(L + sa + ks * 32); accO = MFMA32(qf, sf, accO); }
                asm volatile("" ::: "memory"); }
            { bf16* ob = OUT + (size_t)ROWLO(cidx) * 8192 + h * 512 + vs * 128 + 32 * nv;
              const int tl0 = 32 * mt + 4 * hi; const unsigned o0 = (unsigned)(((dir ? 63 - tl0 : tl0) * 8192 + r32) * 2); const int sgn = dir ? -16384 : 16384;
#pragma unroll
              for (int r = 0; r < 16; ++r) *(bf16*)((char*)ob + (o0 + (unsigned)(sgn * ((r & 3) + 8 * (r >> 2))))) = (bf16)f2bf(accO[r]); }
#pragma unroll
            for (int i = 0; i < 4; ++i) { s16x4 kf[4][2];
                kf[0][0] = tr_off<0>(kbase[i][0]); kf[0][1] = tr_off<0>(kbase[i][1]); kf[1][0] = tr_off<4096>(kbase[i][0]); kf[1][1] = tr_off<4096>(kbase[i][1]);
                kf[2][0] = tr_off<8192>(kbase[i][0]); kf[2][1] = tr_off<8192>(kbase[i][1]); kf[3][0] = tr_off<12288>(kbase[i][0]); kf[3][1] = tr_off<12288>(kbase[i][1]);
                LDS_WAIT_PIN();
#pragma unroll
                for (int ks = 0; ks < 4; ++ks) accS[i] = MFMA32(CAT8(kf[ks][0], kf[ks][1]), CAT8(vf[ks][0], vf[ks][1]), accS[i]); }
        }
        __syncthreads();
    }
#undef RLOAD
#undef ROWLO
}
}
#ifndef MK_MULTI
#define MK_MULTI 0
#endif
constexpr int N_PHASES = 2 + 2 * 14;
struct Args { const float* in[20]; float* out; unsigned char* ws; int ph_lo, ph_hi; };
__global__ void __launch_bounds__(NWAVES * 64, 2) fwd_kernel(Args args) {
    extern __shared__ __attribute__((aligned(16))) unsigned char lds_raw[];
    Frame F0;
    F0.lds = (LAS unsigned char*)lds_raw;
    F0.tid = threadIdx.x; F0.lane = F0.tid & 63; F0.wave = __builtin_amdgcn_readfirstlane(F0.tid >> 6);
    F0.G = gridDim.x; { const int bx = blockIdx.x; F0.vcu = (F0.G % 8 == 0) ? (bx % 8) * (F0.G / 8) + bx / 8 : bx; }
    F0.ws = args.ws; F0.out = args.out;
    LAS unsigned* MISC = (LAS unsigned*)(F0.lds + MISC_OFF);
    if (F0.tid < 16) MISC[F0.tid] = 0u;
    if (F0.tid < 20) { const unsigned long long pv = (unsigned long long)(uintptr_t)args.in[F0.tid]; MISC[16 + 2 * F0.tid] = (unsigned)pv; MISC[17 + 2 * F0.tid] = (unsigned)(pv >> 32); }
    __syncthreads();
    unsigned* ctl = (unsigned*)(F0.ws + WS_CTL);
    if (!MK_MULTI) (void)xcd_barrier_post(ctl + CW_BAR, (volatile LAS unsigned*)(MISC + 8));
#define GRID_BAR() do { XcdBarrier b_; b_.bar = (unsigned*)(F0.ws + WS_CTL) + CW_BAR; b_.x = xb_xcc_id(); b_.st = (volatile LAS unsigned*)(F0.lds + MISC_OFF + 32); xcd_barrier(b_); } while (0)
    const int lo = args.ph_lo, hi = args.ph_hi;
    int ph = 0;
#ifndef PHASE_MASK
#define PHASE_MASK 0xFFFFFFFFu
#endif
#ifndef RT_REPS
#define RT_REPS 1
#endif
#ifndef REP_MASK
#define REP_MASK 0u
#endif
#define PH_BEGIN(kind) if ((((PHASE_MASK) >> (kind)) & 1u) && lo <= ph && ph < hi) for (int rep_ = 0; rep_ < ((((REP_MASK) >> (kind)) & 1u) ? 2 : 1); ++rep_) { if (rep_) __syncthreads(); Frame F = F0; { int t_ = F0.tid; asm volatile("" : "+v"(t_)); F.tid = t_; F.lane = t_ & 63; F.wave = __builtin_amdgcn_readfirstlane(t_ >> 6); } LOADPTRS(F);
#define PH_END   } if (!MK_MULTI && lo <= ph && ph + 1 < hi) GRID_BAR(); ++ph;
#define PH_END_NOBAR }

    PH_BEGIN(0) ph_prologue(F); PH_END
    PH_BEGIN(1) ph_finalize(F); PH_END
    float* XS = (float*)(F0.ws + WS_XS);
    { constexpr int L2 = 0;
        { const int l = 2 * L2, i = L2;
          const bool first = (L2 == 0);
          PH_BEGIN(2) ph_ada_in(F, l, first ? F.x : XS, first ? F.ctx : XS + (size_t)M_LAT * DM); PH_END
          PH_BEGIN(3) { pg8::Gemm g{WSP(pg8::bf16_t, WS_H), WSP(pg8::bf16_t, WS_WINE) + (size_t)i * E_PAD * DM, MT, E_PAD, DM}; pg8::StaticOrder S; S.init(MT, E_PAD, F.G, (int)blockIdx.x);
                     pg8::EpiBf16 E{WSP(pg8::bf16_t, WS_P), E_PAD}; pg8::gemm_phase<pg8::EpiBf16, pg8::StaticOrder, PG8_ALIGN, PG8_SP2>(F.lds, g, S, E); } PH_END
          PH_BEGIN(4) ph_lora_norm(F, i); PH_END
          PH_BEGIN(5) { { pg8::Gemm g{WSP(pg8::bf16_t, WS_CQN), WSP(pg8::bf16_t, WS_WUQ) + (size_t)i * NQ * Q_LORA, MT, NQ, Q_LORA}; pg8::StaticOrder S; S.init(MT, NQ, F.G, (int)blockIdx.x);
                       pg8::EpiBf16 E{WSP(pg8::bf16_t, WS_QF), NQ}; pg8::gemm_phase<pg8::EpiBf16, pg8::StaticOrder, PG8_ALIGN, PG8_SP2>(F.lds, g, S, E); } __syncthreads(); } PH_END_NOBAR
          PH_BEGIN(16) { { pg8::Gemm g{WSP(pg8::bf16_t, WS_CKVN), WSP(pg8::bf16_t, WS_WUKV) + (size_t)i * NKV * KV_LORA, MT, NKV, KV_LORA}; pg8::StaticOrder S; S.init(MT, NKV, F.G, (int)blockIdx.x);
                       pg8::EpiBf16 E{WSP(pg8::bf16_t, WS_KV), NKV}; pg8::gemm_phase<pg8::EpiBf16, pg8::StaticOrder, PG8_ALIGN, PG8_SP2>(F.lds, g, S, E); } } PH_END
          PH_BEGIN(6) ph_qk_norm_rope(F, i); PH_END
          PH_BEGIN(17) { for (int s = 0; s < 128; ++s) if ((64 + s) % F.G == F.vcu) { hg::unit(F, i, s >> 5, (s >> 1) & 15, s & 1); __syncthreads(); } } PH_END_NOBAR
          PH_BEGIN(7) {
#ifndef NO_ATT
              for (int u = F.vcu; u < 1088; u += F.G) {
                  if (u < 1024) { const int b = u >> 8, h = (u >> 4) & 15, qb = u & 15; att::unit(F, h, b * SEQ + qb * 256, b * SEQ, 64, M_LAT + b * CTXL, 68, E_PAD); }
                  else { const int v = u - 1024, b = v >> 4, h = v & 15; att::unit(F, h, M_LAT + b * CTXL, 0, 0, M_LAT + b * CTXL, 4, E_PAD); } }
#endif
              } PH_END
          PH_BEGIN(8) ph_hg_merge(F, i); PH_END
          PH_BEGIN(9) { pg8::Gemm g{WSP(pg8::bf16_t, WS_A), WSP(pg8::bf16_t, WS_WOE) + (size_t)i * DM * DM, MT, DM, DM}; pg8::StaticOrder S; S.init(MT, DM, F.G, (int)blockIdx.x);
                     pg8::EpiRes E{first ? F.x : XS, first ? F.ctx : XS + (size_t)M_LAT * DM, XS, XS + (size_t)M_LAT * DM, WSP(float, WS_MOD) + (size_t)l * 5 * MODW + 2 * DM};
                     pg8::gemm_phase<pg8::EpiRes, pg8::StaticOrder, PG8_ALIGN, PG8_SP2>(F.lds, g, S, E); } PH_END
        }
        { const int l = 2 * L2 + 1, i = L2; const bool last = (L2 == 1);
          PH_BEGIN(10) ph_ada_in(F, l, XS, XS + (size_t)M_LAT * DM); PH_END
          PH_BEGIN(11) { pg8::Gemm g{WSP(pg8::bf16_t, WS_H), WSP(pg8::bf16_t, WS_WINO) + (size_t)i * O_END * DM, MT, O_END, DM}; pg8::StaticOrder S; S.init(MT, O_END, F.G, (int)blockIdx.x);
                     pg8::EpiBf16 E{WSP(pg8::bf16_t, WS_P), O_END}; pg8::gemm_phase<pg8::EpiBf16, pg8::StaticOrder, PG8_ALIGN, PG8_SP2>(F.lds, g, S, E); } PH_END
          PH_BEGIN(12) ph_ret_rope(F); PH_END
          PH_BEGIN(13) { for (int u0 = F.vcu; u0 < 512 * RT_REPS; u0 += F.G) { const int u = u0 & 511; rt::unit(F, i, u >> 7, (u >> 3) & 15, (u >> 2) & 1, u & 3); __syncthreads(); } } PH_END
          PH_BEGIN(14) ph_ret_merge(F, i); PH_END
          PH_BEGIN(15) { const int M = last ? M_LAT : MT; pg8::Gemm g{WSP(pg8::bf16_t, WS_A), WSP(pg8::bf16_t, WS_WOO) + (size_t)i * DM * 8192, M, DM, 8192}; pg8::StaticOrder S; S.init(M, DM, F.G, (int)blockIdx.x);
                     pg8::EpiRes E{XS, XS + (size_t)M_LAT * DM, last ? F.out : XS, XS + (size_t)M_LAT * DM, WSP(float, WS_MOD) + (size_t)l * 5 * MODW + 2 * DM};
                     pg8::gemm_phase<pg8::EpiRes, pg8::StaticOrder, PG8_ALIGN, PG8_SP2>(F.lds, g, S, E); } PH_END
        }
    }
    { constexpr int L2 = 1;
        { const int l = 2 * L2, i = L2;
          const bool first = (L2 == 0);
          PH_BEGIN(2) ph_ada_in(F, l, first ? F.x : XS, first ? F.ctx : XS + (size_t)M_LAT * DM); PH_END
          PH_BEGIN(3) { pg8::Gemm g{WSP(pg8::bf16_t, WS_H), WSP(pg8::bf16_t, WS_WINE) + (size_t)i * E_PAD * DM, MT, E_PAD, DM}; pg8::StaticOrder S; S.init(MT, E_PAD, F.G, (int)blockIdx.x);
                     pg8::EpiBf16 E{WSP(pg8::bf16_t, WS_P), E_PAD}; pg8::gemm_phase<pg8::EpiBf16, pg8::StaticOrder, PG8_ALIGN, PG8_SP2>(F.lds, g, S, E); } PH_END
          PH_BEGIN(4) ph_lora_norm(F, i); PH_END
          PH_BEGIN(5) { { pg8::Gemm g{WSP(pg8::bf16_t, WS_CQN), WSP(pg8::bf16_t, WS_WUQ) + (size_t)i * NQ * Q_LORA, MT, NQ, Q_LORA}; pg8::StaticOrder S; S.init(MT, NQ, F.G, (int)blockIdx.x);
                       pg8::EpiBf16 E{WSP(pg8::bf16_t, WS_QF), NQ}; pg8::gemm_phase<pg8::EpiBf16, pg8::StaticOrder, PG8_ALIGN, PG8_SP2>(F.lds, g, S, E); } __syncthreads(); } PH_END_NOBAR
          PH_BEGIN(16) { { pg8::Gemm g{WSP(pg8::bf16_t, WS_CKVN), WSP(pg8::bf16_t, WS_WUKV) + (size_t)i * NKV * KV_LORA, MT, NKV, KV_LORA}; pg8::StaticOrder S; S.init(MT, NKV, F.G, (int)blockIdx.x);
                       pg8::EpiBf16 E{WSP(pg8::bf16_t, WS_KV), NKV}; pg8::gemm_phase<pg8::EpiBf16, pg8::StaticOrder, PG8_ALIGN, PG8_SP2>(F.lds, g, S, E); } } PH_END
          PH_BEGIN(6) ph_qk_norm_rope(F, i); PH_END
          PH_BEGIN(17) { for (int s = 0; s < 128; ++s) if ((64 + s) % F.G == F.vcu) { hg::unit(F, i, s >> 5, (s >> 1) & 15, s & 1); __syncthreads(); } } PH_END_NOBAR
          PH_BEGIN(7) {
#ifndef NO_ATT
              for (int u = F.vcu; u < 1088; u += F.G) {
                  if (u < 1024) { const int b = u >> 8, h = (u >> 4) & 15, qb = u & 15; att::unit(F, h, b * SEQ + qb * 256, b * SEQ, 64, M_LAT + b * CTXL, 68, E_PAD); }
                  else { const int v = u - 1024, b = v >> 4, h = v & 15; att::unit(F, h, M_LAT + b * CTXL, 0, 0, M_LAT + b * CTXL, 4, E_PAD); } }
#endif
              } PH_END
          PH_BEGIN(8) ph_hg_merge(F, i); PH_END
          PH_BEGIN(9) { pg8::Gemm g{WSP(pg8::bf16_t, WS_A), WSP(pg8::bf16_t, WS_WOE) + (size_t)i * DM * DM, MT, DM, DM}; pg8::StaticOrder S; S.init(MT, DM, F.G, (int)blockIdx.x);
                     pg8::EpiRes E{first ? F.x : XS, first ? F.ctx : XS + (size_t)M_LAT * DM, XS, XS + (size_t)M_LAT * DM, WSP(float, WS_MOD) + (size_t)l * 5 * MODW + 2 * DM};
                     pg8::gemm_phase<pg8::EpiRes, pg8::StaticOrder, PG8_ALIGN, PG8_SP2>(F.lds, g, S, E); } PH_END
        }
        { const int l = 2 * L2 + 1, i = L2; const bool last = (L2 == 1);
          PH_BEGIN(10) ph_ada_in(F, l, XS, XS + (size_t)M_LAT * DM); PH_END
          PH_BEGIN(11) { pg8::Gemm g{WSP(pg8::bf16_t, WS_H), WSP(pg8::bf16_t, WS_WINO) + (size_t)i * O_END * DM, MT, O_END, DM}; pg8::StaticOrder S; S.init(MT, O_END, F.G, (int)blockIdx.x);
                     pg8::EpiBf16 E{WSP(pg8::bf16_t, WS_P), O_END}; pg8::gemm_phase<pg8::EpiBf16, pg8::StaticOrder, PG8_ALIGN, PG8_SP2>(F.lds, g, S, E); } PH_END
          PH_BEGIN(12) ph_ret_rope(F); PH_END
          PH_BEGIN(13) { for (int u0 = F.vcu; u0 < 512 * RT_REPS; u0 += F.G) { const int u = u0 & 511; rt::unit(F, i, u >> 7, (u >> 3) & 15, (u >> 2) & 1, u & 3); __syncthreads(); } } PH_END
          PH_BEGIN(14) ph_ret_merge(F, i); PH_END
          PH_BEGIN(15) { const int M = last ? M_LAT : MT; pg8::Gemm g{WSP(pg8::bf16_t, WS_A), WSP(pg8::bf16_t, WS_WOO) + (size_t)i * DM * 8192, M, DM, 8192}; pg8::StaticOrder S; S.init(M, DM, F.G, (int)blockIdx.x);
                     pg8::EpiRes E{XS, XS + (size_t)M_LAT * DM, last ? F.out : XS, XS + (size_t)M_LAT * DM, WSP(float, WS_MOD) + (size_t)l * 5 * MODW + 2 * DM};
                     pg8::gemm_phase<pg8::EpiRes, pg8::StaticOrder, PG8_ALIGN, PG8_SP2>(F.lds, g, S, E); } PH_END
        }
    }
#undef PH_BEGIN
#undef PH_END
}

extern "C" void kernel_launch(void* const* d_in, const int* in_sizes, int n_in, void* d_out, int out_size, void* d_ws, size_t ws_size, hipStream_t stream) {
    static int grid = 0;
    if (grid == 0) {
        if (n_in != 20 || in_sizes[0] != M_LAT * DM || out_size != M_LAT * DM || ws_size < WS_END) {
            fprintf(stderr, "kernel_launch: shape mismatch (n_in %d, in0 %d, out %d, ws %zu need %zu); nothing launched\n", n_in, n_in > 0 ? in_sizes[0] : -1, out_size, ws_size, (size_t)WS_END); grid = -1; return; }
        int dev = 0, cus = 0, per_cu = 0;
        if (hipGetDevice(&dev) != hipSuccess || hipDeviceGetAttribute(&cus, hipDeviceAttributeMultiprocessorCount, dev) != hipSuccess) { grid = -1; return; }
        if (hipFuncSetAttribute((const void*)fwd_kernel, hipFuncAttributeMaxDynamicSharedMemorySize, LDS_BYTES) != hipSuccess) { fprintf(stderr, "kernel_launch: hipFuncSetAttribute failed\n"); grid = -1; return; }
        if (hipOccupancyMaxActiveBlocksPerMultiprocessor(&per_cu, (const void*)fwd_kernel, NWAVES * 64, LDS_BYTES) != hipSuccess || per_cu < 1) { fprintf(stderr, "kernel_launch: occupancy query says %d\n", per_cu); }
        (void)hipGetLastError();
        grid = cus;
    }
    if (grid < 0) return;
    if (hipMemsetAsync((char*)d_ws + WS_CTL, 0, CTL_ZERO_BYTES, stream) != hipSuccess) return;
    Args a{};
    for (int i = 0; i < 20; ++i) a.in[i] = (const float*)d_in[i];
    a.out = (float*)d_out; a.ws = (unsigned char*)d_ws;
#if MK_MULTI
#ifndef DBG_HI
#define DBG_HI N_PHASES
#endif
#ifndef DBG_LO
#define DBG_LO 0
#endif
    for (int p = DBG_LO; p < DBG_HI; ++p) { a.ph_lo = p; a.ph_hi = p + 1; hipLaunchKernelGGL(fwd_kernel, dim3(grid), dim3(NWAVES * 64), LDS_BYTES, stream, a); }
#else
    a.ph_lo = 0; a.ph_hi = N_PHASES; hipLaunchKernelGGL(fwd_kernel, dim3(grid), dim3(NWAVES * 64), LDS_BYTES, stream, a);
#endif
    const hipError_t le = hipPeekAtLastError();
    if (le != hipSuccess) fprintf(stderr, "kernel_launch: launch failed: %s\n", hipGetErrorName(le));
}
```

```cpp
#include <hip/hip_runtime.h>
#include <cstdio>
#include <cstdint>
namespace pg8 {
#define PG8_LAS __attribute__((address_space(3)))
typedef unsigned short bf16_t;
typedef short bf16x8 __attribute__((ext_vector_type(8)));
typedef float f32x4 __attribute__((ext_vector_type(4)));
typedef unsigned u32x4 __attribute__((ext_vector_type(4)));
constexpr int BM = 256, BK = 64, HALF = 128, HTB = HALF * BK * 2  , STAGE_BYTES = 8 * HTB, NXCD = 8, WGM = 8;

__host__ __device__ __forceinline__ int lds_byte(int r, int c) { const int st = (r >> 4) * 2 + (c >> 5), rr = r & 15, cc = c & 31, ob = rr * 64 + cc * 2; return st * 1024 + (ob ^ (((ob >> 9) & 1) << 5)); }
__host__ __device__ __forceinline__ void stage_rc(int b, int& R, int& C) { const int st = b / 1024, sb = b % 1024, swz = sb ^ (((sb >> 9) & 1) << 5); R = (st >> 1) * 16 + swz / 64; C = (st & 1) * 32 + (swz % 64) / 2; }
__host__ __device__ __forceinline__ int perm32(int rho) { const int n = rho >> 4, i = rho & 15; return 8 * (i >> 2) + 4 * n + (i & 3); }

struct Unit { int pm, pn, kq; };
struct Gemm { const bf16_t* A; const bf16_t* Bt; int M, N, K; int ld; };

struct StaticOrder {
    int nM, nN, nwg, G, c;
    __host__ __device__ void init(int M, int N, int G_, int c_) { nM = M / BM; nN = N / BM; nwg = nM * nN; G = G_; c = c_; }
    __host__ __device__ bool next(int i, Unit& u) const { return tile((long)i * G + c, u); }
    __host__ __device__ bool tile(long L, Unit& u) const {
        if (L >= nwg) return false;
        int wgid = (int)L; { const int q = nwg / NXCD, r = nwg % NXCD, xcd = wgid % NXCD, off = wgid / NXCD; wgid = (xcd < r ? xcd * (q + 1) : r * (q + 1) + (xcd - r) * q) + off; }
        const int nig = WGM * nN, gid = wgid / nig, fm = gid * WGM, gsz = (nM - fm) < WGM ? (nM - fm) : WGM;
        u.pm = fm + ((wgid % nig) % gsz); u.pn = (wgid % nig) / gsz; return true;
    }
    __device__ __forceinline__ void a_ready(const Unit&) const {}
    __device__ __forceinline__ void done(const Unit&) const {}
    __device__ __forceinline__ size_t aoff(const Unit& u, size_t tstep) const { return (size_t)u.pm * tstep; }
    __device__ __forceinline__ size_t boff(const Unit& u, size_t tstep) const { return (size_t)u.pn * tstep; }
};
__device__ __forceinline__ unsigned cvt_pk_bf16(float lo, float hi) { unsigned r; asm volatile("v_cvt_pk_bf16_f32 %0, %1, %2" : "=v"(r) : "v"(lo), "v"(hi)); return r; }
struct EpiBf16 {
    static constexpr bool PERM = true, AFTER_DRAIN = false;
    bf16_t* O; int ldc;
    __device__ __forceinline__ void operator()(const f32x4 (&acc)[2][2][4][2], const Unit& u, int wr, int wc, int fr, int fq) const {
        const int row0 = u.pm * BM + wr * 64 + fr; const int col0 = u.pn * BM + wc * 32 + 8 * fq;
#pragma unroll
        for (int ai = 0; ai < 2; ++ai)
#pragma unroll
            for (int m = 0; m < 4; ++m) { bf16_t* rowp = O + (size_t)(row0 + ai * HALF + m * 16) * ldc + col0;
#pragma unroll
                for (int bj = 0; bj < 2; ++bj) { const f32x4 v0 = acc[ai][bj][m][0], v1 = acc[ai][bj][m][1];
                    u32x4 w; w.x = cvt_pk_bf16(v0[0], v0[1]); w.y = cvt_pk_bf16(v0[2], v0[3]); w.z = cvt_pk_bf16(v1[0], v1[1]); w.w = cvt_pk_bf16(v1[2], v1[3]);
                    *(u32x4*)(rowp + bj * HALF) = w; } }
    }
};
typedef unsigned u32x2 __attribute__((ext_vector_type(2)));
template <bool RES_BF16, bool OUT_BF16> struct EpiResT {
    static constexpr bool PERM = false, AFTER_DRAIN = false;
    const void* res; void* out; const float* gate_base;
    __device__ __forceinline__ void operator()(const f32x4 (&acc)[2][2][4][2], const Unit& u, int wr, int wc, int fr, int fq) const {
        const int seg = u.pm >> 4, lrow0 = u.pm * BM + wr * 64 + fr, col0 = u.pn * BM + wc * 32 + 4 * fq;
        const float* gate = gate_base + (size_t)seg * 12288;
        f32x4 gv[2][2];
#pragma unroll
        for (int bj = 0; bj < 2; ++bj)
#pragma unroll
            for (int n = 0; n < 2; ++n) gv[bj][n] = *(const f32x4*)(gate + col0 + bj * HALF + n * 16);
#pragma unroll
        for (int ai = 0; ai < 2; ++ai)
#pragma unroll
            for (int m = 0; m < 4; ++m) { const size_t off = (size_t)(lrow0 + ai * HALF + m * 16) * 4096 + col0;
#pragma unroll
                for (int bj = 0; bj < 2; ++bj)
#pragma unroll
                    for (int n = 0; n < 2; ++n) { const size_t o = off + bj * HALF + n * 16; f32x4 r;
                        if constexpr (RES_BF16) { const u32x2 w = *(const u32x2*)((const bf16_t*)res + o);
                            r = (f32x4){__uint_as_float(w.x << 16), __uint_as_float(w.x & 0xffff0000u), __uint_as_float(w.y << 16), __uint_as_float(w.y & 0xffff0000u)}; }
                        else r = *(const f32x4*)((const float*)res + o);
                        const f32x4 v = r + gv[bj][n] * acc[ai][bj][m][n];
                        if constexpr (OUT_BF16) { u32x2 w; w.x = cvt_pk_bf16(v[0], v[1]); w.y = cvt_pk_bf16(v[2], v[3]); *(u32x2*)((bf16_t*)out + o) = w; }
                        else *(f32x4*)((float*)out + o) = v; }
                asm volatile("" ::: "memory"); }
    }
};

struct EpiBf16Rope {
    static constexpr bool PERM = true, AFTER_DRAIN = false;
    bf16_t* O; int ldc; const float* cs; const float* sn;
    __device__ __forceinline__ void operator()(const f32x4 (&acc)[2][2][4][2], const Unit& u, int wr, int wc, int fr, int fq) const {
        const int row0 = u.pm * BM + wr * 64 + fr; const int col0 = u.pn * BM + wc * 32 + 8 * fq;
        const bool rope = u.pn < 32, lat = u.pm < 64; const float ksc = (u.pn >= 16 && u.pn < 32) ? 0.0625f : 1.0f;
#pragma unroll
        for (int ai = 0; ai < 2; ++ai)
#pragma unroll
            for (int m = 0; m < 4; ++m) { const int row = row0 + ai * HALF + m * 16; bf16_t* rowp = O + (size_t)row * ldc + col0;
                f32x4 a0 = acc[ai][0][m][0], a1 = acc[ai][0][m][1], b0 = acc[ai][1][m][0], b1 = acc[ai][1][m][1];
                if (rope) {
                    if (lat) { const size_t to = (size_t)(row & 4095) * 128 + wc * 32 + 8 * fq;
                        const f32x4 c0 = *(const f32x4*)(cs + to), c1 = *(const f32x4*)(cs + to + 4), s0 = *(const f32x4*)(sn + to), s1 = *(const f32x4*)(sn + to + 4);
                        const f32x4 x0 = a0 * c0 - b0 * s0, x1 = a1 * c1 - b1 * s1, y0 = a0 * s0 + b0 * c0, y1 = a1 * s1 + b1 * c1; a0 = x0; a1 = x1; b0 = y0; b1 = y1; }
                    a0 = a0 * ksc; a1 = a1 * ksc; b0 = b0 * ksc; b1 = b1 * ksc; }
                u32x4 w; w.x = cvt_pk_bf16(a0[0], a0[1]); w.y = cvt_pk_bf16(a0[2], a0[3]); w.z = cvt_pk_bf16(a1[0], a1[1]); w.w = cvt_pk_bf16(a1[2], a1[3]); *(u32x4*)(rowp) = w;
                u32x4 v; v.x = cvt_pk_bf16(b0[0], b0[1]); v.y = cvt_pk_bf16(b0[2], b0[3]); v.z = cvt_pk_bf16(b1[0], b1[1]); v.w = cvt_pk_bf16(b1[2], b1[3]); *(u32x4*)(rowp + HALF) = v; }
    }
};

struct LastOddOrder {
    StaticOrder lat; int G, c, nlat;
    __host__ __device__ void init(int G_, int c_) { lat.init(16384, 24576, G_, c_); G = G_; c = c_; nlat = 64 * 96; }
    __host__ __device__ bool next(int i, Unit& u) const {
        const long L = (long)i * G + c; if (L < nlat) return lat.next(i, u);
        const int r = (int)(L - nlat); if (r >= 4 * 48) return false;
        u.pm = 64 + (r & 3); u.pn = 16 + (r >> 2); return true;
    }
    __device__ __forceinline__ void a_ready(const Unit&) const {}
    __device__ __forceinline__ void done(const Unit&) const {}
    __device__ __forceinline__ size_t aoff(const Unit& u, size_t tstep) const { return (size_t)u.pm * tstep; }
    __device__ __forceinline__ size_t boff(const Unit& u, size_t tstep) const { return (size_t)u.pn * tstep; }
};
struct EvenInOrder {
    StaticOrder lat; int G, c;
    __host__ __device__ void init(int G_, int c_) { lat.init(16384, 14592, G_, c_); G = G_; c = c_; }
    __host__ __device__ bool next(int i, Unit& u) const {
        const long L = (long)i * G + c; if (L < 64 * 57) return lat.next(i, u);
        const int r = (int)(L - 64 * 57); if (r >= 4 * 48) return false;
        u.pm = 64 + (r & 3); u.pn = r >> 2; return true;
    }
    __device__ __forceinline__ void a_ready(const Unit&) const {}
    __device__ __forceinline__ void done(const Unit&) const {}
    __device__ __forceinline__ size_t aoff(const Unit& u, size_t tstep) const { return (size_t)u.pm * tstep; }
    __device__ __forceinline__ size_t boff(const Unit& u, size_t tstep) const { return (size_t)u.pn * tstep; }
};
struct UkvOrder {
    StaticOrder base; int G, c;
    __host__ __device__ void init(int M, int N, int G_, int c_) { base.init(M, N, G_, c_); G = G_; c = c_; }
    __host__ __device__ bool next(int i, Unit& u) const {
        if (G != 256 || base.nwg != 1088) return base.next(i, u);
        long L;
        if (i < 3) L = (long)i * 256 + c;
        else if (i == 3) { if (c < 48) return false; L = 768 + (c - 48); }
        else if (i == 4) { if (c < 48 || c >= 160) return false; L = 976 + (c - 48); }
        else return false;
        return base.tile(L, u);
    }
    __device__ __forceinline__ void a_ready(const Unit&) const {}
    __device__ __forceinline__ void done(const Unit&) const {}
    __device__ __forceinline__ size_t aoff(const Unit& u, size_t tstep) const { return (size_t)u.pm * tstep; }
    __device__ __forceinline__ size_t boff(const Unit& u, size_t tstep) const { return (size_t)u.pn * tstep; }
};
struct OddInOrder {
    StaticOrder lat; int G, c;
    __host__ __device__ void init(int G_, int c_) { lat.init(16384, 24576, G_, c_); G = G_; c = c_; }
    __host__ __device__ bool next(int i, Unit& u) const {
        const long L = (long)i * G + c; if (L < 64 * 96) return lat.next(i, u);
        const int r = (int)(L - 64 * 96); if (r >= 4 * 64) return false;
        u.pm = 64 + (r & 3); u.pn = r >> 2; return true;
    }
    __device__ __forceinline__ void a_ready(const Unit&) const {}
    __device__ __forceinline__ void done(const Unit&) const {}
    __device__ __forceinline__ size_t aoff(const Unit& u, size_t tstep) const { return (size_t)u.pm * tstep; }
    __device__ __forceinline__ size_t boff(const Unit& u, size_t tstep) const { return (size_t)u.pn * tstep; }
};
struct CtxSplitOrder {
    int G, c, kq_bytes, n, ns;
    __host__ __device__ void init(int G_, int c_, int K, int n_ = 256, int ns_ = 4) { G = G_; c = c_; kq_bytes = (K / ns_) * 2; n = n_; ns = ns_; }
    __host__ __device__ bool next(int i, Unit& u) const { const long L = (long)i * G + c; if (L >= n) return false; const int r = (int)L, t = r / ns; u.kq = r - t * ns; u.pm = t & 3; u.pn = t >> 2; return true; }
    __device__ __forceinline__ void a_ready(const Unit&) const {}
    __device__ __forceinline__ void done(const Unit&) const {}
    __device__ __forceinline__ size_t aoff(const Unit& u, size_t tstep) const { return (size_t)u.pm * tstep + (size_t)u.kq * kq_bytes; }
    __device__ __forceinline__ size_t boff(const Unit& u, size_t tstep) const { return (size_t)u.pn * tstep + (size_t)u.kq * kq_bytes; }
};
struct EpiPart {
    static constexpr bool PERM = false, AFTER_DRAIN = false;
    float* part; int pitch;
    __device__ __forceinline__ void operator()(const f32x4 (&acc)[2][2][4][2], const Unit& u, int wr, int wc, int fr, int fq) const {
        float* o = part + ((size_t)u.kq * 1024 + (size_t)u.pm * BM + wr * 64 + fr) * pitch + u.pn * BM + wc * 32 + 4 * fq;
#pragma unroll
        for (int ai = 0; ai < 2; ++ai)
#pragma unroll
            for (int m = 0; m < 4; ++m)
#pragma unroll
                for (int bj = 0; bj < 2; ++bj)
#pragma unroll
                    for (int n = 0; n < 2; ++n) *(f32x4*)(o + (size_t)(ai * HALF + m * 16) * pitch + bj * HALF + n * 16) = acc[ai][bj][m][n];
    }
};

template <class Epi, class Sched, bool ALIGN_EPI = false, bool SP2 = false>
__device__ __forceinline__ void gemm_phase(PG8_LAS unsigned char* lds, const Gemm g, const Sched& S, const Epi& E) {
    int tid = threadIdx.x; asm volatile("" : "+v"(tid));
    const int wid = __builtin_amdgcn_readfirstlane(tid >> 6), lane = tid & 63, wr = wid >> 2, wc = wid & 3, fr = lane & 15, fq = lane >> 4;
    const int K = g.ld ? g.ld : g.K, nt = g.K / BK;
    unsigned voffA[2], voffB[2];
#pragma unroll
    for (int i = 0; i < 2; ++i) { int R, C; stage_rc(tid * 16 + i * 8192, R, C); const int Rb = Epi::PERM ? ((R & ~31) + perm32(R & 31)) : R;
        voffA[i] = (unsigned)(R * K + C) * 2u; voffB[i] = (unsigned)(Rb * K + C) * 2u; }
    const size_t kstep = (size_t)(BK * 2);
    const size_t hstep = (size_t)HALF * K * 2;
    const size_t tstep = 2 * hstep;
    const unsigned ldsw = (unsigned)wid * 1024u;
    const int aoff = lds_byte(wr * 64 + fr, fq * 8), boff = lds_byte(wc * 32 + fr, fq * 8);
#define PG8_SA(b, h) (((b) * 2 + (h)) * HTB)
#define PG8_SB(b, h) ((4 + (b) * 2 + (h)) * HTB)
#define PG8_STAGE(bufoff, gbase, voff) do { _Pragma("unroll") for (int _i = 0; _i < 2; ++_i) \
        __builtin_amdgcn_global_load_lds((const unsigned*)((const char*)(gbase) + (voff)[_i]), (PG8_LAS unsigned*)(lds + (bufoff) + ldsw + _i * 8192), 16, 0, 0); } while (0)
#define PG8_LDA(dst, b, h) do { _Pragma("unroll") for (int m = 0; m < 4; ++m) _Pragma("unroll") for (int k = 0; k < 2; ++k) dst[m][k] = *(const PG8_LAS bf16x8*)(lds + PG8_SA(b, h) + aoff + m * 2048 + k * 1024); } while (0)
#define PG8_LDB(dst, b, h) do { _Pragma("unroll") for (int n = 0; n < 2; ++n) _Pragma("unroll") for (int k = 0; k < 2; ++k) dst[n][k] = *(const PG8_LAS bf16x8*)(lds + PG8_SB(b, h) + boff + n * 2048 + k * 1024); } while (0)
#define PG8_MMA(ai, bj, At, Bt) do { __builtin_amdgcn_s_setprio(1); _Pragma("unroll") for (int m = 0; m < 4; ++m) _Pragma("unroll") for (int n = 0; n < 2; ++n) _Pragma("unroll") for (int k = 0; k < 2; ++k) \
        acc[ai][bj][m][n] = __builtin_amdgcn_mfma_f32_16x16x32_bf16(Bt[n][k], At[m][k], acc[ai][bj][m][n], 0, 0, 0); __builtin_amdgcn_s_setprio(0); } while (0)
#define PG8_WAIT_V(n) asm volatile("s_waitcnt vmcnt(" #n ")" ::: "memory")
#define PG8_WAIT_L(n) asm volatile("s_waitcnt lgkmcnt(" #n ")" ::: "memory")
#define PG8_BAR __builtin_amdgcn_s_barrier()
#define PG8_SCHED __builtin_amdgcn_sched_barrier(0)
    Unit cur, nxt; int ui = 0;
    if (!S.next(0, cur)) return;
    f32x4 acc[2][2][4][2];
#pragma unroll
    for (int a = 0; a < 2; ++a)
#pragma unroll
        for (int b = 0; b < 2; ++b)
#pragma unroll
            for (int m = 0; m < 4; ++m)
#pragma unroll
                for (int n = 0; n < 2; ++n) acc[a][b][m][n] = (f32x4){0.f, 0.f, 0.f, 0.f};
    bf16x8 At[4][2], B0[2][2], B1[2][2];
    const char* cA = (const char*)g.A + S.aoff(cur, tstep); const char* cB = (const char*)g.Bt + S.boff(cur, tstep);
    S.a_ready(cur);
    if constexpr (SP2) {
        PG8_STAGE(PG8_SB(0, 0), cB, voffB); PG8_STAGE(PG8_SB(0, 1), cB + hstep, voffB); PG8_STAGE(PG8_SA(0, 0), cA, voffA); PG8_STAGE(PG8_SA(0, 1), cA + hstep, voffA);
        if (wr == 1) PG8_BAR;
        PG8_WAIT_V(2); PG8_BAR;
        PG8_STAGE(PG8_SB(1, 0), cB + kstep, voffB); PG8_STAGE(PG8_SA(1, 0), cA + kstep, voffA); PG8_STAGE(PG8_SB(1, 1), cB + hstep + kstep, voffB);
        PG8_WAIT_V(6); PG8_BAR;
    } else {
        PG8_STAGE(PG8_SB(0, 0), cB, voffB); PG8_STAGE(PG8_SA(0, 0), cA, voffA); PG8_STAGE(PG8_SB(0, 1), cB + hstep, voffB); PG8_STAGE(PG8_SA(0, 1), cA + hstep, voffA);
        if (wr == 1) PG8_BAR;
        PG8_WAIT_V(4); PG8_BAR;
        PG8_STAGE(PG8_SB(1, 0), cB + kstep, voffB); PG8_STAGE(PG8_SA(1, 0), cA + kstep, voffA); PG8_STAGE(PG8_SB(1, 1), cB + hstep + kstep, voffB);
        PG8_WAIT_V(6); PG8_BAR;
    }
    for (;;) {
        const bool has_next = S.next(ui + 1, nxt);
        const char* nA = has_next ? (const char*)g.A + S.aoff(nxt, tstep) : cA; const char* nB = has_next ? (const char*)g.Bt + S.boff(nxt, tstep) : cB;
        for (int t = 0; t < nt; t += 2) {
            const bool last = (t == nt - 2);
            const char* a1 = cA + (size_t)(t + 1) * kstep;
            const char* a2 = last ? nA : cA + (size_t)(t + 2) * kstep; const char* b2 = last ? nB : cB + (size_t)(t + 2) * kstep;
            const char* a3 = a2 + kstep; const char* b3 = b2 + kstep;
            if (last && has_next) S.a_ready(nxt);
            if constexpr (SP2) {
            PG8_LDB(B0, 0, 0); PG8_LDB(B1, 0, 1); PG8_SCHED; PG8_LDA(At, 0, 0); PG8_STAGE(PG8_SA(1, 1), a1 + hstep, voffA);
            PG8_WAIT_V(8); PG8_WAIT_L(0); PG8_BAR; PG8_MMA(0, 0, At, B0); PG8_MMA(0, 1, At, B1); PG8_BAR; PG8_SCHED;
            PG8_LDA(At, 0, 1); PG8_STAGE(PG8_SB(0, 0), b2, voffB); PG8_STAGE(PG8_SB(0, 1), b2 + hstep, voffB); PG8_STAGE(PG8_SA(0, 0), a2, voffA);
            PG8_WAIT_V(8); PG8_WAIT_L(0); PG8_BAR; PG8_MMA(1, 0, At, B0); PG8_MMA(1, 1, At, B1); PG8_BAR; PG8_SCHED;
            PG8_LDB(B0, 1, 0); PG8_LDB(B1, 1, 1); PG8_SCHED; PG8_LDA(At, 1, 0); PG8_STAGE(PG8_SA(0, 1), a2 + hstep, voffA);
            PG8_WAIT_V(8); PG8_WAIT_L(0); PG8_BAR; PG8_MMA(0, 0, At, B0); PG8_MMA(0, 1, At, B1); PG8_BAR; PG8_SCHED;
            PG8_LDA(At, 1, 1); PG8_STAGE(PG8_SB(1, 0), b3, voffB); PG8_STAGE(PG8_SB(1, 1), b3 + hstep, voffB); PG8_STAGE(PG8_SA(1, 0), a3, voffA);
            PG8_WAIT_V(8); PG8_WAIT_L(0); PG8_BAR; PG8_MMA(1, 0, At, B0); PG8_MMA(1, 1, At, B1); PG8_BAR; PG8_SCHED;
            } else {
            PG8_LDB(B0, 0, 0); PG8_SCHED; PG8_LDA(At, 0, 0); PG8_STAGE(PG8_SA(1, 1), a1 + hstep, voffA);
            PG8_WAIT_L(8); PG8_BAR; PG8_WAIT_L(0); PG8_MMA(0, 0, At, B0); PG8_BAR; PG8_SCHED;
            PG8_LDB(B1, 0, 1); PG8_STAGE(PG8_SB(0, 0), b2, voffB);
            PG8_BAR; PG8_WAIT_L(0); PG8_MMA(0, 1, At, B1); PG8_BAR;
            PG8_LDA(At, 0, 1); PG8_STAGE(PG8_SA(0, 0), a2, voffA);
            PG8_BAR; PG8_WAIT_L(0); PG8_MMA(1, 0, At, B0); PG8_BAR; PG8_SCHED;
            PG8_STAGE(PG8_SB(0, 1), b2 + hstep, voffB);
            PG8_WAIT_V(6); PG8_BAR; PG8_MMA(1, 1, At, B1); PG8_BAR;
            PG8_LDB(B0, 1, 0); PG8_SCHED; PG8_LDA(At, 1, 0); PG8_STAGE(PG8_SA(0, 1), a2 + hstep, voffA);
            PG8_WAIT_L(8); PG8_BAR; PG8_WAIT_L(0); PG8_MMA(0, 0, At, B0); PG8_BAR; PG8_SCHED;
            PG8_LDB(B1, 1, 1); PG8_STAGE(PG8_SB(1, 0), b3, voffB);
            PG8_BAR; PG8_WAIT_L(0); PG8_MMA(0, 1, At, B1); PG8_BAR;
            PG8_LDA(At, 1, 1); PG8_STAGE(PG8_SA(1, 0), a3, voffA);
            PG8_BAR; PG8_WAIT_L(0); PG8_MMA(1, 0, At, B0); PG8_BAR; PG8_SCHED;
            PG8_STAGE(PG8_SB(1, 1), b3 + hstep, voffB);
            PG8_WAIT_V(6); PG8_BAR; PG8_MMA(1, 1, At, B1); PG8_BAR;
            }
        }
        if constexpr (ALIGN_EPI) { if (wr == 0) PG8_BAR; }
        if constexpr (!Epi::AFTER_DRAIN) { E(acc, cur, wr, wc, fr, fq); S.done(cur); }
        if (!has_next) break;
#pragma unroll
        for (int a = 0; a < 2; ++a)
#pragma unroll
            for (int b = 0; b < 2; ++b)
#pragma unroll
                for (int m = 0; m < 4; ++m)
#pragma unroll
                    for (int n = 0; n < 2; ++n) acc[a][b][m][n] = (f32x4){0.f, 0.f, 0.f, 0.f};
        cur = nxt; cA = nA; cB = nB; ++ui;
        if constexpr (ALIGN_EPI) { if (wr == 1) PG8_BAR; }
    }
    PG8_WAIT_V(0);
    if constexpr (!ALIGN_EPI) { if (wr == 0) PG8_BAR; }
    PG8_BAR;
    if constexpr (Epi::AFTER_DRAIN) { E.fused(acc, cur, wr, wc, fr, fq, lds, wid, lane); S.done(cur); }
#undef PG8_SA
#undef PG8_SB
#undef PG8_STAGE
#undef PG8_LDA
#undef PG8_LDB
#undef PG8_MMA
#undef PG8_WAIT_V
#undef PG8_WAIT_L
#undef PG8_BAR
#undef PG8_SCHED
}
}
#ifndef PG8_SP2
#define PG8_SP2 true
#endif
#ifndef PG8_ALIGN
#define PG8_ALIGN true
#endif
constexpr int NWAVES = 8;
constexpr int DM = 4096, NB = 4, SEQ = 4096, CTXL = 256, DEPTH = 4;
constexpr int M_LAT = NB * SEQ, M_CTX = NB * CTXL, MT = M_LAT + M_CTX;
constexpr int HEADS = 16, QKD = 192, NOPE = 128, ROPED = 64, VDIM = 128, Q_LORA = 1536, KV_LORA = 512;
constexpr int E_CQ = 0, E_CKV = 1536, E_KPE = 2048, E_GM = 2112, E_QH = 4160, E_FF = 6208, E_FB = 8256, E_IH = 10304, E_GH = 12352, E_END = 14400, E_PAD = 14592;
constexpr int O_Q = 0, O_K = 4096, O_V = 8192, O_G = 16384, O_END = 24576;
constexpr int NQ = HEADS * QKD, NKV = HEADS * 256;
constexpr float EPS = 1e-6f;
constexpr int MODW = 3 * DM;
constexpr int KCH = 32;
constexpr size_t al256(size_t x) { return (x + 255) / 256 * 256; }
constexpr size_t WS_CTL = 0, CTL_ZERO_BYTES = 1u << 20;
constexpr size_t WS_MODP = CTL_ZERO_BYTES;
constexpr size_t WS_MOD  = WS_MODP + al256((size_t)KCH * 4 * 5 * MODW * 4);
constexpr size_t WS_LB   = WS_MOD + al256((size_t)4 * 5 * MODW * 4);
constexpr size_t WS_WINE = WS_LB + al256((size_t)2 * 2 * 2048 * 4);
constexpr size_t WS_WUQ  = WS_WINE + (size_t)2 * E_PAD * DM * 2;
constexpr size_t WS_WUKV = WS_WUQ + (size_t)2 * NQ * Q_LORA * 2;
constexpr size_t WS_WOE  = WS_WUKV + (size_t)2 * NKV * KV_LORA * 2;
constexpr size_t WS_WINO = WS_WOE + (size_t)2 * DM * DM * 2;
constexpr size_t WS_WOO  = WS_WINO + (size_t)2 * O_END * DM * 2;
constexpr size_t WS_XS   = WS_WOO + (size_t)2 * DM * 8192 * 2;
constexpr size_t WS_H    = WS_XS + (size_t)MT * DM * 4;
constexpr size_t WS_P    = WS_H + (size_t)MT * DM * 2;
constexpr size_t WS_U    = WS_P + (size_t)MT * O_END * 2;
constexpr size_t WS_CQN  = WS_U;
constexpr size_t WS_CKVN = WS_CQN + (size_t)MT * Q_LORA * 2;
constexpr size_t WS_QF   = WS_CKVN + (size_t)MT * KV_LORA * 2;
constexpr size_t WS_KV   = WS_QF + (size_t)MT * NQ * 2;
constexpr size_t WS_KF   = WS_KV + (size_t)MT * NKV * 2;
constexpr size_t WS_OFE  = WS_KF + (size_t)MT * NQ * 2;
constexpr size_t WS_OBE  = WS_OFE + (size_t)MT * 2048 * 2;
constexpr size_t WS_UE_END = WS_OBE + (size_t)MT * 2048 * 2;
constexpr size_t WS_OFO  = WS_U;
constexpr size_t WS_OBO  = WS_OFO + (size_t)MT * 8192 * 2;
constexpr size_t WS_UO_END = WS_OBO + (size_t)MT * 8192 * 2;
constexpr size_t WS_A    = WS_UE_END > WS_UO_END ? WS_UE_END : WS_UO_END;
constexpr size_t WS_END  = WS_A + (size_t)MT * 8192 * 2;
constexpr int CW_BAR = 4096, CW_QUEUE = 8192;
constexpr int CW_BAR_ = 0;
constexpr int LDS_BYTES = 163840 - 1024;
constexpr int MISC_OFF = LDS_BYTES - 256;
#define LAS __attribute__((address_space(3)))
typedef unsigned short bf16;
typedef unsigned v4u __attribute__((ext_vector_type(4)));
typedef unsigned v2u __attribute__((ext_vector_type(2)));
typedef float f32x4 __attribute__((ext_vector_type(4)));
typedef float f32x16 __attribute__((ext_vector_type(16)));
typedef short bf16x8 __attribute__((ext_vector_type(8)));
typedef short s16x4 __attribute__((ext_vector_type(4)));
#define DI __device__ __forceinline__
typedef __bf16 bf2_t __attribute__((ext_vector_type(2)));
typedef float f32x2_t __attribute__((ext_vector_type(2)));
DI unsigned pk2(float lo, float hi) { const f32x2_t v = {lo, hi}; return __builtin_bit_cast(unsigned, __builtin_convertvector(v, bf2_t)); }
DI unsigned f2bf(float f) { return (unsigned)__builtin_bit_cast(unsigned short, (__bf16)f); }
DI float bflo(unsigned w) { return __uint_as_float(w << 16); }
DI float bfhi(unsigned w) { return __uint_as_float(w & 0xffff0000u); }
DI float bf2f(bf16 v) { return __uint_as_float(((unsigned)v) << 16); }
DI float bperm(int srclane, float v) { return __int_as_float(__builtin_amdgcn_ds_bpermute(srclane << 2, __float_as_int(v))); }
DI float wave_sum(float v, int lane) {
#pragma unroll
    for (int o = 1; o < 64; o <<= 1) v += bperm(lane ^ o, v);
    return v;
}
DI float siluf(float x) { return x / (1.0f + __expf(-x)); }
#define MFMA16(a, b, c) __builtin_amdgcn_mfma_f32_16x16x32_bf16((a), (b), (c), 0, 0, 0)
#define MFMA32(a, b, c) __builtin_amdgcn_mfma_f32_32x32x16_bf16((a), (b), (c), 0, 0, 0)
DI int crow(int r, int hi) { return (r & 3) + 8 * (r >> 2) + 4 * hi; }
DI unsigned img_off(unsigned row, unsigned ch) { return 256u * row + 16u * (ch ^ (((row & 3u) << 2) | ((row >> 2) & 3u))); }
DI unsigned tr32_addr(unsigned lane, unsigned k0, unsigned c, unsigned t) {
    const unsigned h = lane >> 5, blk = (lane >> 4) & 1u, q = (lane & 15u) >> 2, p = lane & 3u;
    return img_off(k0 + 8 * h + 4 * t + q, 4 * c + 2 * blk + (p >> 1)) + 8 * (p & 1u);
}
DI unsigned tr16_addr(unsigned lane, unsigned k0, unsigned c, unsigned t) {
    const unsigned g = lane >> 4, q = (lane & 15u) >> 2, p = lane & 3u;
    return img_off(k0 + 8 * g + 4 * t + q, 2 * c + (p >> 1)) + 8 * (p & 1u);
}
DI s16x4 tr_issue(unsigned lds_addr) { s16x4 r; asm volatile("ds_read_b64_tr_b16 %0, %1" : "=&v"(r) : "v"(lds_addr) : "memory"); return r; }
#define LDS_WAIT_PIN() do { asm volatile("s_waitcnt lgkmcnt(0)" ::: "memory"); __builtin_amdgcn_sched_barrier(0); } while (0)
#define CAT8(L, H) (bf16x8){L[0], L[1], L[2], L[3], H[0], H[1], H[2], H[3]}
DI unsigned cvtpk(float lo, float hi) { unsigned r; asm volatile("v_cvt_pk_bf16_f32 %0, %1, %2" : "=v"(r) : "v"(lo), "v"(hi)); return r; }

constexpr size_t WS_COS = WS_END, WS_SIN = WS_COS + (size_t)SEQ * 128 * 4, WS_END2 = WS_SIN + (size_t)SEQ * 128 * 4;
constexpr size_t WS_PART = WS_END2, WS_END3 = WS_PART + (size_t)4 * M_CTX * DM * 4;
constexpr size_t WS_SILU = WS_END3, WS_END4 = WS_SILU + (size_t)5 * DM * 4;
static_assert(WS_END4 <= (size_t)3221225472ull, "workspace map must fit 4 x the largest tensor (3 GiB)");
#define XB_TMO      128
#define XB_XCNT(j)  (256  + 64 * (j))
#define XB_XSUB(j)  (1280 + 64 * (j))
#define XB_XGEN(j)  (2304 + 64 * (j))
#define XB_TOP      3328
#define XB_TOPGEN   3392
#define XCD_BAR_WORDS 3456
#define XB_SPIN_CAP (1u << 18)

__device__ __forceinline__ unsigned xb_ld(unsigned* p)              { return __hip_atomic_load(p, __ATOMIC_RELAXED, __HIP_MEMORY_SCOPE_AGENT); }
__device__ __forceinline__ unsigned xb_add(unsigned* p, unsigned v) { return __hip_atomic_fetch_add(p, v, __ATOMIC_RELAXED, __HIP_MEMORY_SCOPE_AGENT); }
__device__ __forceinline__ unsigned xb_xcc_id() { return (unsigned)__builtin_amdgcn_s_getreg((3 << 11) | 20) & 0xFu; }
#define XB_SPIN(cond, bar) do { unsigned _sp = 0; while (cond) { __builtin_amdgcn_s_sleep(1); \
    if ((++_sp & 255u) == 0u) { if (xb_ld(&(bar)[XB_TMO])) break; if (_sp > XB_SPIN_CAP) { atomicAdd(&(bar)[XB_TMO], 1u); break; } } } } while (0)

struct XcdBarrier {
    unsigned* bar; unsigned x;
    volatile LAS unsigned* st;
};

__device__ __forceinline__ XcdBarrier xcd_barrier_post(unsigned* bar, volatile LAS unsigned* st) {
    XcdBarrier b; b.bar = bar; b.x = xb_xcc_id(); b.st = st;
    if (threadIdx.x == 0) (void)xb_add(&bar[XB_XCNT(b.x)], 1u);
    return b;
}
__device__ __forceinline__ void xcd_barrier_complete(unsigned* bar, unsigned x, unsigned& nloc, unsigned& nx) {
    const unsigned G = gridDim.x * gridDim.y * gridDim.z;
    unsigned sum, cnt, mine, sp = 0u;
    for (;;) {
        sum = 0u; cnt = 0u; mine = 0u;
#pragma unroll
        for (unsigned j = 0; j < 16; ++j) { const unsigned c = xb_ld(&bar[XB_XCNT(j)]); sum += c; cnt += (c > 0u) ? 1u : 0u; mine = (j == x) ? c : mine; }
        if (sum == G) break;
        __builtin_amdgcn_s_sleep(1);
        if ((++sp & 255u) == 0u) { if (xb_ld(&bar[XB_TMO])) break; if (sp > XB_SPIN_CAP) { atomicAdd(&bar[XB_TMO], 1u); break; } }
    }
    nloc = mine > 0u ? mine : 1u; nx = cnt > 0u ? cnt : 1u;
}

__device__ __forceinline__ void xcd_barrier(const XcdBarrier& b) {
    asm volatile("s_waitcnt vmcnt(0)" ::: "memory");
    __syncthreads();
    if (threadIdx.x == 0) {
        unsigned* bar = b.bar;
        __builtin_amdgcn_s_waitcnt(0);
        unsigned nloc = b.st[0], nx = b.st[1];
        if (nloc == 0u) { xcd_barrier_complete(bar, b.x, nloc, nx); b.st[0] = nloc; b.st[1] = nx; }
        const unsigned old = xb_add(&bar[XB_XSUB(b.x)], 1u);
        const unsigned gen = old / nloc;
        if (old + 1u == (gen + 1u) * nloc) {
            __builtin_amdgcn_fence(__ATOMIC_RELEASE, "agent");
            asm volatile("s_waitcnt vmcnt(0)" ::: "memory");
            const unsigned og = xb_add(&bar[XB_TOP], 1u);
            const unsigned tg = og / nx;
            if (og + 1u == (tg + 1u) * nx) xb_add(&bar[XB_TOPGEN], 1u);
            else XB_SPIN(xb_ld(&bar[XB_TOPGEN]) == tg, bar);
            __builtin_amdgcn_fence(__ATOMIC_ACQUIRE, "agent");
            xb_add(&bar[XB_XGEN(b.x)], 1u);
            asm volatile("s_waitcnt vmcnt(0)" ::: "memory");
        } else {
            XB_SPIN(xb_ld(&bar[XB_XGEN(b.x)]) == gen, bar);
            __builtin_amdgcn_fence(__ATOMIC_ACQUIRE, "agent");
            asm volatile("s_waitcnt vmcnt(0)" ::: "memory");
        }
    }
    __syncthreads();
}
struct Frame {
    LAS unsigned char* lds;
    int tid, lane, wave, vcu, G;
    unsigned char* ws;
    const float *x, *c, *ctx, *c_ctx, *mod_w, *mod_b, *norm_gain, *even_w_in, *q_a_gain, *kv_a_gain, *w_uq, *w_ukv, *q_norm_gain, *k_norm_gain, *hg_lb, *hg_norm_gain, *even_w_out, *odd_w_in, *ret_decay, *odd_w_out;
    float* out;
};
#define WSP(T, off) ((T*)(F.ws + (off)))
DI const float* ld_ptr(const LAS unsigned* tbl, int k) { const unsigned lo = __builtin_amdgcn_readfirstlane(tbl[2 * k]), hi = __builtin_amdgcn_readfirstlane(tbl[2 * k + 1]); return (const float*)(uintptr_t)(((unsigned long long)hi << 32) | lo); }
#define LOADPTRS(F) do { const LAS unsigned* t_ = (const LAS unsigned*)((F).lds + MISC_OFF + 64); \
    (F).x = ld_ptr(t_, 0); (F).c = ld_ptr(t_, 1); (F).ctx = ld_ptr(t_, 2); (F).c_ctx = ld_ptr(t_, 3); (F).mod_w = ld_ptr(t_, 4); (F).mod_b = ld_ptr(t_, 5); (F).norm_gain = ld_ptr(t_, 6); (F).even_w_in = ld_ptr(t_, 7); \
    (F).q_a_gain = ld_ptr(t_, 8); (F).kv_a_gain = ld_ptr(t_, 9); (F).w_uq = ld_ptr(t_, 10); (F).w_ukv = ld_ptr(t_, 11); (F).q_norm_gain = ld_ptr(t_, 12); (F).k_norm_gain = ld_ptr(t_, 13); (F).hg_lb = ld_ptr(t_, 14); \
    (F).hg_norm_gain = ld_ptr(t_, 15); (F).even_w_out = ld_ptr(t_, 16); (F).odd_w_in = ld_ptr(t_, 17); (F).ret_decay = ld_ptr(t_, 18); (F).odd_w_out = ld_ptr(t_, 19); } while (0)

struct ConvDesc { const float* W; bf16* WT; int K, N, item; };
constexpr int I_WINE = (DM / 64) * (E_END / 32), I_WUQ = (Q_LORA / 64) * (NQ / 32), I_WUKV = (KV_LORA / 64) * (NKV / 32), I_WOE = (DM / 64) * (DM / 32),
              I_WINO = (DM / 64) * (O_END / 32), I_WOO = (8192 / 64) * (DM / 32), I_EVEN = I_WINE + I_WUQ + I_WUKV + I_WOE, I_ODD = I_WINO + I_WOO;
constexpr int CONV_LIST_LEN[3] = {I_EVEN - I_WOE, I_WOE + I_ODD + I_EVEN, I_ODD};
DI ConvDesc conv_decode(Frame& F, int list, int g) {
    int i, odd, r;
    if (list == 0) { i = 0; odd = 0; r = g; } else if (list == 2) { i = 1; odd = 1; r = g; } else if (g < I_WOE) { i = 0; odd = 0; r = I_EVEN - I_WOE + g; } else if (g < I_WOE + I_ODD) { i = 0; odd = 1; r = g - I_WOE; } else { i = 1; odd = 0; r = g - I_WOE - I_ODD; }
    ConvDesc d;
    if (odd) {
        if (r < I_WINO) { d.W = F.odd_w_in + (size_t)i * DM * O_END; d.K = DM; d.N = O_END; d.WT = WSP(bf16, WS_WINO) + (size_t)i * O_END * DM; d.item = r; }
        else { d.W = F.odd_w_out + (size_t)i * 8192 * DM; d.K = 8192; d.N = DM; d.WT = WSP(bf16, WS_WOO) + (size_t)i * DM * 8192; d.item = r - I_WINO; }
    } else {
        if (r < I_WINE) { d.W = F.even_w_in + (size_t)i * DM * E_END; d.K = DM; d.N = E_END; d.WT = WSP(bf16, WS_WINE) + (size_t)i * E_PAD * DM; d.item = r; }
        else if (r < I_WINE + I_WUQ) { d.W = F.w_uq + (size_t)i * Q_LORA * NQ; d.K = Q_LORA; d.N = NQ; d.WT = WSP(bf16, WS_WUQ) + (size_t)i * NQ * Q_LORA; d.item = r - I_WINE; }
        else if (r < I_WINE + I_WUQ + I_WUKV) { d.W = F.w_ukv + (size_t)i * KV_LORA * NKV; d.K = KV_LORA; d.N = NKV; d.WT = WSP(bf16, WS_WUKV) + (size_t)i * NKV * KV_LORA; d.item = r - I_WINE - I_WUQ; }
        else { d.W = F.even_w_out + (size_t)i * DM * DM; d.K = DM; d.N = DM; d.WT = WSP(bf16, WS_WOE) + (size_t)i * DM * DM; d.item = r - I_WINE - I_WUQ - I_WUKV; }
    }
    return d;
}
DI void tp_load(const ConvDesc& d, int lane, f32x4 (&tv)[8]) {
    const int nblk = d.N / 32, kb = d.item / nblk, nb = d.item % nblk; const float* p = d.W + (size_t)(64 * kb + 8 * (lane >> 3)) * d.N + 32 * nb + 4 * (lane & 7);
#pragma unroll
    for (int e = 0; e < 8; ++e) tv[e] = *(const f32x4*)(p + (size_t)e * d.N);
}
DI void tp_store(const ConvDesc& d, const f32x4 (&tv)[8], int lane) {
    const int nblk = d.N / 32, kb = d.item / nblk, nb = d.item % nblk, k0 = 64 * kb + 8 * (lane >> 3), n0 = 32 * nb + 4 * (lane & 7);
#pragma unroll
    for (int j = 0; j < 4; ++j) { v4u o; o.x = pk2(tv[0][j], tv[1][j]); o.y = pk2(tv[2][j], tv[3][j]); o.z = pk2(tv[4][j], tv[5][j]); o.w = pk2(tv[6][j], tv[7][j]);
        *(v4u*)(d.WT + (size_t)(n0 + j) * d.K + k0) = o; }
}
DI void conv_items(Frame& F, int list, int start, int end, int stride) {
    for (int it = start; it < end; it += 4 * stride) {
        const bool h1 = it + stride < end, h2 = it + 2 * stride < end, h3 = it + 3 * stride < end;
        f32x4 t0[8], t1[8], t2[8], t3[8];
        const ConvDesc d0 = conv_decode(F, list, it); ConvDesc d1 = d0, d2 = d0, d3 = d0;
        tp_load(d0, F.lane, t0);
        if (h1) { d1 = conv_decode(F, list, it + stride); tp_load(d1, F.lane, t1); }
        if (h2) { d2 = conv_decode(F, list, it + 2 * stride); tp_load(d2, F.lane, t2); }
        if (h3) { d3 = conv_decode(F, list, it + 3 * stride); tp_load(d3, F.lane, t3); }
        tp_store(d0, t0, F.lane);
        if (h1) tp_store(d1, t1, F.lane);
        if (h2) tp_store(d2, t2, F.lane);
        if (h3) tp_store(d3, t3, F.lane);
    }
}
DI void ph_prologue(Frame& F) {
    const int gw = F.vcu * NWAVES + F.wave, NGW = F.G * NWAVES;
    conv_items(F, 0, gw, CONV_LIST_LEN[0], NGW);
    { const size_t n16 = (size_t)(E_PAD - E_END) * DM * 2 / 16;
      for (size_t j = (size_t)blockIdx.x * 512 + F.tid; j < 2 * n16; j += (size_t)F.G * 512) { const size_t i = j / n16, o = j % n16;
          *((v4u*)(WSP(bf16, WS_WINE) + (i * E_PAD + E_END) * DM) + o) = (v4u){0u, 0u, 0u, 0u}; } }
    { float* cs = WSP(float, WS_COS); float* sn = WSP(float, WS_SIN);
      for (int j = blockIdx.x * 512 + F.tid; j < SEQ * 128; j += F.G * 512) { const int pos = j >> 7, i = j & 127; const float inv = 1.0f / powf(10000.0f, (float)i * (1.0f / 127.0f));
          float sv, cv; sincosf((float)pos * inv, &sv, &cv); cs[j] = cv; sn[j] = sv; } }
    __syncthreads();
    LAS float* tab = (LAS float*)F.lds;
    for (int j = F.tid; j < 5 * DM; j += 512) { const int r = j >> 12, k = j & 4095; const float v = r < 4 ? F.c[r * DM + k] : F.c_ctx[k]; const float sv = v / (1.0f + __expf(-v)); tab[j] = sv;
        if (F.vcu == 0) WSP(float, WS_SILU)[j] = sv; }
    __syncthreads();
    constexpr int NT = MODW / 256, KC = DM / KCH;
    float* modp = WSP(float, WS_MODP);
    for (int it = gw; it < NT * KCH; it += NGW) {
        const int kc = it % KCH, nt = (it / KCH) % NT, l = 0;
        const float* W = F.mod_w + ((size_t)l * DM + (size_t)kc * KC) * MODW + nt * 256 + F.lane * 4;
        f32x4 acc[5];
#pragma unroll
        for (int r = 0; r < 5; ++r) acc[r] = (f32x4){0.f, 0.f, 0.f, 0.f};
#pragma unroll 8
        for (int k = 0; k < KC; ++k) { const f32x4 w = *(const f32x4*)(W + (size_t)k * MODW);
#pragma unroll
            for (int r = 0; r < 5; ++r) { const float s = tab[r * DM + kc * KC + k]; acc[r] += w * s; } }
#pragma unroll
        for (int r = 0; r < 5; ++r) *(f32x4*)(modp + ((size_t)(kc * 4 + l) * 5 + r) * MODW + nt * 256 + F.lane * 4) = acc[r];
    }
}
DI void adaln_batch(Frame& F, int bidx) {
    constexpr int NT = MODW / 256, KC = DM / KCH;
    const int l = 1 + bidx / (KCH * (NT / 8)), rem = bidx % (KCH * (NT / 8)), kc = rem / (NT / 8), nt = (rem % (NT / 8)) * 8 + F.wave;
    LAS float* tab = (LAS float*)(F.lds + 131072); const float* sg = WSP(float, WS_SILU);
    for (int j = F.tid; j < 5 * KC; j += 512) { const int r = j / KC, k = j % KC; tab[j] = sg[r * DM + kc * KC + k]; }
    __syncthreads();
    const float* W = F.mod_w + ((size_t)l * DM + (size_t)kc * KC) * MODW + nt * 256 + F.lane * 4;
    f32x4 acc[5];
#pragma unroll
    for (int r = 0; r < 5; ++r) acc[r] = (f32x4){0.f, 0.f, 0.f, 0.f};
#pragma unroll 8
    for (int k = 0; k < KC; ++k) { const f32x4 w = *(const f32x4*)(W + (size_t)k * MODW);
#pragma unroll
        for (int r = 0; r < 5; ++r) { const float s = tab[r * KC + k]; acc[r] += w * s; } }
    float* modp = WSP(float, WS_MODP);
#pragma unroll
    for (int r = 0; r < 5; ++r) *(f32x4*)(modp + ((size_t)(kc * 4 + l) * 5 + r) * MODW + nt * 256 + F.lane * 4) = acc[r];
    __syncthreads();
}
constexpr int ADALN_NB = 3 * KCH * (MODW / 256 / 8);
DI void ph_finalize_mod(Frame& F, int l_lo, int l_hi) {
    const float* modp = WSP(float, WS_MODP); float* mod = WSP(float, WS_MOD);
    for (int j = 5 * l_lo * (MODW / 4) + blockIdx.x * 512 + F.tid; j < 5 * l_hi * (MODW / 4); j += F.G * 512) {
        const int n4 = j % (MODW / 4), lr = j / (MODW / 4), l = lr / 5;
        f32x4 s = *(const f32x4*)(F.mod_b + (size_t)l * MODW + n4 * 4);
        for (int kc = 0; kc < KCH; ++kc) s += *(const f32x4*)(modp + ((size_t)kc * 20 + lr) * MODW + n4 * 4);
        *(f32x4*)(mod + (size_t)lr * MODW + n4 * 4) = s;
    }
}
DI void ph_finalize(Frame& F) {
    ph_finalize_mod(F, 0, 1);
    float* lb = WSP(float, WS_LB);
    for (int j = blockIdx.x * 512 + F.tid; j < 2 * 2048; j += F.G * 512) {
        const float a0 = F.hg_lb[j], a1 = F.hg_lb[2 * 2048 + j], m = fmaxf(a0, a1), e0 = expf(a0 - m), e1 = expf(a1 - m);
        lb[j] = 0.f; lb[2 * 2048 + j] = e1 / (e0 + e1);
    }
}
DI void ph_ada_in(Frame& F, int l, const void* xl, bool xl_f32, const void* xc, bool xc_f32) {
    const int gw = F.vcu * NWAVES + F.wave, NGW = F.G * NWAVES;
    const float* gain = F.norm_gain + (size_t)l * DM; bf16* H = WSP(bf16, WS_H);
    for (int row = gw; row < MT; row += NGW) {
        const bool lat = row < M_LAT; const bool sf32 = lat ? xl_f32 : xc_f32;
        const size_t ro = lat ? (size_t)row * DM : (size_t)(row - M_LAT) * DM; const void* sp = lat ? xl : xc;
        const int seg = lat ? (row >> 12) : 4;
        const float* md = WSP(float, WS_MOD) + ((size_t)l * 5 + seg) * MODW;
        float v[8][8]; float ss = 0.f;
        if (sf32) {
#pragma unroll
            for (int j = 0; j < 8; ++j) { const int c8 = F.lane + 64 * j; const f32x4 a = *((const f32x4*)((const float*)sp + ro) + 2 * c8), b = *((const f32x4*)((const float*)sp + ro) + 2 * c8 + 1);
                v[j][0] = a.x; v[j][1] = a.y; v[j][2] = a.z; v[j][3] = a.w; v[j][4] = b.x; v[j][5] = b.y; v[j][6] = b.z; v[j][7] = b.w; }
        } else {
#pragma unroll
            for (int j = 0; j < 8; ++j) { const int c8 = F.lane + 64 * j; const v4u w = *((const v4u*)((const bf16*)sp + ro) + c8);
#pragma unroll
                for (int e = 0; e < 4; ++e) { v[j][2 * e] = bflo(w[e]); v[j][2 * e + 1] = bfhi(w[e]); } }
        }
        if (l >= 1 && !lat) { const float* pp = WSP(float, WS_PART) + (size_t)(row - M_LAT) * DM; const float* gt = WSP(float, WS_MOD) + ((size_t)(l - 1) * 5 + 4) * MODW + 2 * DM;
            bf16* xs = WSP(bf16, WS_XS) + (size_t)row * DM;
#pragma unroll
            for (int j = 0; j < 8; ++j) { const int c8 = F.lane + 64 * j; f32x4 s0 = *((const f32x4*)pp + 2 * c8), s1 = *((const f32x4*)pp + 2 * c8 + 1);
#pragma unroll
                for (int q = 1; q < 4; ++q) { s0 += *((const f32x4*)(pp + (size_t)q * M_CTX * DM) + 2 * c8); s1 += *((const f32x4*)(pp + (size_t)q * M_CTX * DM) + 2 * c8 + 1); }
                const f32x4 g0 = *((const f32x4*)gt + 2 * c8), g1 = *((const f32x4*)gt + 2 * c8 + 1);
                v[j][0] += g0.x * s0.x; v[j][1] += g0.y * s0.y; v[j][2] += g0.z * s0.z; v[j][3] += g0.w * s0.w; v[j][4] += g1.x * s1.x; v[j][5] += g1.y * s1.y; v[j][6] += g1.z * s1.z; v[j][7] += g1.w * s1.w;
                v4u o; o.x = pk2(v[j][0], v[j][1]); o.y = pk2(v[j][2], v[j][3]); o.z = pk2(v[j][4], v[j][5]); o.w = pk2(v[j][6], v[j][7]); *((v4u*)xs + c8) = o; } }
#pragma unroll
        for (int j = 0; j < 8; ++j)
#pragma unroll
            for (int e = 0; e < 8; ++e) ss += v[j][e] * v[j][e];
        const float rinv = rsqrtf(wave_sum(ss, F.lane) * (1.0f / DM) + EPS);
#pragma unroll
        for (int j = 0; j < 8; ++j) { const int c8 = F.lane + 64 * j;
            const f32x4 g0 = *((const f32x4*)gain + 2 * c8), g1 = *((const f32x4*)gain + 2 * c8 + 1), h0 = *((const f32x4*)md + 2 * c8), h1 = *((const f32x4*)md + 2 * c8 + 1),
                        c0 = *((const f32x4*)(md + DM) + 2 * c8), c1 = *((const f32x4*)(md + DM) + 2 * c8 + 1);
            v4u o; o.x = pk2(v[j][0] * rinv * g0.x * (c0.x + 1.0f) + h0.x, v[j][1] * rinv * g0.y * (c0.y + 1.0f) + h0.y); o.y = pk2(v[j][2] * rinv * g0.z * (c0.z + 1.0f) + h0.z, v[j][3] * rinv * g0.w * (c0.w + 1.0f) + h0.w);
            o.z = pk2(v[j][4] * rinv * g1.x * (c1.x + 1.0f) + h1.x, v[j][5] * rinv * g1.y * (c1.y + 1.0f) + h1.y); o.w = pk2(v[j][6] * rinv * g1.z * (c1.z + 1.0f) + h1.z, v[j][7] * rinv * g1.w * (c1.w + 1.0f) + h1.w);
            *((v4u*)(H + (size_t)row * DM) + c8) = o; }
    }
}
DI void ph_tail_fold(Frame& F) {
    const float* part = WSP(float, WS_PART); bf16* P = WSP(bf16, WS_P);
    for (int idx = F.vcu * (NWAVES * 64) + F.tid; idx < M_CTX * 288; idx += F.G * (NWAVES * 64)) { const int row = idx / 288, ch = idx - row * 288;
        const float* p = part + (size_t)row * DM + ch * 8;
        f32x4 a0 = *(const f32x4*)p, a1 = *(const f32x4*)(p + 4);
#pragma unroll
        for (int q = 1; q < 4; ++q) { a0 += *(const f32x4*)(p + (size_t)q * M_CTX * DM); a1 += *(const f32x4*)(p + (size_t)q * M_CTX * DM + 4); }
        v4u w; w.x = pk2(a0[0], a0[1]); w.y = pk2(a0[2], a0[3]); w.z = pk2(a1[0], a1[1]); w.w = pk2(a1[2], a1[3]);
        *(v4u*)(P + (size_t)(M_LAT + row) * E_PAD + 48 * 256 + ch * 8) = w; }
}
DI void ph_lora_norm(Frame& F, int i) {
    const int gw = F.vcu * NWAVES + F.wave, NGW = F.G * NWAVES;
    const bf16* P = WSP(bf16, WS_P); bf16* CQN = WSP(bf16, WS_CQN); bf16* CKVN = WSP(bf16, WS_CKVN);
    const float* qg = F.q_a_gain + (size_t)i * Q_LORA; const float* kg = F.kv_a_gain + (size_t)i * KV_LORA;
    for (int row = gw; row < MT; row += NGW) {
        const bf16* pr = P + (size_t)row * E_PAD;
        v4u a[3]; float ss = 0.f;
#pragma unroll
        for (int j = 0; j < 3; ++j) { a[j] = *((const v4u*)(pr + E_CQ) + F.lane + 64 * j);
#pragma unroll
            for (int e = 0; e < 4; ++e) { const float lo = bflo(a[j][e]), hi = bfhi(a[j][e]); ss += lo * lo + hi * hi; } }
        const float rq = rsqrtf(wave_sum(ss, F.lane) * (1.0f / Q_LORA) + EPS);
#pragma unroll
        for (int j = 0; j < 3; ++j) { const int c8 = F.lane + 64 * j; const f32x4 g0 = *((const f32x4*)qg + 2 * c8), g1 = *((const f32x4*)qg + 2 * c8 + 1); v4u o;
            o.x = pk2(bflo(a[j].x) * rq * g0.x, bfhi(a[j].x) * rq * g0.y); o.y = pk2(bflo(a[j].y) * rq * g0.z, bfhi(a[j].y) * rq * g0.w);
            o.z = pk2(bflo(a[j].z) * rq * g1.x, bfhi(a[j].z) * rq * g1.y); o.w = pk2(bflo(a[j].w) * rq * g1.z, bfhi(a[j].w) * rq * g1.w);
            *((v4u*)(CQN + (size_t)row * Q_LORA) + c8) = o; }
        const v4u b = *((const v4u*)(pr + E_CKV) + F.lane); float s2 = 0.f;
#pragma unroll
        for (int e = 0; e < 4; ++e) { const float lo = bflo(b[e]), hi = bfhi(b[e]); s2 += lo * lo + hi * hi; }
        const float rk = rsqrtf(wave_sum(s2, F.lane) * (1.0f / KV_LORA) + EPS);
        { const f32x4 g0 = *((const f32x4*)kg + 2 * F.lane), g1 = *((const f32x4*)kg + 2 * F.lane + 1); v4u o;
          o.x = pk2(bflo(b.x) * rk * g0.x, bfhi(b.x) * rk * g0.y); o.y = pk2(bflo(b.y) * rk * g0.z, bfhi(b.y) * rk * g0.w);
          o.z = pk2(bflo(b.z) * rk * g1.x, bfhi(b.z) * rk * g1.y); o.w = pk2(bflo(b.w) * rk * g1.z, bfhi(b.w) * rk * g1.w);
          *((v4u*)(CKVN + (size_t)row * KV_LORA) + F.lane) = o; }
    }
}
DI void ph_qk_norm_rope(Frame& F, int i) {
    const int gw = F.vcu * NWAVES + F.wave, NGW = F.G * NWAVES;
    bf16* QF = WSP(bf16, WS_QF); const bf16* KV = WSP(bf16, WS_KV); bf16* KF = WSP(bf16, WS_KF); const bf16* P = WSP(bf16, WS_P);
    const float* qg = F.q_norm_gain + (size_t)i * QKD; const float* kg = F.k_norm_gain + (size_t)i * QKD;
    const int h = F.lane >> 2, part = F.lane & 3;
    float inv[8];
#pragma unroll
    for (int j = 0; j < 8; ++j) inv[j] = exp2f(-(float)(8 * (part & 1) + j) * (13.287712379549449f / 16.0f));
    constexpr float QSCL = 0.07216878364870322f * 1.4426950408889634f;
    for (int row = gw; row < MT; row += NGW) {
        const bool lat = row < M_LAT; const int t = row & 4095; const float prow = (float)(t >> 6), pcol = (float)(t & 63);
        float cs[2][8], sn[2][8];
        if (lat) {
#pragma unroll
            for (int j = 0; j < 8; ++j) { sincosf(prow * inv[j], &sn[0][j], &cs[0][j]); sincosf(pcol * inv[j], &sn[1][j], &cs[1][j]); }
        }
#pragma unroll
        for (int which = 0; which < 2; ++which) {
            float v[6][8]; float ss = 0.f;
#pragma unroll
            for (int ii = 0; ii < 6; ++ii) { const int c = part + 4 * ii; v4u w;
                if (which == 0) w = *(const v4u*)(QF + (size_t)row * NQ + h * QKD + 8 * c);
                else if (ii < 4) w = *(const v4u*)(KV + (size_t)row * NKV + h * 256 + 8 * c);
                else w = *(const v4u*)(P + (size_t)row * E_PAD + E_KPE + 8 * (c - 16));
#pragma unroll
                for (int e = 0; e < 4; ++e) { v[ii][2 * e] = bflo(w[e]); v[ii][2 * e + 1] = bfhi(w[e]); ss += v[ii][2 * e] * v[ii][2 * e] + v[ii][2 * e + 1] * v[ii][2 * e + 1]; } }
            ss += bperm(F.lane ^ 1, ss); ss += bperm(F.lane ^ 2, ss);
            const float rn = rsqrtf(ss * (1.0f / QKD) + EPS); const float* gg = which == 0 ? qg : kg;
#pragma unroll
            for (int ii = 0; ii < 6; ++ii) { const int c = part + 4 * ii;
#pragma unroll
                for (int e = 0; e < 8; ++e) v[ii][e] = v[ii][e] * rn * gg[8 * c + e]; }
            if (lat) {
#pragma unroll
                for (int hf = 0; hf < 2; ++hf) {
#pragma unroll
                    for (int e = 0; e < 8; ++e) { const float m = v[4 + hf][e], o = bperm(F.lane ^ 2, m);
                        v[4 + hf][e] = (part < 2) ? (m * cs[hf][e] - o * sn[hf][e]) : (o * sn[hf][e] + m * cs[hf][e]); } }
            }
            const float scl = which == 0 ? QSCL : 1.0f;
#pragma unroll
            for (int ii = 0; ii < 6; ++ii) { const int c = part + 4 * ii; v4u o;
#pragma unroll
                for (int e = 0; e < 4; ++e) o[e] = pk2(v[ii][2 * e] * scl, v[ii][2 * e + 1] * scl);
                if (which == 0) *(v4u*)(QF + (size_t)row * NQ + h * QKD + 8 * c) = o; else *(v4u*)(KF + (size_t)row * NQ + h * QKD + 8 * c) = o; }
        }
    }
}
DI void ph_hg_merge(Frame& F, int i) {
    const int gw = F.vcu * NWAVES + F.wave, NGW = F.G * NWAVES;
    const bf16* OFp = WSP(bf16, WS_OFE); const bf16* OBp = WSP(bf16, WS_OBE); const bf16* P = WSP(bf16, WS_P); bf16* A = WSP(bf16, WS_A);
    const float* hgg = F.hg_norm_gain + (size_t)i * 128; const int h = F.lane >> 2, part = F.lane & 3;
    for (int row = gw; row < MT; row += NGW) {
        const size_t o0 = (size_t)row * 2048 + h * 128 + part * 32; f32x4 v[8]; float ss = 0.f;
#pragma unroll
        for (int j = 0; j < 4; ++j) { const v4u a = *((const v4u*)(OFp + o0) + j), b = *((const v4u*)(OBp + o0) + j);
            v[2 * j] = (f32x4){bflo(a.x) + bflo(b.x), bfhi(a.x) + bfhi(b.x), bflo(a.y) + bflo(b.y), bfhi(a.y) + bfhi(b.y)};
            v[2 * j + 1] = (f32x4){bflo(a.z) + bflo(b.z), bfhi(a.z) + bfhi(b.z), bflo(a.w) + bflo(b.w), bfhi(a.w) + bfhi(b.w)}; }
#pragma unroll
        for (int j = 0; j < 8; ++j) ss += (v[j].x * v[j].x + v[j].y * v[j].y) + (v[j].z * v[j].z + v[j].w * v[j].w);
        ss += bperm(F.lane ^ 1, ss); ss += bperm(F.lane ^ 2, ss);
        const float rn = rsqrtf(ss * (1.0f / 128) + EPS);
        const bf16* gp = P + (size_t)row * E_PAD + E_GH + h * 128 + part * 32; bf16* ap = A + (size_t)row * DM + 2048 + h * 128 + part * 32;
#pragma unroll
        for (int j = 0; j < 4; ++j) { const v4u g = *((const v4u*)gp + j); const f32x4 a = v[2 * j], b = v[2 * j + 1];
            const f32x4 g0 = *((const f32x4*)(hgg + part * 32) + 2 * j), g1 = *((const f32x4*)(hgg + part * 32) + 2 * j + 1); v4u o;
            o.x = pk2(a.x * rn * g0.x * siluf(bflo(g.x)), a.y * rn * g0.y * siluf(bfhi(g.x))); o.y = pk2(a.z * rn * g0.z * siluf(bflo(g.y)), a.w * rn * g0.w * siluf(bfhi(g.y)));
            o.z = pk2(b.x * rn * g1.x * siluf(bflo(g.z)), b.y * rn * g1.y * siluf(bfhi(g.z))); o.w = pk2(b.z * rn * g1.z * siluf(bflo(g.w)), b.w * rn * g1.w * siluf(bfhi(g.w)));
            *((v4u*)ap + j) = o; }
    }
}
DI void ph_ret_rope(Frame& F) {
    const int gw = F.vcu * NWAVES + F.wave, NGW = F.G * NWAVES; bf16* P = WSP(bf16, WS_P);
    const int hsub = F.lane >> 4, i0 = 8 * (F.lane & 15);
    float inv[8];
#pragma unroll
    for (int j = 0; j < 8; ++j) inv[j] = 1.0f / powf(10000.0f, (float)(i0 + j) * (1.0f / 127.0f));
    for (int row = gw; row < MT; row += NGW) {
        const bool lat = row < M_LAT; const float pos = (float)(row & 4095);
        float cs[8], sn[8];
#pragma unroll
        for (int j = 0; j < 8; ++j) { if (lat) sincosf(pos * inv[j], &sn[j], &cs[j]); else { cs[j] = 1.f; sn[j] = 0.f; } }
#pragma unroll
        for (int which = 0; which < 2; ++which) {
            const float scl = which ? 0.0625f : 1.0f;
#pragma unroll
            for (int it = 0; it < 4; ++it) { const int h = 4 * it + hsub; bf16* p1 = P + (size_t)row * O_END + (which ? O_K : O_Q) + h * 256 + i0; bf16* p2 = p1 + 128;
                const v4u a = *(const v4u*)p1, b = *(const v4u*)p2; v4u oa, ob;
#pragma unroll
                for (int e = 0; e < 4; ++e) { const float x1l = bflo(a[e]), x1h = bfhi(a[e]), x2l = bflo(b[e]), x2h = bfhi(b[e]);
                    oa[e] = pk2((x1l * cs[2 * e] - x2l * sn[2 * e]) * scl, (x1h * cs[2 * e + 1] - x2h * sn[2 * e + 1]) * scl);
                    ob[e] = pk2((x1l * sn[2 * e] + x2l * cs[2 * e]) * scl, (x1h * sn[2 * e + 1] + x2h * cs[2 * e + 1]) * scl); }
                *(v4u*)p1 = oa; *(v4u*)p2 = ob; }
        }
    }
}
DI void ph_ret_merge(Frame& F, int li, bool ctx_split) {
    const int gw = F.vcu * NWAVES + F.wave, NGW = F.G * NWAVES;
    const bf16* OBp = WSP(bf16, WS_OBO); const bf16* P = WSP(bf16, WS_P); bf16* A = WSP(bf16, WS_A);
    LAS float* l2t = (LAS float*)F.lds;
    if (F.tid < 32) { const float dl = F.ret_decay[(size_t)li * 32 + F.tid]; l2t[F.tid] = -log1pf(expf(-dl)) * 1.4426950408889634f; }
    __syncthreads();
    for (int row = gw; row < MT; row += NGW) {
        const float j = (float)(row & 63);
#pragma unroll 8
        for (int h = 0; h < 16; ++h) { const size_t o0 = (size_t)row * 8192 + h * 512 + F.lane * 8;
            const float sb = __builtin_amdgcn_exp2f(-j * l2t[16 + h]);
            const v4u fb = *(const v4u*)(OBp + o0);
            const f32x4 a = (f32x4){bflo(fb.x) * sb, bfhi(fb.x) * sb, bflo(fb.y) * sb, bfhi(fb.y) * sb};
            const f32x4 b = (f32x4){bflo(fb.z) * sb, bfhi(fb.z) * sb, bflo(fb.w) * sb, bfhi(fb.w) * sb};
            const float ss = (a.x * a.x + a.y * a.y) + (a.z * a.z + a.w * a.w) + (b.x * b.x + b.y * b.y) + (b.z * b.z + b.w * b.w);
            const float rn = rsqrtf(wave_sum(ss, F.lane) * (1.0f / 512) + EPS);
            v4u g;
            if (ctx_split && row >= M_LAT) { const float* pp = WSP(float, WS_PART) + (size_t)(row - M_LAT) * 8192 + h * 512 + F.lane * 8; const size_t hs = (size_t)M_CTX * 8192;
                const f32x4 x0 = *(const f32x4*)pp + *(const f32x4*)(pp + hs), x1 = *(const f32x4*)(pp + 4) + *(const f32x4*)(pp + hs + 4);
                g.x = pk2(x0[0], x0[1]); g.y = pk2(x0[2], x0[3]); g.z = pk2(x1[0], x1[1]); g.w = pk2(x1[2], x1[3]); }
            else g = *(const v4u*)(P + (size_t)row * O_END + O_G + h * 512 + F.lane * 8);
            v4u o;
            o.x = pk2(a.x * rn * siluf(bflo(g.x)), a.y * rn * siluf(bfhi(g.x))); o.y = pk2(a.z * rn * siluf(bflo(g.y)), a.w * rn * siluf(bfhi(g.y)));
            o.z = pk2(b.x * rn * siluf(bflo(g.z)), b.y * rn * siluf(bfhi(g.z))); o.w = pk2(b.z * rn * siluf(bflo(g.w)), b.w * rn * siluf(bfhi(g.w)));
            *(v4u*)(A + (size_t)row * 8192 + h * 512 + F.lane * 8) = o; }
    }
}
namespace att {
constexpr int KP = 400;
constexpr int VB = 64 * 128 * 2, KB = 64 * KP;
constexpr int OFF_V = 0, OFF_K = 3 * VB, OFF_WS = OFF_K + 3 * KB;
static_assert(OFF_WS + 8 * 256 <= MISC_OFF, "attention LDS map");
constexpr float THR2 = 11.5f;
DI int v_st(int k, int c) { const int kk = (k & ~0xC) | ((k & 4) << 1) | ((k & 8) >> 1); return ((kk >> 3) * 4 + (c >> 5)) * 512 + ((kk & 7) * 32 + (c & 31)) * 2; }
DI int v_rd_base(int lane) { return ((lane & 3) << 3) | (((lane >> 2) & 3) << 6) | (((lane >> 4) & 1) << 5) | (((lane >> 5) & 1) << 8); }
constexpr int v_rd_off(int d0, int ks, int half) { return d0 * 512 + ks * 4096 + half * 2048; }
template <int OFF> DI s16x4 tr_read(int vb) { s16x4 r; asm volatile("ds_read_b64_tr_b16 %0, %1 offset:%2" : "=&v"(r) : "v"(vb), "i"(OFF) : "memory"); return r; }
template <int D0> DI void pv_one(f32x16& od, int vb, bf16x8 pa0, bf16x8 pa1, bf16x8 pa2, bf16x8 pa3) {
    const s16x4 l0 = tr_read<v_rd_off(D0, 0, 0)>(vb), h0 = tr_read<v_rd_off(D0, 0, 1)>(vb), l1 = tr_read<v_rd_off(D0, 1, 0)>(vb), h1 = tr_read<v_rd_off(D0, 1, 1)>(vb);
    const s16x4 l2 = tr_read<v_rd_off(D0, 2, 0)>(vb), h2 = tr_read<v_rd_off(D0, 2, 1)>(vb), l3 = tr_read<v_rd_off(D0, 3, 0)>(vb), h3 = tr_read<v_rd_off(D0, 3, 1)>(vb);
    LDS_WAIT_PIN();
    od = MFMA32(pa0, CAT8(l0, h0), od); od = MFMA32(pa1, CAT8(l1, h1), od); od = MFMA32(pa2, CAT8(l2, h2), od); od = MFMA32(pa3, CAT8(l3, h3), od);
}
DI void unit(Frame& F, int h, int qrow0, int klat0, int nlat, int kctx0, int NT, int ldp) {
    const int tid = F.tid, wid = F.wave, lane = F.lane, r32 = lane & 31, hi = lane >> 5;
    const bf16* QF = WSP(bf16, WS_QF); const bf16* KF = WSP(bf16, WS_KF); const bf16* KV = WSP(bf16, WS_KV); const bf16* P = WSP(bf16, WS_P); bf16* A = WSP(bf16, WS_A);
    LAS unsigned char* Vl = F.lds + OFF_V; LAS unsigned char* Kl = F.lds + OFF_K;
    LAS float* wsl = (LAS float*)(F.lds + OFF_WS) + wid * 64; LAS float* li_l = wsl; LAS float* al_l = wsl + 32;
    float m_reg = -1e30f, l_reg = 0.f; f32x16 o[4];
#pragma unroll
    for (int d = 0; d < 4; ++d)
#pragma unroll
        for (int r = 0; r < 16; ++r) o[d][r] = 0.f;
    bf16x8 qr[12];
    { const bf16* Qw = QF + (size_t)(qrow0 + wid * 32 + r32) * NQ + h * QKD + hi * 8;
#pragma unroll
      for (int d0 = 0; d0 < 12; ++d0) qr[d0] = *(const bf16x8*)(Qw + d0 * 16); }
    int krow[3], kch[3];
#pragma unroll
    for (int i = 0; i < 3; ++i) { const int idx = tid + 512 * i; krow[i] = idx / 24; kch[i] = idx % 24; }
    const int vrow0 = tid >> 4, vc = (tid & 15) * 8;
    v4u sk[3], sv[2];
    const int vb0 = (int)(uintptr_t)Vl + v_rd_base(lane);
#define KEYROW(kt) ((kt) < nlat ? klat0 + 64 * (kt) : kctx0 + 64 * ((kt) - nlat))
#define SLOADK(kt) do { const int kr_ = KEYROW(kt); _Pragma("unroll") for (int i = 0; i < 3; ++i) sk[i] = *(const v4u*)(KF + (size_t)(kr_ + krow[i]) * NQ + h * QKD + kch[i] * 8); } while (0)
#define SLOADV(kt) do { const int kr_ = KEYROW(kt); _Pragma("unroll") for (int i = 0; i < 2; ++i) sv[i] = *(const v4u*)(KV + (size_t)(kr_ + vrow0 + 32 * i) * NKV + h * 256 + 128 + vc); } while (0)
#define SWRITEK(b) do { _Pragma("unroll") for (int i = 0; i < 3; ++i) *(LAS v4u*)(Kl + (b) * KB + krow[i] * KP + kch[i] * 16) = sk[i]; } while (0)
#define SWRITEV(b) do { _Pragma("unroll") for (int i = 0; i < 2; ++i) *(LAS v4u*)(Vl + (b) * VB + v_st(vrow0 + 32 * i, vc)) = sv[i]; } while (0)
    const bool grpA = wid < 4;
    SLOADK(0); SLOADV(0); SWRITEK(0); SWRITEV(0);
    if (NT > 1) { SLOADK(1); SWRITEK(1); }
    if (NT > 2) SLOADK(2);
    if (NT > 1) SLOADV(1);
    __syncthreads();
    int kb = 0, kb2 = 2, vb1 = 1;
    for (int j = 0; j < NT; ++j) {
        f32x16 p0, p1;
#pragma unroll
        for (int r = 0; r < 16; ++r) { p0[r] = 0.f; p1[r] = 0.f; }
        { const LAS unsigned char* Ks = Kl + kb * KB; __builtin_amdgcn_s_setprio(1);
#pragma unroll
          for (int d0 = 0; d0 < 12; ++d0) { const int cb = (d0 * 16 + hi * 8) * 2;
              const bf16x8 b0 = *(const LAS bf16x8*)(Ks + r32 * KP + cb), b1 = *(const LAS bf16x8*)(Ks + (32 + r32) * KP + cb);
              p0 = MFMA32(b0, qr[d0], p0); p1 = MFMA32(b1, qr[d0], p1); } __builtin_amdgcn_s_setprio(0); }
        if (grpA) __syncthreads();
        float pmax = p0[0];
#pragma unroll
        for (int r = 1; r < 16; ++r) pmax = fmaxf(pmax, p0[r]);
#pragma unroll
        for (int r = 0; r < 16; ++r) pmax = fmaxf(pmax, p1[r]);
        { auto rr = __builtin_amdgcn_permlane32_swap(__float_as_uint(pmax), __float_as_uint(pmax), false, false); pmax = fmaxf(__uint_as_float(rr[0]), __uint_as_float(rr[1])); }
        float mn, alpha;
        if (__all(pmax - m_reg <= THR2)) { mn = m_reg; alpha = 1.f; }
        else { mn = fmaxf(m_reg, pmax); alpha = __builtin_amdgcn_exp2f(m_reg - mn); m_reg = mn; }
        float ps = 0.f;
#pragma unroll
        for (int r = 0; r < 16; ++r) { p0[r] = __builtin_amdgcn_exp2f(p0[r] - mn); p1[r] = __builtin_amdgcn_exp2f(p1[r] - mn); ps += p0[r] + p1[r]; }
        { auto rr = __builtin_amdgcn_permlane32_swap(__float_as_uint(ps), __float_as_uint(ps), false, false); ps = __uint_as_float(rr[0]) + __uint_as_float(rr[1]); }
        l_reg = l_reg * alpha + ps;
        bf16x8 pa0, pa1, pa2, pa3;
#define PK4(Pv, BASE, OUT) do { unsigned a0 = cvtpk(Pv[BASE + 0], Pv[BASE + 1]), a1 = cvtpk(Pv[BASE + 2], Pv[BASE + 3]); \
        unsigned b0_ = cvtpk(Pv[BASE + 4], Pv[BASE + 5]), b1_ = cvtpk(Pv[BASE + 6], Pv[BASE + 7]); \
        auto r0 = __builtin_amdgcn_permlane32_swap(a0, b0_, false, false); auto r1 = __builtin_amdgcn_permlane32_swap(a1, b1_, false, false); \
        v4u w = {r0[0], r1[0], r0[1], r1[1]}; OUT = __builtin_bit_cast(bf16x8, w); } while (0)
        PK4(p0, 0, pa0); PK4(p0, 8, pa1); PK4(p1, 0, pa2); PK4(p1, 8, pa3);
#undef PK4
        if (__any(alpha < 1.f)) { if (hi == 0) al_l[r32] = alpha; asm volatile("s_waitcnt lgkmcnt(0)" ::: "memory");
#pragma unroll
            for (int r = 0; r < 16; ++r) { const float a = al_l[crow(r, hi)];
#pragma unroll
                for (int d = 0; d < 4; ++d) o[d][r] *= a; } }
        if (j + 2 < NT) SWRITEK(kb2);
        if (j + 1 < NT) SWRITEV(vb1);
        if (j + 3 < NT) SLOADK(j + 3);
        if (j + 2 < NT) SLOADV(j + 2);
        if (!grpA) __syncthreads();
        { const int vb = vb0 + kb * VB;
          pv_one<0>(o[0], vb, pa0, pa1, pa2, pa3); pv_one<1>(o[1], vb, pa0, pa1, pa2, pa3); pv_one<2>(o[2], vb, pa0, pa1, pa2, pa3); pv_one<3>(o[3], vb, pa0, pa1, pa2, pa3); }
        kb = kb == 2 ? 0 : kb + 1; kb2 = kb2 == 2 ? 0 : kb2 + 1; vb1 = vb1 == 2 ? 0 : vb1 + 1;
    }
    __syncthreads();
#undef SLOADK
#undef SLOADV
#undef SWRITEK
#undef SWRITEV
#undef KEYROW
    if (hi == 0) li_l[r32] = l_reg; asm volatile("s_waitcnt lgkmcnt(0)" ::: "memory");
#pragma unroll
    for (int r = 0; r < 16; ++r) { const int orow = crow(r, hi); const float rl = __builtin_amdgcn_rcpf(li_l[orow]); const size_t grow = (size_t)(qrow0 + wid * 32 + orow);
#pragma unroll
        for (int d0 = 0; d0 < 4; ++d0) { const int col = h * 128 + d0 * 32 + r32; const float g = bf2f(P[grow * ldp + E_GM + col]);
            A[grow * DM + col] = (bf16)f2bf(o[d0][r] * rl * siluf(g)); } }
    __syncthreads();
}
}
namespace hg {
constexpr int TP = 272;
constexpr int OFF_QP = 0, OFF_KP = OFF_QP + 32 * TP, OFF_QS = OFF_KP + 32 * TP, OFF_KH = OFF_QS + 32 * TP, OFF_V = OFF_KH + 8192, OFF_A = OFF_V + 8192, OFF_E = OFF_A + 2560, OFF_SB = OFF_E + 512, SB_BYTES = 128 * TP;
static_assert(OFF_SB + 2 * SB_BYTES <= MISC_OFF && OFF_SB % 16 == 0, "hgrn LDS map");
constexpr int NCH = 8 + 128;
template <int OFF> DI s16x4 tr_off(unsigned base) { s16x4 r; asm volatile("ds_read_b64_tr_b16 %0, %1 offset:%2" : "=&v"(r) : "v"(base), "i"(OFF) : "memory"); return r; }
DI float scan32(float x) {
    x += __int_as_float(__builtin_amdgcn_update_dpp(0, __float_as_int(x), 0x111, 0xF, 0xF, false));
    x += __int_as_float(__builtin_amdgcn_update_dpp(0, __float_as_int(x), 0x112, 0xF, 0xF, false));
    x += __int_as_float(__builtin_amdgcn_update_dpp(0, __float_as_int(x), 0x114, 0xF, 0xF, false));
    x += __int_as_float(__builtin_amdgcn_update_dpp(0, __float_as_int(x), 0x118, 0xF, 0xF, false));
    x += __int_as_float(__builtin_amdgcn_update_dpp(0, __float_as_int(x), 0x142, 0xA, 0xF, false));
    return x;
}
DI void unit(Frame& F, int li, int b, int h, int dir) {
    const int wid = F.wave, lane0 = F.lane;
    const bf16* P = WSP(bf16, WS_P); bf16* OUT = dir ? WSP(bf16, WS_OBE) : WSP(bf16, WS_OFE);
    LAS unsigned char* L = F.lds;
    const int p0 = lane0 & 31, ch0 = 2 * wid + (lane0 >> 5);
    float lbv[8], omv[8];
    { const float* lbp = WSP(float, WS_LB) + ((size_t)li * 2 + dir) * 2048 + h * 128 + ch0 * 8;
#pragma unroll
      for (int j = 0; j < 8; ++j) { lbv[j] = lbp[j]; omv[j] = 1.0f - lbv[j]; } }
    const unsigned goff = (unsigned)(((dir ? 31 - p0 : p0) * E_PAD + ch0 * 8) * 2);
    const unsigned lrow = p0 * TP + ch0 * 16, limg = img_off(p0, ch0);
    const int fcol = (dir ? E_FB : E_FF) + h * 128, qcol = E_QH + h * 128, vcol = E_IH + h * 128;
#define ROWLO(ci) ((ci) < 8 ? M_LAT + b * CTXL + (dir ? CTXL - 32 - (ci) * 32 : (ci) * 32) : b * SEQ + (dir ? SEQ - 32 - ((ci) - 8) * 32 : ((ci) - 8) * 32))
#define HLOAD(ci) do { const char* pb_ = (const char*)(P + (size_t)ROWLO(ci) * E_PAD); rq = *(const v4u*)(pb_ + qcol * 2 + goff); rf = *(const v4u*)(pb_ + fcol * 2 + goff); rv = *(const v4u*)(pb_ + vcol * 2 + goff); } while (0)
    f32x16 accS[2];
#pragma unroll
    for (int i = 0; i < 2; ++i)
#pragma unroll
        for (int r = 0; r < 16; ++r) accS[i][r] = 0.f;
    for (int j = F.tid; j < SB_BYTES / 16; j += 512) *((LAS v4u*)(L + OFF_SB) + j) = (v4u){0u, 0u, 0u, 0u};
    v4u rq, rf, rv;
    HLOAD(0);
    __syncthreads();
    for (int cidx = 0; cidx < NCH; ++cidx) {
        int lane = lane0; asm volatile("" : "+v"(lane));
        const int cur = cidx & 1;
        const unsigned SBc = OFF_SB + cur * SB_BYTES, SBn = OFF_SB + (cur ^ 1) * SB_BYTES;
        const v4u cq = rq, cf = rf, cv = rv;
        if (cidx + 1 < NCH) HLOAD(cidx + 1);
        {
            v4u oqp, okp, oqs, okh; float qp[8], kp[8], qs[8], kh[8], e31[8];
            const bool up = lane >= 32;
#pragma unroll
            for (int e = 0; e < 8; ++e) { const float f = (e & 1) ? bfhi(cf[e >> 1]) : bflo(cf[e >> 1]), q = (e & 1) ? bfhi(cq[e >> 1]) : bflo(cq[e >> 1]);
                const float t = __builtin_amdgcn_exp2f(-1.4426950408889634f * __builtin_fabsf(f)), r = __builtin_amdgcn_rcpf(1.0f + t), tr = t * r;
                const float sp = f >= 0.f ? r : tr, sn = f >= 0.f ? tr : r;
                const float key = omv[e] * sn, g = lbv[e] + omv[e] * sp;
                const float bb = scan32(fmaxf(__builtin_amdgcn_logf(g), -120.0f));
                const int bi = __float_as_int(bb), s15 = __builtin_amdgcn_readlane(bi, 15), s47 = __builtin_amdgcn_readlane(bi, 47), s31 = __builtin_amdgcn_readlane(bi, 31), s63 = __builtin_amdgcn_readlane(bi, 63);
                const float c = __int_as_float(up ? s47 : s15), bl = __int_as_float(up ? s63 : s31);
                const float e1 = __builtin_amdgcn_exp2f(bb - c), e2 = __builtin_amdgcn_exp2f(c - bb), ec = __builtin_amdgcn_exp2f(c), ebc = __builtin_amdgcn_exp2f(bl - c);
                qp[e] = q * e1; kp[e] = key * e2; qs[e] = qp[e] * ec; kh[e] = kp[e] * ebc; e31[e] = ec * ebc; }
            if ((lane & 31) == 31) { *(LAS f32x4*)(L + OFF_E + ch0 * 32) = (f32x4){e31[0], e31[1], e31[2], e31[3]}; *(LAS f32x4*)(L + OFF_E + ch0 * 32 + 16) = (f32x4){e31[4], e31[5], e31[6], e31[7]}; }
#pragma unroll
            for (int e = 0; e < 4; ++e) { oqp[e] = pk2(qp[2 * e], qp[2 * e + 1]); okp[e] = pk2(kp[2 * e], kp[2 * e + 1]); oqs[e] = pk2(qs[2 * e], qs[2 * e + 1]); okh[e] = pk2(kh[2 * e], kh[2 * e + 1]); }
            *(LAS v4u*)(L + OFF_QP + lrow) = oqp; *(LAS v4u*)(L + OFF_KP + lrow) = okp; *(LAS v4u*)(L + OFF_QS + lrow) = oqs; *(LAS v4u*)(L + OFF_KH + limg) = okh; *(LAS v4u*)(L + OFF_V + limg) = cv;
        }
        __syncthreads();
        if (wid < 3) { const int mi = wid >= 1 ? 1 : 0, ni = wid == 2 ? 1 : 0; f32x4 acc = {0.f, 0.f, 0.f, 0.f};
            const unsigned qa = OFF_QP + (mi * 16 + (lane & 15)) * TP + (lane >> 4) * 16, ka = OFF_KP + (ni * 16 + (lane & 15)) * TP + (lane >> 4) * 16;
#pragma unroll
            for (int ks = 0; ks < 4; ++ks) { const bf16x8 a = *(const LAS bf16x8*)(L + qa + ks * 64); const bf16x8 bfr = *(const LAS bf16x8*)(L + ka + ks * 64); acc = MFMA16(a, bfr, acc); }
            const int tq = 4 * (lane >> 4), sc = lane & 15;
#pragma unroll
            for (int r = 0; r < 4; ++r) { const float v = (mi != ni || tq + r >= sc) ? acc[r] : 0.f; *(LAS bf16*)(L + OFF_A + (mi * 16 + tq + r) * 80 + (ni * 16 + sc) * 2) = (bf16)f2bf(v); } }
        else if (wid == 3 && cidx == 0) { const int t = lane >> 2, s0 = 16 + 4 * (lane & 3); *(LAS v2u*)(L + OFF_A + t * 80 + s0 * 2) = (v2u){0u, 0u}; }
        __syncthreads();
        {
            const unsigned lbase = (unsigned)(uintptr_t)L, hi = lane >> 5, g4 = lane >> 4, q4 = (lane & 15) >> 2, p4 = lane & 3, blk = (lane >> 4) & 1;
            const int mk = wid >> 1, nv0 = 2 * (wid & 1);
            s16x4 v16[2], ka[2][2], vb[2][2][2];
#pragma unroll
            for (int t = 0; t < 2; ++t) { const unsigned row = 8 * g4 + 4 * t + q4; v16[t] = tr_off<0>(lbase + OFF_V + img_off(row, 2 * wid + (p4 >> 1)) + 8 * (p4 & 1)); }
#pragma unroll
            for (int t = 0; t < 2; ++t) { const unsigned row = 8 * hi + 4 * t + q4, sw = (q4 << 2) | ((2 * hi + t) & 3u), lo8 = 8 * (p4 & 1);
                const unsigned kb = lbase + OFF_KH + 256u * row + 16u * ((unsigned)(4 * mk + 2 * blk + (p4 >> 1)) ^ sw) + lo8;
                ka[0][t] = tr_off<0>(kb); ka[1][t] = tr_off<4096>(kb);
#pragma unroll
                for (int nvi = 0; nvi < 2; ++nvi) { const unsigned vbb = lbase + OFF_V + 256u * row + 16u * ((unsigned)(4 * (nv0 + nvi) + 2 * blk + (p4 >> 1)) ^ sw) + lo8;
                    vb[nvi][0][t] = tr_off<0>(vbb); vb[nvi][1][t] = tr_off<4096>(vbb); } }
            LDS_WAIT_PIN();
            const bf16x8 vfr = CAT8(v16[0], v16[1]);
            f32x4 accO[2];
            const unsigned aa = OFF_A + (lane & 15) * 80 + g4 * 16, qa = OFF_QS + (lane & 15) * TP + g4 * 16, sa = SBc + (16 * wid + (lane & 15)) * TP + g4 * 16;
#pragma unroll
            for (int mi = 0; mi < 2; ++mi) { accO[mi] = (f32x4){0.f, 0.f, 0.f, 0.f};
                const bf16x8 afr = *(const LAS bf16x8*)(L + aa + mi * 16 * 80);
                accO[mi] = MFMA16(afr, vfr, accO[mi]);
#pragma unroll
                for (int ks = 0; ks < 4; ++ks) { const bf16x8 qf = *(const LAS bf16x8*)(L + qa + mi * 16 * TP + ks * 64); const bf16x8 sf = *(const LAS bf16x8*)(L + sa + ks * 64); accO[mi] = MFMA16(qf, sf, accO[mi]); } }
            { bf16* ob = OUT + (size_t)ROWLO(cidx) * 2048 + h * 128 + 16 * wid; const int t0 = 4 * g4;
              const unsigned o0 = (unsigned)(((dir ? 31 - t0 : t0) * 2048 + (lane & 15)) * 2); const int sgn = dir ? -4096 : 4096;
#pragma unroll
              for (int mi = 0; mi < 2; ++mi)
#pragma unroll
                  for (int r = 0; r < 4; ++r) *(bf16*)((char*)ob + (o0 + (unsigned)(sgn * (16 * mi + r)))) = (bf16)f2bf(accO[mi][r]); }
            const unsigned sbw = SBn + (lane & 31) * TP + (32 * mk) * 2 + 8 * hi;
#pragma unroll
            for (int nvi = 0; nvi < 2; ++nvi) {
#pragma unroll
                for (int g = 0; g < 4; ++g) { const f32x4 ev = *(const LAS f32x4*)(L + OFF_E + (32 * mk + 8 * g + 4 * hi) * 4);
#pragma unroll
                    for (int j = 0; j < 4; ++j) accS[nvi][4 * g + j] *= ev[j]; }
#pragma unroll
                for (int ks = 0; ks < 2; ++ks) accS[nvi] = MFMA32(CAT8(ka[ks][0], ka[ks][1]), CAT8(vb[nvi][ks][0], vb[nvi][ks][1]), accS[nvi]);
#pragma unroll
                for (int g = 0; g < 4; ++g) { v2u w; w.x = pk2(accS[nvi][4 * g], accS[nvi][4 * g + 1]); w.y = pk2(accS[nvi][4 * g + 2], accS[nvi][4 * g + 3]);
                    *(LAS v2u*)(L + sbw + 32 * (nv0 + nvi) * TP + g * 16) = w; }
            }
        }
        __syncthreads();
    }
#undef HLOAD
#undef ROWLO
}
}
namespace rt {
constexpr int QP = 528, SBP = 528, PP = 144;
constexpr int OFF_Q = 0, OFF_K = OFF_Q + 64 * QP, OFF_V = OFF_K + 32768, OFF_P = OFF_V + 16384, OFF_SB = OFF_P + 64 * PP, LDS_END = OFF_SB + 128 * SBP;
static_assert(LDS_END <= MISC_OFF, "retention LDS map");
constexpr int NCH = 4 + 64;
template <int OFF> DI s16x4 tr_off(unsigned base) { s16x4 r; asm volatile("ds_read_b64_tr_b16 %0, %1 offset:%2" : "=&v"(r) : "v"(base), "i"(OFF) : "memory"); return r; }
template <int DIR> DI void unit(Frame& F, int li, int b, int h, int vs) {
    constexpr int dir = DIR;
    const int tid = F.tid, wid = F.wave, lane0 = F.lane;
    const bf16* P = WSP(bf16, WS_P); bf16* OUT = dir ? WSP(bf16, WS_OBO) : WSP(bf16, WS_OFO);
    LAS unsigned char* L = F.lds;
    const float dl = F.ret_decay[((size_t)li * 2 + dir) * 16 + h];
    const float l2g = -log1pf(expf(-dl)) * 1.4426950408889634f;
    const float g64 = exp2f(64.0f * l2g);
    char* PK = (char*)WSP(bf16, WS_OFO) + (size_t)(((b * 16 + h) * 4 + vs) * NCH) * 16384;
    float abR[16]; float ls = 0.f; f32x16 accP; v4u fw0 = {0u, 0u, 0u, 0u}, fw1 = {0u, 0u, 0u, 0u};
#define OSTORE_B(ci) do { const int tl0_ = 32 * mt + 4 * (lane >> 5); const unsigned o0_ = (unsigned)(((63 - tl0_) * 8192 + (lane & 31)) * 2); const float baseR_ = exp2f(63.0f * l2g - (float)tl0_ * ls); \
        bf16* ob_ = OUT + (size_t)ROWLO(ci) * 8192 + h * 512 + vs * 128 + 32 * nv; const unsigned fd_[8] = {fw0.x, fw0.y, fw0.z, fw0.w, fw1.x, fw1.y, fw1.z, fw1.w}; \
        _Pragma("unroll") for (int r = 0; r < 16; ++r) { const unsigned d_ = fd_[(15 - r) >> 1]; const float of_ = __uint_as_float(((15 - r) & 1) ? (d_ & 0xffff0000u) : (d_ << 16)); \
            *(bf16*)((char*)ob_ + (o0_ - (unsigned)(16384 * ((r & 3) + 8 * (r >> 2))))) = (bf16)f2bf(accP[r] + of_ * (baseR_ * abR[r])); } } while (0)
    if constexpr (DIR == 1) {
#pragma unroll
        for (int r = 0; r < 16; ++r) accP[r] = 0.f; const float dlf = F.ret_decay[((size_t)li * 2) * 16 + h]; ls = l2g - log1pf(expf(-dlf)) * 1.4426950408889634f;
#pragma unroll
        for (int r = 0; r < 16; ++r) abR[r] = __uint_as_float((unsigned)__builtin_amdgcn_readfirstlane((int)__float_as_uint(exp2f(-(float)((r & 3) + 8 * (r >> 2)) * ls)))); }
    f32x16 accS[4];
#pragma unroll
    for (int i = 0; i < 4; ++i)
#pragma unroll
        for (int r = 0; r < 16; ++r) accS[i][r] = 0.f;
    const int qrow = tid >> 5, qc = tid & 31, vrow = tid >> 4, vc = tid & 15;
    unsigned gq[4], gv[2]; float vw[2];
#pragma unroll
    for (int i = 0; i < 4; ++i) { const int r = qrow + 16 * i; gq[i] = (unsigned)(((dir ? 63 - r : r) * O_END + qc * 8) * 2); }
#pragma unroll
    for (int i = 0; i < 2; ++i) { const int r = vrow + 32 * i; gv[i] = (unsigned)(((dir ? 63 - r : r) * O_END + vc * 8) * 2); vw[i] = exp2f((float)(63 - r) * l2g); }
    const unsigned lq = OFF_Q + qrow * QP + qc * 16, lk = OFF_K + (qc >> 4) * 16384 + img_off(qrow, qc & 15), lv = OFF_V + img_off(vrow, vc);
    v4u sq[4], sk[4], sv[2];
#define ROWLO(ci) ((ci) < 4 ? M_LAT + b * CTXL + (dir ? CTXL - 64 - (ci) * 64 : (ci) * 64) : b * SEQ + (dir ? SEQ - 64 - ((ci) - 4) * 64 : ((ci) - 4) * 64))
#define RLOAD(ci) do { const char* pb_ = (const char*)(P + (size_t)ROWLO(ci) * O_END + h * 256); const char* pv_ = (const char*)(P + (size_t)ROWLO(ci) * O_END + O_V + h * 512 + vs * 128); \
        _Pragma("unroll") for (int i = 0; i < 4; ++i) { sq[i] = *(const v4u*)(pb_ + gq[i]); sk[i] = *(const v4u*)(pb_ + O_K * 2 + gq[i]); } \
        _Pragma("unroll") for (int i = 0; i < 2; ++i) sv[i] = *(const v4u*)(pv_ + gv[i]); } while (0)
    RLOAD(0);
    const int nv = wid & 3, mk0 = 4 * (wid >> 2), mt = wid >> 2;
    if (tid < 256) { const int blk = tid >> 7, e = tid & 127, t = 32 * blk + (e >> 3), s0 = 32 * blk + 16 + 2 * (e & 7); *(LAS unsigned*)(L + OFF_P + t * PP + s0 * 2) = 0u; }
    for (int cidx = 0; cidx < NCH; ++cidx) {
        int lane = lane0; asm volatile("" : "+v"(lane));
        const int r32 = lane & 31, hi = lane >> 5;
#pragma unroll
        for (int i = 0; i < 4; ++i) { *(LAS v4u*)(L + lq + i * 16 * QP) = sq[i]; *(LAS v4u*)(L + lk + i * 4096) = sk[i]; }
#pragma unroll
        for (int i = 0; i < 2; ++i) { v4u o;
#pragma unroll
            for (int e = 0; e < 4; ++e) o[e] = pk2(bflo(sv[i][e]) * vw[i], bfhi(sv[i][e]) * vw[i]);
            *(LAS v4u*)(L + lv + i * 8192) = o; }
        __syncthreads();
        if constexpr (DIR == 1) { if (cidx > 0) OSTORE_B(cidx - 1);
            const char* src = PK + (size_t)(((cidx < 4 ? 3 - cidx : 71 - cidx) * 8 + (wid ^ 4)) * 2048 + (lane ^ 32) * 32); fw0 = *(const v4u*)src; fw1 = *(const v4u*)(src + 16); }
        if (cidx + 1 < NCH) RLOAD(cidx + 1);
        {
#pragma unroll
            for (int rep = 0; rep < 2; ++rep) { const int tl = wid + 8 * rep;
                if (tl < 10) { const int mi = tl >= 6 ? 3 : (tl >= 3 ? 2 : (tl >= 1 ? 1 : 0)), ni = tl - (mi * (mi + 1)) / 2; f32x4 acc = {0.f, 0.f, 0.f, 0.f};
                    const unsigned qa = OFF_Q + (mi * 16 + (lane & 15)) * QP + (lane >> 4) * 16;
                    const unsigned krow = ni * 16 + (lane & 15), ksw = ((krow & 3u) << 2) | ((krow >> 2) & 3u), kb = OFF_K + 256u * krow;
#pragma unroll
                    for (int ks = 0; ks < 8; ++ks) { const bf16x8 a = *(const LAS bf16x8*)(L + qa + ks * 64);
                        const bf16x8 bfr = *(const LAS bf16x8*)(L + kb + (ks >> 2) * 16384 + 16u * ((unsigned)(4 * (ks & 3) + (lane >> 4)) ^ ksw)); acc = MFMA16(a, bfr, acc); }
                    const int tq = 4 * (lane >> 4), sc = lane & 15;
#pragma unroll
                    for (int r = 0; r < 4; ++r) { const float v = (mi != ni || tq + r >= sc) ? acc[r] : 0.f;
                        *(LAS bf16*)(L + OFF_P + (mi * 16 + tq + r) * PP + (ni * 16 + sc) * 2) = (bf16)f2bf(v); } } }
            const unsigned sbw = OFF_SB + (32 * nv + r32) * SBP + 8 * hi;
#pragma unroll
            for (int i = 0; i < 4; ++i) {
#pragma unroll
                for (int r = 0; r < 16; ++r) accS[i][r] *= g64;
#pragma unroll
                for (int g = 0; g < 4; ++g) { v2u w; w.x = pk2(accS[i][4 * g], accS[i][4 * g + 1]); w.y = pk2(accS[i][4 * g + 2], accS[i][4 * g + 3]);
                    *(LAS v2u*)(L + sbw + (mk0 + i) * 64 + g * 16) = w; } } }
        __syncthreads();
        {
            const unsigned lbase = (unsigned)(uintptr_t)L;
            const unsigned q4 = (lane & 15) >> 2, p4 = lane & 3, blk = (lane >> 4) & 1;
            unsigned vbase[2], kbase[4][2];
#pragma unroll
            for (int t = 0; t < 2; ++t) { const unsigned row = 8 * hi + 4 * t + q4, sw = (q4 << 2) | ((2 * hi + t) & 3u);
                vbase[t] = lbase + OFF_V + 256u * row + 16u * ((unsigned)(4 * nv + 2 * blk + (p4 >> 1)) ^ sw) + 8 * (p4 & 1);
#pragma unroll
                for (int c = 0; c < 4; ++c) kbase[c][t] = lbase + OFF_K + (mk0 >> 2) * 16384 + 256u * row + 16u * ((unsigned)(4 * c + 2 * blk + (p4 >> 1)) ^ sw) + 8 * (p4 & 1); }
            s16x4 vf[4][2];
            vf[0][0] = tr_off<0>(vbase[0]); vf[0][1] = tr_off<0>(vbase[1]); vf[1][0] = tr_off<4096>(vbase[0]); vf[1][1] = tr_off<4096>(vbase[1]);
            vf[2][0] = tr_off<8192>(vbase[0]); vf[2][1] = tr_off<8192>(vbase[1]); vf[3][0] = tr_off<12288>(vbase[0]); vf[3][1] = tr_off<12288>(vbase[1]);
            LDS_WAIT_PIN();
            f32x16 accO, accO2;
#pragma unroll
            for (int r = 0; r < 16; ++r) { accO[r] = 0.f; accO2[r] = 0.f; }
            const unsigned pa = OFF_P + (32 * mt + r32) * PP + 16 * hi, qa = OFF_Q + (32 * mt + r32) * QP + 16 * hi, sa = OFF_SB + (32 * nv + r32) * SBP + 16 * hi;
#pragma unroll
            for (int ks = 0; ks < 4; ++ks) { if (ks < 2 || mt == 1) { const bf16x8 pf = *(const LAS bf16x8*)(L + pa + ks * 32); accO = MFMA32(pf, CAT8(vf[ks][0], vf[ks][1]), accO); } }
#pragma unroll
            for (int kg = 0; kg < 4; ++kg) {
#pragma unroll
                for (int kk = 0; kk < 4; ++kk) { const int ks = 4 * kg + kk;
                    const bf16x8 qf = *(const LAS bf16x8*)(L + qa + ks * 32); const bf16x8 sf = *(const LAS bf16x8*)(L + sa + ks * 32);
                    if (kk & 1) accO2 = MFMA32(qf, sf, accO2); else accO = MFMA32(qf, sf, accO); }
                asm volatile("" ::: "memory"); }
#pragma unroll
            for (int r = 0; r < 16; ++r) accO[r] += accO2[r];
            if constexpr (DIR == 0) { char* dst = PK + (size_t)((cidx * 8 + wid) * 2048 + lane * 32); v4u w0, w1;
              w0.x = pk2(accO[0], accO[1]); w0.y = pk2(accO[2], accO[3]); w0.z = pk2(accO[4], accO[5]); w0.w = pk2(accO[6], accO[7]);
              w1.x = pk2(accO[8], accO[9]); w1.y = pk2(accO[10], accO[11]); w1.z = pk2(accO[12], accO[13]); w1.w = pk2(accO[14], accO[15]);
              *(v4u*)dst = w0; *(v4u*)(dst + 16) = w1; }
            else accP = accO;
            s16x4 kfa[4][2], kfb[4][2];
#define KTR(dst, i_) do { dst[0][0] = tr_off<0>(kbase[i_][0]); dst[0][1] = tr_off<0>(kbase[i_][1]); dst[1][0] = tr_off<4096>(kbase[i_][0]); dst[1][1] = tr_off<4096>(kbase[i_][1]); \
                dst[2][0] = tr_off<8192>(kbase[i_][0]); dst[2][1] = tr_off<8192>(kbase[i_][1]); dst[3][0] = tr_off<12288>(kbase[i_][0]); dst[3][1] = tr_off<12288>(kbase[i_][1]); } while (0)
#define KMM(src, i_) do { _Pragma("unroll") for (int ks = 0; ks < 4; ++ks) accS[i_] = MFMA32(CAT8(src[ks][0], src[ks][1]), CAT8(vf[ks][0], vf[ks][1]), accS[i_]); } while (0)
            KTR(kfa, 0); KTR(kfb, 1);
            asm volatile("s_waitcnt lgkmcnt(8)" ::: "memory"); __builtin_amdgcn_sched_barrier(0);
            KMM(kfa, 0); __builtin_amdgcn_sched_barrier(0);
            KTR(kfa, 2);
            asm volatile("s_waitcnt lgkmcnt(8)" ::: "memory"); __builtin_amdgcn_sched_barrier(0);
            KMM(kfb, 1); __builtin_amdgcn_sched_barrier(0);
            KTR(kfb, 3);
            asm volatile("s_waitcnt lgkmcnt(8)" ::: "memory"); __builtin_amdgcn_sched_barrier(0);
            KMM(kfa, 2); __builtin_amdgcn_sched_barrier(0);
            LDS_WAIT_PIN();
            KMM(kfb, 3);
#undef KTR
#undef KMM
        }
        __syncthreads();
    }
    if constexpr (DIR == 1) { int lane = lane0; asm volatile("" : "+v"(lane)); OSTORE_B(NCH - 1); }
#undef OSTORE_B
#undef RLOAD
#undef ROWLO
}
}
#ifndef MK_MULTI
#define MK_MULTI 0
#endif
constexpr int N_PHASES = 2 + 2 * 13;
struct Args { const float* in[20]; float* out; unsigned char* ws; int ph_lo, ph_hi; };
__global__ void __launch_bounds__(NWAVES * 64, 2) fwd_kernel(Args args) {
    extern __shared__ __attribute__((aligned(16))) unsigned char lds_raw[];
    Frame F0;
    F0.lds = (LAS unsigned char*)lds_raw;
    F0.tid = threadIdx.x; F0.lane = F0.tid & 63; F0.wave = __builtin_amdgcn_readfirstlane(F0.tid >> 6);
    F0.G = gridDim.x; { const int bx = blockIdx.x; F0.vcu = (F0.G % 8 == 0) ? (bx % 8) * (F0.G / 8) + bx / 8 : bx; }
    F0.ws = args.ws; F0.out = args.out;
    LAS unsigned* MISC = (LAS unsigned*)(F0.lds + MISC_OFF);
    if (F0.tid < 16) MISC[F0.tid] = 0u;
    if (F0.tid < 20) { const unsigned long long pv = (unsigned long long)(uintptr_t)args.in[F0.tid]; MISC[16 + 2 * F0.tid] = (unsigned)pv; MISC[17 + 2 * F0.tid] = (unsigned)(pv >> 32); }
    __syncthreads();
    unsigned* ctl = (unsigned*)(F0.ws + WS_CTL);
    if (!MK_MULTI) (void)xcd_barrier_post(ctl + CW_BAR, (volatile LAS unsigned*)(MISC + 8));
#define GRID_BAR() do { XcdBarrier b_; b_.bar = (unsigned*)(F0.ws + WS_CTL) + CW_BAR; b_.x = xb_xcc_id(); b_.st = (volatile LAS unsigned*)(F0.lds + MISC_OFF + 32); xcd_barrier(b_); } while (0)
    const int lo = args.ph_lo, hi = args.ph_hi;
    int ph = 0;
#ifndef PHASE_MASK
#define PHASE_MASK 0xFFFFFFFFu
#endif
#ifndef RT_REPS
#define RT_REPS 1
#endif
#ifndef REP_MASK
#define REP_MASK 0u
#endif
#define PH_BEGIN(kind) if ((((PHASE_MASK) >> (kind)) & 1u) && lo <= ph && ph < hi) for (int rep_ = 0; rep_ < ((((REP_MASK) >> (kind)) & 1u) ? 2 : 1); ++rep_) { if (rep_) __syncthreads(); Frame F = F0; { int t_ = F0.tid; asm volatile("" : "+v"(t_)); F.tid = t_; F.lane = t_ & 63; F.wave = __builtin_amdgcn_readfirstlane(t_ >> 6); } LOADPTRS(F);
#define PH_END   } if (!MK_MULTI && lo <= ph && ph + 1 < hi) GRID_BAR(); ++ph;
#define PH_END_NOBAR }

    PH_BEGIN(0) ph_prologue(F); PH_END
    PH_BEGIN(1) ph_finalize(F); PH_END
    bf16* XS = (bf16*)(F0.ws + WS_XS);
    { constexpr int L2 = 0;
        { const int l = 2 * L2, i = L2;
          const bool first = (L2 == 0);
          PH_BEGIN(2) ph_ada_in(F, l, first ? (const void*)F.x : (const void*)XS, first, first ? (const void*)F.ctx : (const void*)(XS + (size_t)M_LAT * DM), first); PH_END
          PH_BEGIN(3) { { pg8::Gemm g{WSP(pg8::bf16_t, WS_H), WSP(pg8::bf16_t, WS_WINE) + (size_t)i * E_PAD * DM, MT, E_PAD, DM}; pg8::EvenInOrder S; S.init(F.G, (int)blockIdx.x);
                       pg8::EpiBf16 E{WSP(pg8::bf16_t, WS_P), E_PAD}; pg8::gemm_phase<pg8::EpiBf16, pg8::EvenInOrder, PG8_ALIGN, PG8_SP2>(F.lds, g, S, E); }
                     __syncthreads();
                     { pg8::Gemm g{WSP(pg8::bf16_t, WS_H) + (size_t)M_LAT * DM, WSP(pg8::bf16_t, WS_WINE) + ((size_t)i * E_PAD + 48 * 256) * DM, M_CTX, 9 * 256, DM / 4, DM}; pg8::CtxSplitOrder S; S.init(F.G, (int)blockIdx.x, DM, 144);
                       pg8::EpiPart E{WSP(float, WS_PART), DM}; pg8::gemm_phase<pg8::EpiPart, pg8::CtxSplitOrder, PG8_ALIGN, PG8_SP2>(F.lds, g, S, E); } } PH_END
          PH_BEGIN(4) { ph_tail_fold(F); ph_lora_norm(F, i); } PH_END
          PH_BEGIN(5) { { pg8::Gemm g{WSP(pg8::bf16_t, WS_CQN), WSP(pg8::bf16_t, WS_WUQ) + (size_t)i * NQ * Q_LORA, MT, NQ, Q_LORA}; pg8::StaticOrder S; S.init(MT, NQ, F.G, (int)blockIdx.x);
                       pg8::EpiBf16 E{WSP(pg8::bf16_t, WS_QF), NQ}; pg8::gemm_phase<pg8::EpiBf16, pg8::StaticOrder, PG8_ALIGN, PG8_SP2>(F.lds, g, S, E); } __syncthreads(); } PH_END_NOBAR
          PH_BEGIN(16) { { pg8::Gemm g{WSP(pg8::bf16_t, WS_CKVN), WSP(pg8::bf16_t, WS_WUKV) + (size_t)i * NKV * KV_LORA, MT, NKV, KV_LORA}; pg8::UkvOrder S; S.init(MT, NKV, F.G, (int)blockIdx.x);
                       pg8::EpiBf16 E{WSP(pg8::bf16_t, WS_KV), NKV}; pg8::gemm_phase<pg8::EpiBf16, pg8::UkvOrder, PG8_ALIGN, PG8_SP2>(F.lds, g, S, E); } } PH_END
          PH_BEGIN(6) ph_qk_norm_rope(F, i); PH_END
          PH_BEGIN(17) { for (int s = 0; s < 128; ++s) if ((64 + s) % F.G == F.vcu) { hg::unit(F, i, s >> 5, (s >> 1) & 15, s & 1); __syncthreads(); } } PH_END_NOBAR
#if defined(CLK_PROBE) && defined(CLK_SITE_ATT)
          long long clkA_ = 0, rtA_ = 0; if (L2 == 0 && lo <= ph && ph < hi) { clkA_ = clock64(); rtA_ = wall_clock64(); }
#endif
          PH_BEGIN(7) {
#ifndef NO_ATT
              {
                  unsigned* qctr = (unsigned*)(F.ws + WS_CTL) + CW_QUEUE + 64 * L2; unsigned* cctr = qctr + 128;
                  LAS unsigned* qslot = (LAS unsigned*)(F.lds + MISC_OFF) + 14;
                  constexpr int CONV_LIST = 1 + L2, CONV_LEN = CONV_LIST_LEN[CONV_LIST], CONV_BATCH = 256, CONV_NW = (CONV_LEN + CONV_BATCH - 1) / CONV_BATCH, CONV_NB = CONV_NW + (L2 == 0 ? ADALN_NB : 0);
                  int cb = 0;
                  for (;;) {
                      if (F.tid == 0) *qslot = __hip_atomic_fetch_add(qctr, 1u, __ATOMIC_RELAXED, __HIP_MEMORY_SCOPE_AGENT);
                      __syncthreads();
                      const int u = __builtin_amdgcn_readfirstlane((int)*qslot);
                      __syncthreads();
                      Frame Fu = F; { int t_ = F.tid; asm volatile("" : "+v"(t_)); Fu.tid = t_; Fu.lane = t_ & 63; Fu.wave = __builtin_amdgcn_readfirstlane(t_ >> 6); }
                      if (u < 1024) { const int b = u >> 8, h = (u >> 4) & 15, qb = u & 15; att::unit(Fu, h, b * SEQ + qb * 256, b * SEQ, 64, M_LAT + b * CTXL, 68, E_PAD); }
                      else if (u < 1088) { const int v = u - 1024, b = v >> 4, h = v & 15; att::unit(Fu, h, M_LAT + b * CTXL, 0, 0, M_LAT + b * CTXL, 4, E_PAD); }
                      if (cb < CONV_NB) {
                          if (F.tid == 0) qslot[1] = __hip_atomic_fetch_add(cctr, 1u, __ATOMIC_RELAXED, __HIP_MEMORY_SCOPE_AGENT);
                          __syncthreads();
                          cb = __builtin_amdgcn_readfirstlane((int)qslot[1]);
                          __syncthreads();
                          if (cb < CONV_NB) { const int e0 = cb * CONV_BATCH, e1 = e0 + CONV_BATCH < CONV_LEN ? e0 + CONV_BATCH : CONV_LEN; Frame Fc = F; { int t_ = F.tid; asm volatile("" : "+v"(t_)); Fc.tid = t_; Fc.lane = t_ & 63; Fc.wave = __builtin_amdgcn_readfirstlane(t_ >> 6); }
                              if (cb < CONV_NW) { conv_items(Fc, CONV_LIST, e0 + Fc.wave, e1, NWAVES); __syncthreads(); } else adaln_batch(Fc, cb - CONV_NW); } }
                      if (u >= 1088 && cb >= CONV_NB) break; } }
#endif
#if defined(CLK_PROBE) && defined(CLK_SITE_ATT)
              if (L2 == 0 && blockIdx.x == CLK_PROBE && F.tid == 0) { const long long dc = clock64() - clkA_, dr = wall_clock64() - rtA_; ((LAS unsigned*)(F0.lds + MISC_OFF))[12] = (unsigned)((dc * 10000) / (dr > 0 ? dr : 1)); }
#endif
              } PH_END
          PH_BEGIN(8) { if constexpr (L2 == 0) ph_finalize_mod(F, 1, 4); ph_hg_merge(F, i); } PH_END
          PH_BEGIN(9) { { pg8::Gemm g{WSP(pg8::bf16_t, WS_A), WSP(pg8::bf16_t, WS_WOE) + (size_t)i * DM * DM, M_LAT, DM, DM, 0}; pg8::StaticOrder S; S.init(M_LAT, DM, F.G, (int)blockIdx.x);
                       if constexpr (L2 == 0) { pg8::EpiResT<false, true> E{F.x, XS, WSP(float, WS_MOD) + (size_t)l * 5 * MODW + 2 * DM}; pg8::gemm_phase<pg8::EpiResT<false, true>, pg8::StaticOrder, PG8_ALIGN, PG8_SP2>(F.lds, g, S, E); }
                       else { pg8::EpiResT<true, true> E{XS, XS, WSP(float, WS_MOD) + (size_t)l * 5 * MODW + 2 * DM}; pg8::gemm_phase<pg8::EpiResT<true, true>, pg8::StaticOrder, PG8_ALIGN, PG8_SP2>(F.lds, g, S, E); } }
                     __syncthreads();
                     { pg8::Gemm g{WSP(pg8::bf16_t, WS_A) + (size_t)M_LAT * DM, WSP(pg8::bf16_t, WS_WOE) + (size_t)i * DM * DM, M_CTX, DM, DM / 4, DM}; pg8::CtxSplitOrder S; S.init(F.G, (int)blockIdx.x, DM);
                       pg8::EpiPart E{WSP(float, WS_PART), DM}; pg8::gemm_phase<pg8::EpiPart, pg8::CtxSplitOrder, PG8_ALIGN, PG8_SP2>(F.lds, g, S, E); } } PH_END
        }
        { const int l = 2 * L2 + 1, i = L2; const bool last = (L2 == 1);
          PH_BEGIN(10) ph_ada_in(F, l, XS, false, L2 == 0 ? (const void*)F.ctx : (const void*)(XS + (size_t)M_LAT * DM), L2 == 0); PH_END
#ifdef CLK_PROBE
          long long clk0_ = 0, rt0_ = 0; if (L2 == 0 && lo <= ph && ph < hi) { clk0_ = clock64(); rt0_ = wall_clock64(); }
#endif
          PH_BEGIN(11) { pg8::Gemm g{WSP(pg8::bf16_t, WS_H), WSP(pg8::bf16_t, WS_WINO) + (size_t)i * O_END * DM, MT, O_END, DM}; pg8::EpiBf16Rope E{WSP(pg8::bf16_t, WS_P), O_END, WSP(float, WS_COS), WSP(float, WS_SIN)};
                     if constexpr (L2 == 1) { pg8::LastOddOrder S; S.init(F.G, (int)blockIdx.x); pg8::gemm_phase<pg8::EpiBf16Rope, pg8::LastOddOrder, PG8_ALIGN, PG8_SP2>(F.lds, g, S, E); }
                     else { { pg8::OddInOrder S; S.init(F.G, (int)blockIdx.x); pg8::gemm_phase<pg8::EpiBf16Rope, pg8::OddInOrder, PG8_ALIGN, PG8_SP2>(F.lds, g, S, E); }
                            __syncthreads();
                            pg8::Gemm g2{WSP(pg8::bf16_t, WS_H) + (size_t)M_LAT * DM, WSP(pg8::bf16_t, WS_WINO) + ((size_t)i * O_END + O_G) * DM, M_CTX, 8192, DM / 2, DM}; pg8::CtxSplitOrder S2; S2.init(F.G, (int)blockIdx.x, DM, 256, 2);
                            pg8::EpiPart E2{WSP(float, WS_PART), 8192}; pg8::gemm_phase<pg8::EpiPart, pg8::CtxSplitOrder, PG8_ALIGN, PG8_SP2>(F.lds, g2, S2, E2); } }
#if defined(CLK_PROBE) && !defined(CLK_SITE_ATT)
          if (L2 == 0 && blockIdx.x == CLK_PROBE && F.tid == 0) { const long long dc = clock64() - clk0_, dr = wall_clock64() - rt0_; ((LAS unsigned*)(F0.lds + MISC_OFF))[12] = (unsigned)((dc * 10000) / (dr > 0 ? dr : 1)); }
#endif
          PH_END
          PH_BEGIN(13) { for (int p0 = F.vcu; p0 < 256 * RT_REPS; p0 += F.G) { const int p = p0 & 255;
                             rt::unit<0>(F, i, p >> 6, (p >> 2) & 15, p & 3); __syncthreads(); if (F.tid == 0) __threadfence(); __syncthreads();
                             rt::unit<1>(F, i, p >> 6, (p >> 2) & 15, p & 3); __syncthreads(); } } PH_END
          PH_BEGIN(14) ph_ret_merge(F, i, L2 == 0); PH_END
          PH_BEGIN(15) { { pg8::Gemm g{WSP(pg8::bf16_t, WS_A), WSP(pg8::bf16_t, WS_WOO) + (size_t)i * DM * 8192, M_LAT, DM, 8192, 0}; pg8::StaticOrder S; S.init(M_LAT, DM, F.G, (int)blockIdx.x);
                       if constexpr (L2 == 1) { pg8::EpiResT<true, false> E{XS, F.out, WSP(float, WS_MOD) + (size_t)l * 5 * MODW + 2 * DM}; pg8::gemm_phase<pg8::EpiResT<true, false>, pg8::StaticOrder, PG8_ALIGN, PG8_SP2>(F.lds, g, S, E); }
                       else { pg8::EpiResT<true, true> E{XS, XS, WSP(float, WS_MOD) + (size_t)l * 5 * MODW + 2 * DM}; pg8::gemm_phase<pg8::EpiResT<true, true>, pg8::StaticOrder, PG8_ALIGN, PG8_SP2>(F.lds, g, S, E); } }
                     if constexpr (L2 == 0) { __syncthreads();
                       pg8::Gemm g{WSP(pg8::bf16_t, WS_A) + (size_t)M_LAT * 8192, WSP(pg8::bf16_t, WS_WOO) + (size_t)i * DM * 8192, M_CTX, DM, 8192 / 4, 8192}; pg8::CtxSplitOrder S; S.init(F.G, (int)blockIdx.x, 8192);
                       pg8::EpiPart E{WSP(float, WS_PART), DM}; pg8::gemm_phase<pg8::EpiPart, pg8::CtxSplitOrder, PG8_ALIGN, PG8_SP2>(F.lds, g, S, E); } } PH_END
        }
    }
    { constexpr int L2 = 1;
        { const int l = 2 * L2, i = L2;
          const bool first = (L2 == 0);
          PH_BEGIN(2) ph_ada_in(F, l, first ? (const void*)F.x : (const void*)XS, first, first ? (const void*)F.ctx : (const void*)(XS + (size_t)M_LAT * DM), first); PH_END
          PH_BEGIN(3) { { pg8::Gemm g{WSP(pg8::bf16_t, WS_H), WSP(pg8::bf16_t, WS_WINE) + (size_t)i * E_PAD * DM, MT, E_PAD, DM}; pg8::EvenInOrder S; S.init(F.G, (int)blockIdx.x);
                       pg8::EpiBf16 E{WSP(pg8::bf16_t, WS_P), E_PAD}; pg8::gemm_phase<pg8::EpiBf16, pg8::EvenInOrder, PG8_ALIGN, PG8_SP2>(F.lds, g, S, E); }
                     __syncthreads();
                     { pg8::Gemm g{WSP(pg8::bf16_t, WS_H) + (size_t)M_LAT * DM, WSP(pg8::bf16_t, WS_WINE) + ((size_t)i * E_PAD + 48 * 256) * DM, M_CTX, 9 * 256, DM / 4, DM}; pg8::CtxSplitOrder S; S.init(F.G, (int)blockIdx.x, DM, 144);
                       pg8::EpiPart E{WSP(float, WS_PART), DM}; pg8::gemm_phase<pg8::EpiPart, pg8::CtxSplitOrder, PG8_ALIGN, PG8_SP2>(F.lds, g, S, E); } } PH_END
          PH_BEGIN(4) { ph_tail_fold(F); ph_lora_norm(F, i); } PH_END
          PH_BEGIN(5) { { pg8::Gemm g{WSP(pg8::bf16_t, WS_CQN), WSP(pg8::bf16_t, WS_WUQ) + (size_t)i * NQ * Q_LORA, MT, NQ, Q_LORA}; pg8::StaticOrder S; S.init(MT, NQ, F.G, (int)blockIdx.x);
                       pg8::EpiBf16 E{WSP(pg8::bf16_t, WS_QF), NQ}; pg8::gemm_phase<pg8::EpiBf16, pg8::StaticOrder, PG8_ALIGN, PG8_SP2>(F.lds, g, S, E); } __syncthreads(); } PH_END_NOBAR
          PH_BEGIN(16) { { pg8::Gemm g{WSP(pg8::bf16_t, WS_CKVN), WSP(pg8::bf16_t, WS_WUKV) + (size_t)i * NKV * KV_LORA, MT, NKV, KV_LORA}; pg8::UkvOrder S; S.init(MT, NKV, F.G, (int)blockIdx.x);
                       pg8::EpiBf16 E{WSP(pg8::bf16_t, WS_KV), NKV}; pg8::gemm_phase<pg8::EpiBf16, pg8::UkvOrder, PG8_ALIGN, PG8_SP2>(F.lds, g, S, E); } } PH_END
          PH_BEGIN(6) ph_qk_norm_rope(F, i); PH_END
          PH_BEGIN(17) { for (int s = 0; s < 128; ++s) if ((64 + s) % F.G == F.vcu) { hg::unit(F, i, s >> 5, (s >> 1) & 15, s & 1); __syncthreads(); } } PH_END_NOBAR
#if defined(CLK_PROBE) && defined(CLK_SITE_ATT)
          long long clkA_ = 0, rtA_ = 0; if (L2 == 0 && lo <= ph && ph < hi) { clkA_ = clock64(); rtA_ = wall_clock64(); }
#endif
          PH_BEGIN(7) {
#ifndef NO_ATT
              {
                  unsigned* qctr = (unsigned*)(F.ws + WS_CTL) + CW_QUEUE + 64 * L2; unsigned* cctr = qctr + 128;
                  LAS unsigned* qslot = (LAS unsigned*)(F.lds + MISC_OFF) + 14;
                  constexpr int CONV_LIST = 1 + L2, CONV_LEN = CONV_LIST_LEN[CONV_LIST], CONV_BATCH = 256, CONV_NW = (CONV_LEN + CONV_BATCH - 1) / CONV_BATCH, CONV_NB = CONV_NW + (L2 == 0 ? ADALN_NB : 0);
                  int cb = 0;
                  for (;;) {
                      if (F.tid == 0) *qslot = __hip_atomic_fetch_add(qctr, 1u, __ATOMIC_RELAXED, __HIP_MEMORY_SCOPE_AGENT);
                      __syncthreads();
                      const int u = __builtin_amdgcn_readfirstlane((int)*qslot);
                      __syncthreads();
                      Frame Fu = F; { int t_ = F.tid; asm volatile("" : "+v"(t_)); Fu.tid = t_; Fu.lane = t_ & 63; Fu.wave = __builtin_amdgcn_readfirstlane(t_ >> 6); }
                      if (u < 1024) { const int b = u >> 8, h = (u >> 4) & 15, qb = u & 15; att::unit(Fu, h, b * SEQ + qb * 256, b * SEQ, 64, M_LAT + b * CTXL, 68, E_PAD); }
                      else if (u < 1088) { const int v = u - 1024, b = v >> 4, h = v & 15; att::unit(Fu, h, M_LAT + b * CTXL, 0, 0, M_LAT + b * CTXL, 4, E_PAD); }
                      if (cb < CONV_NB) {
                          if (F.tid == 0) qslot[1] = __hip_atomic_fetch_add(cctr, 1u, __ATOMIC_RELAXED, __HIP_MEMORY_SCOPE_AGENT);
                          __syncthreads();
                          cb = __builtin_amdgcn_readfirstlane((int)qslot[1]);
                          __syncthreads();
                          if (cb < CONV_NB) { const int e0 = cb * CONV_BATCH, e1 = e0 + CONV_BATCH < CONV_LEN ? e0 + CONV_BATCH : CONV_LEN; Frame Fc = F; { int t_ = F.tid; asm volatile("" : "+v"(t_)); Fc.tid = t_; Fc.lane = t_ & 63; Fc.wave = __builtin_amdgcn_readfirstlane(t_ >> 6); }
                              if (cb < CONV_NW) { conv_items(Fc, CONV_LIST, e0 + Fc.wave, e1, NWAVES); __syncthreads(); } else adaln_batch(Fc, cb - CONV_NW); } }
                      if (u >= 1088 && cb >= CONV_NB) break; } }
#endif
#if defined(CLK_PROBE) && defined(CLK_SITE_ATT)
              if (L2 == 0 && blockIdx.x == CLK_PROBE && F.tid == 0) { const long long dc = clock64() - clkA_, dr = wall_clock64() - rtA_; ((LAS unsigned*)(F0.lds + MISC_OFF))[12] = (unsigned)((dc * 10000) / (dr > 0 ? dr : 1)); }
#endif
              } PH_END
          PH_BEGIN(8) { if constexpr (L2 == 0) ph_finalize_mod(F, 1, 4); ph_hg_merge(F, i); } PH_END
          PH_BEGIN(9) { { pg8::Gemm g{WSP(pg8::bf16_t, WS_A), WSP(pg8::bf16_t, WS_WOE) + (size_t)i * DM * DM, M_LAT, DM, DM, 0}; pg8::StaticOrder S; S.init(M_LAT, DM, F.G, (int)blockIdx.x);
                       if constexpr (L2 == 0) { pg8::EpiResT<false, true> E{F.x, XS, WSP(float, WS_MOD) + (size_t)l * 5 * MODW + 2 * DM}; pg8::gemm_phase<pg8::EpiResT<false, true>, pg8::StaticOrder, PG8_ALIGN, PG8_SP2>(F.lds, g, S, E); }
                       else { pg8::EpiResT<true, true> E{XS, XS, WSP(float, WS_MOD) + (size_t)l * 5 * MODW + 2 * DM}; pg8::gemm_phase<pg8::EpiResT<true, true>, pg8::StaticOrder, PG8_ALIGN, PG8_SP2>(F.lds, g, S, E); } }
                     __syncthreads();
                     { pg8::Gemm g{WSP(pg8::bf16_t, WS_A) + (size_t)M_LAT * DM, WSP(pg8::bf16_t, WS_WOE) + (size_t)i * DM * DM, M_CTX, DM, DM / 4, DM}; pg8::CtxSplitOrder S; S.init(F.G, (int)blockIdx.x, DM);
                       pg8::EpiPart E{WSP(float, WS_PART), DM}; pg8::gemm_phase<pg8::EpiPart, pg8::CtxSplitOrder, PG8_ALIGN, PG8_SP2>(F.lds, g, S, E); } } PH_END
        }
        { const int l = 2 * L2 + 1, i = L2; const bool last = (L2 == 1);
          PH_BEGIN(10) ph_ada_in(F, l, XS, false, L2 == 0 ? (const void*)F.ctx : (const void*)(XS + (size_t)M_LAT * DM), L2 == 0); PH_END
#ifdef CLK_PROBE
          long long clk0_ = 0, rt0_ = 0; if (L2 == 0 && lo <= ph && ph < hi) { clk0_ = clock64(); rt0_ = wall_clock64(); }
#endif
          PH_BEGIN(11) { pg8::Gemm g{WSP(pg8::bf16_t, WS_H), WSP(pg8::bf16_t, WS_WINO) + (size_t)i * O_END * DM, MT, O_END, DM}; pg8::EpiBf16Rope E{WSP(pg8::bf16_t, WS_P), O_END, WSP(float, WS_COS), WSP(float, WS_SIN)};
                     if constexpr (L2 == 1) { pg8::LastOddOrder S; S.init(F.G, (int)blockIdx.x); pg8::gemm_phase<pg8::EpiBf16Rope, pg8::LastOddOrder, PG8_ALIGN, PG8_SP2>(F.lds, g, S, E); }
                     else { { pg8::OddInOrder S; S.init(F.G, (int)blockIdx.x); pg8::gemm_phase<pg8::EpiBf16Rope, pg8::OddInOrder, PG8_ALIGN, PG8_SP2>(F.lds, g, S, E); }
                            __syncthreads();
                            pg8::Gemm g2{WSP(pg8::bf16_t, WS_H) + (size_t)M_LAT * DM, WSP(pg8::bf16_t, WS_WINO) + ((size_t)i * O_END + O_G) * DM, M_CTX, 8192, DM / 2, DM}; pg8::CtxSplitOrder S2; S2.init(F.G, (int)blockIdx.x, DM, 256, 2);
                            pg8::EpiPart E2{WSP(float, WS_PART), 8192}; pg8::gemm_phase<pg8::EpiPart, pg8::CtxSplitOrder, PG8_ALIGN, PG8_SP2>(F.lds, g2, S2, E2); } }
#if defined(CLK_PROBE) && !defined(CLK_SITE_ATT)
          if (L2 == 0 && blockIdx.x == CLK_PROBE && F.tid == 0) { const long long dc = clock64() - clk0_, dr = wall_clock64() - rt0_; ((LAS unsigned*)(F0.lds + MISC_OFF))[12] = (unsigned)((dc * 10000) / (dr > 0 ? dr : 1)); }
#endif
          PH_END
          PH_BEGIN(13) { for (int p0 = F.vcu; p0 < 256 * RT_REPS; p0 += F.G) { const int p = p0 & 255;
                             rt::unit<0>(F, i, p >> 6, (p >> 2) & 15, p & 3); __syncthreads(); if (F.tid == 0) __threadfence(); __syncthreads();
                             rt::unit<1>(F, i, p >> 6, (p >> 2) & 15, p & 3); __syncthreads(); } } PH_END
          PH_BEGIN(14) ph_ret_merge(F, i, L2 == 0); PH_END
          PH_BEGIN(15) { { pg8::Gemm g{WSP(pg8::bf16_t, WS_A), WSP(pg8::bf16_t, WS_WOO) + (size_t)i * DM * 8192, M_LAT, DM, 8192, 0}; pg8::StaticOrder S; S.init(M_LAT, DM, F.G, (int)blockIdx.x);
                       if constexpr (L2 == 1) { pg8::EpiResT<true, false> E{XS, F.out, WSP(float, WS_MOD) + (size_t)l * 5 * MODW + 2 * DM}; pg8::gemm_phase<pg8::EpiResT<true, false>, pg8::StaticOrder, PG8_ALIGN, PG8_SP2>(F.lds, g, S, E); }
                       else { pg8::EpiResT<true, true> E{XS, XS, WSP(float, WS_MOD) + (size_t)l * 5 * MODW + 2 * DM}; pg8::gemm_phase<pg8::EpiResT<true, true>, pg8::StaticOrder, PG8_ALIGN, PG8_SP2>(F.lds, g, S, E); } }
                     if constexpr (L2 == 0) { __syncthreads();
                       pg8::Gemm g{WSP(pg8::bf16_t, WS_A) + (size_t)M_LAT * 8192, WSP(pg8::bf16_t, WS_WOO) + (size_t)i * DM * 8192, M_CTX, DM, 8192 / 4, 8192}; pg8::CtxSplitOrder S; S.init(F.G, (int)blockIdx.x, 8192);
                       pg8::EpiPart E{WSP(float, WS_PART), DM}; pg8::gemm_phase<pg8::EpiPart, pg8::CtxSplitOrder, PG8_ALIGN, PG8_SP2>(F.lds, g, S, E); } } PH_END
        }
    }
#ifdef CLK_PROBE
    __syncthreads();
    if (blockIdx.x == CLK_PROBE && F0.tid == 0) { const unsigned long long ticks = ((LAS unsigned*)(F0.lds + MISC_OFF))[12]; const unsigned long long t0 = wall_clock64(); while ((unsigned long long)wall_clock64() - t0 < ticks) __builtin_amdgcn_s_sleep(8); }
#endif
#undef PH_BEGIN
#undef PH_END
}

extern "C" void kernel_launch(void* const* d_in, const int* in_sizes, int n_in, void* d_out, int out_size, void* d_ws, size_t ws_size, hipStream_t stream) {
    static int grid = 0;
    if (grid == 0) {
        if (n_in != 20 || in_sizes[0] != M_LAT * DM || out_size != M_LAT * DM || ws_size < WS_END4) {
            fprintf(stderr, "kernel_launch: shape mismatch (n_in %d, in0 %d, out %d, ws %zu need %zu); nothing launched\n", n_in, n_in > 0 ? in_sizes[0] : -1, out_size, ws_size, (size_t)WS_END4); grid = -1; return; }
        int dev = 0, cus = 0, per_cu = 0;
        if (hipGetDevice(&dev) != hipSuccess || hipDeviceGetAttribute(&cus, hipDeviceAttributeMultiprocessorCount, dev) != hipSuccess) { grid = -1; return; }
        if (hipFuncSetAttribute((const void*)fwd_kernel, hipFuncAttributeMaxDynamicSharedMemorySize, LDS_BYTES) != hipSuccess) { fprintf(stderr, "kernel_launch: hipFuncSetAttribute failed\n"); grid = -1; return; }
        if (hipOccupancyMaxActiveBlocksPerMultiprocessor(&per_cu, (const void*)fwd_kernel, NWAVES * 64, LDS_BYTES) != hipSuccess || per_cu < 1) { fprintf(stderr, "kernel_launch: occupancy query says %d\n", per_cu); }
        (void)hipGetLastError();
        grid = cus;
    }
    if (grid < 0) return;
    if (hipMemsetAsync((char*)d_ws + WS_CTL, 0, CTL_ZERO_BYTES, stream) != hipSuccess) return;
    Args a{};
    for (int i = 0; i < 20; ++i) a.in[i] = (const float*)d_in[i];
    a.out = (float*)d_out; a.ws = (unsigned char*)d_ws;
#if MK_MULTI
#ifndef DBG_HI
#define DBG_HI N_PHASES
#endif
#ifndef DBG_LO
#define DBG_LO 0
#endif
    for (int p = DBG_LO; p < DBG_HI; ++p) { a.ph_lo = p; a.ph_hi = p + 1; hipLaunchKernelGGL(fwd_kernel, dim3(grid), dim3(NWAVES * 64), LDS_BYTES, stream, a); }
#else
    a.ph_lo = 0; a.ph_hi = N_PHASES; hipLaunchKernelGGL(fwd_kernel, dim3(grid), dim3(NWAVES * 64), LDS_BYTES, stream, a);
#endif
    const hipError_t le = hipPeekAtLastError();
    if (le != hipSuccess) fprintf(stderr, "kernel_launch: launch failed: %s\n", hipGetErrorName(le));
}
```

```cpp
#include <hip/hip_runtime.h>
#include <cstdio>
#include <cstdint>
namespace pg8 {
#define PG8_LAS __attribute__((address_space(3)))
typedef unsigned short bf16_t;
typedef short bf16x8 __attribute__((ext_vector_type(8)));
typedef float f32x4 __attribute__((ext_vector_type(4)));
typedef unsigned u32x4 __attribute__((ext_vector_type(4)));
constexpr int BM = 256, BK = 64, HALF = 128, HTB = HALF * BK * 2  , STAGE_BYTES = 8 * HTB, NXCD = 8, WGM = 8;

__host__ __device__ __forceinline__ int lds_byte(int r, int c) { const int st = (r >> 4) * 2 + (c >> 5), rr = r & 15, cc = c & 31, ob = rr * 64 + cc * 2; return st * 1024 + (ob ^ (((ob >> 9) & 1) << 5)); }
__host__ __device__ __forceinline__ void stage_rc(int b, int& R, int& C) { const int st = b / 1024, sb = b % 1024, swz = sb ^ (((sb >> 9) & 1) << 5); R = (st >> 1) * 16 + swz / 64; C = (st & 1) * 32 + (swz % 64) / 2; }
__host__ __device__ __forceinline__ int perm32(int rho) { const int n = rho >> 4, i = rho & 15; return 8 * (i >> 2) + 4 * n + (i & 3); }

struct Unit { int pm, pn, kq; };
struct Gemm { const bf16_t* A; const bf16_t* Bt; int M, N, K; int ld; };

struct StaticOrder {
    int nM, nN, nwg, G, c;
    __host__ __device__ void init(int M, int N, int G_, int c_) { nM = M / BM; nN = N / BM; nwg = nM * nN; G = G_; c = c_; }
    __host__ __device__ bool next(int i, Unit& u) const { return tile((long)i * G + c, u); }
    __host__ __device__ bool tile(long L, Unit& u) const {
        if (L >= nwg) return false;
        int wgid = (int)L; { const int q = nwg / NXCD, r = nwg % NXCD, xcd = wgid % NXCD, off = wgid / NXCD; wgid = (xcd < r ? xcd * (q + 1) : r * (q + 1) + (xcd - r) * q) + off; }
        const int nig = WGM * nN, gid = wgid / nig, fm = gid * WGM, gsz = (nM - fm) < WGM ? (nM - fm) : WGM;
        u.pm = fm + ((wgid % nig) % gsz); u.pn = (wgid % nig) / gsz; return true;
    }
    __device__ __forceinline__ void a_ready(const Unit&) const {}
    __device__ __forceinline__ void done(const Unit&) const {}
    __device__ __forceinline__ size_t aoff(const Unit& u, size_t tstep) const { return (size_t)u.pm * tstep; }
    __device__ __forceinline__ size_t boff(const Unit& u, size_t tstep) const { return (size_t)u.pn * tstep; }
};
__device__ __forceinline__ unsigned cvt_pk_bf16(float lo, float hi) { unsigned r; asm volatile("v_cvt_pk_bf16_f32 %0, %1, %2" : "=v"(r) : "v"(lo), "v"(hi)); return r; }
struct EpiBf16 {
    static constexpr bool PERM = true, AFTER_DRAIN = false;
    bf16_t* O; int ldc;
    __device__ __forceinline__ void operator()(const f32x4 (&acc)[2][2][4][2], const Unit& u, int wr, int wc, int fr, int fq) const {
        const int row0 = u.pm * BM + wr * 64 + fr; const int col0 = u.pn * BM + wc * 32 + 8 * fq;
#pragma unroll
        for (int ai = 0; ai < 2; ++ai)
#pragma unroll
            for (int m = 0; m < 4; ++m) { bf16_t* rowp = O + (size_t)(row0 + ai * HALF + m * 16) * ldc + col0;
#pragma unroll
                for (int bj = 0; bj < 2; ++bj) { const f32x4 v0 = acc[ai][bj][m][0], v1 = acc[ai][bj][m][1];
                    u32x4 w; w.x = cvt_pk_bf16(v0[0], v0[1]); w.y = cvt_pk_bf16(v0[2], v0[3]); w.z = cvt_pk_bf16(v1[0], v1[1]); w.w = cvt_pk_bf16(v1[2], v1[3]);
                    *(u32x4*)(rowp + bj * HALF) = w; } }
    }
};
typedef unsigned u32x2 __attribute__((ext_vector_type(2)));
template <bool RES_BF16, bool OUT_BF16> struct EpiResT {
    static constexpr bool PERM = false, AFTER_DRAIN = false;
    const void* res; void* out; const float* gate_base;
    __device__ __forceinline__ void operator()(const f32x4 (&acc)[2][2][4][2], const Unit& u, int wr, int wc, int fr, int fq) const {
        const int seg = u.pm >> 4, lrow0 = u.pm * BM + wr * 64 + fr, col0 = u.pn * BM + wc * 32 + 4 * fq;
        const float* gate = gate_base + (size_t)seg * 12288;
        f32x4 gv[2][2];
#pragma unroll
        for (int bj = 0; bj < 2; ++bj)
#pragma unroll
            for (int n = 0; n < 2; ++n) gv[bj][n] = *(const f32x4*)(gate + col0 + bj * HALF + n * 16);
#pragma unroll
        for (int ai = 0; ai < 2; ++ai)
#pragma unroll
            for (int m = 0; m < 4; ++m) { const size_t off = (size_t)(lrow0 + ai * HALF + m * 16) * 4096 + col0;
#pragma unroll
                for (int bj = 0; bj < 2; ++bj)
#pragma unroll
                    for (int n = 0; n < 2; ++n) { const size_t o = off + bj * HALF + n * 16; f32x4 r;
                        if constexpr (RES_BF16) { const u32x2 w = *(const u32x2*)((const bf16_t*)res + o);
                            r = (f32x4){__uint_as_float(w.x << 16), __uint_as_float(w.x & 0xffff0000u), __uint_as_float(w.y << 16), __uint_as_float(w.y & 0xffff0000u)}; }
                        else r = *(const f32x4*)((const float*)res + o);
                        const f32x4 v = r + gv[bj][n] * acc[ai][bj][m][n];
                        if constexpr (OUT_BF16) { u32x2 w; w.x = cvt_pk_bf16(v[0], v[1]); w.y = cvt_pk_bf16(v[2], v[3]); *(u32x2*)((bf16_t*)out + o) = w; }
                        else *(f32x4*)((float*)out + o) = v; }
                asm volatile("" ::: "memory"); }
    }
};

struct EpiBf16Rope {
    static constexpr bool PERM = true, AFTER_DRAIN = false;
    bf16_t* O; int ldc; const float* cs; const float* sn;
    __device__ __forceinline__ void operator()(const f32x4 (&acc)[2][2][4][2], const Unit& u, int wr, int wc, int fr, int fq) const {
        const int row0 = u.pm * BM + wr * 64 + fr; const int col0 = u.pn * BM + wc * 32 + 8 * fq;
        const bool rope = u.pn < 32, lat = u.pm < 64; const float ksc = (u.pn >= 16 && u.pn < 32) ? 0.0625f : 1.0f;
#pragma unroll
        for (int ai = 0; ai < 2; ++ai)
#pragma unroll
            for (int m = 0; m < 4; ++m) { const int row = row0 + ai * HALF + m * 16; bf16_t* rowp = O + (size_t)row * ldc + col0;
                f32x4 a0 = acc[ai][0][m][0], a1 = acc[ai][0][m][1], b0 = acc[ai][1][m][0], b1 = acc[ai][1][m][1];
                if (rope) {
                    if (lat) { const size_t to = (size_t)(row & 4095) * 128 + wc * 32 + 8 * fq;
                        const f32x4 c0 = *(const f32x4*)(cs + to), c1 = *(const f32x4*)(cs + to + 4), s0 = *(const f32x4*)(sn + to), s1 = *(const f32x4*)(sn + to + 4);
                        const f32x4 x0 = a0 * c0 - b0 * s0, x1 = a1 * c1 - b1 * s1, y0 = a0 * s0 + b0 * c0, y1 = a1 * s1 + b1 * c1; a0 = x0; a1 = x1; b0 = y0; b1 = y1; }
                    a0 = a0 * ksc; a1 = a1 * ksc; b0 = b0 * ksc; b1 = b1 * ksc; }
                u32x4 w; w.x = cvt_pk_bf16(a0[0], a0[1]); w.y = cvt_pk_bf16(a0[2], a0[3]); w.z = cvt_pk_bf16(a1[0], a1[1]); w.w = cvt_pk_bf16(a1[2], a1[3]); *(u32x4*)(rowp) = w;
                u32x4 v; v.x = cvt_pk_bf16(b0[0], b0[1]); v.y = cvt_pk_bf16(b0[2], b0[3]); v.z = cvt_pk_bf16(b1[0], b1[1]); v.w = cvt_pk_bf16(b1[2], b1[3]); *(u32x4*)(rowp + HALF) = v; }
    }
};

struct LastOddOrder {
    StaticOrder lat; int G, c, nlat;
    __host__ __device__ void init(int G_, int c_) { lat.init(16384, 24576, G_, c_); G = G_; c = c_; nlat = 64 * 96; }
    __host__ __device__ bool next(int i, Unit& u) const {
        const long L = (long)i * G + c; if (L < nlat) return lat.next(i, u);
        const int r = (int)(L - nlat); if (r >= 4 * 48) return false;
        u.pm = 64 + (r & 3); u.pn = 16 + (r >> 2); return true;
    }
    __device__ __forceinline__ void a_ready(const Unit&) const {}
    __device__ __forceinline__ void done(const Unit&) const {}
    __device__ __forceinline__ size_t aoff(const Unit& u, size_t tstep) const { return (size_t)u.pm * tstep; }
    __device__ __forceinline__ size_t boff(const Unit& u, size_t tstep) const { return (size_t)u.pn * tstep; }
};
struct EvenInOrder {
    StaticOrder lat; int G, c;
    __host__ __device__ void init(int G_, int c_) { lat.init(16384, 14592, G_, c_); G = G_; c = c_; }
    __host__ __device__ bool next(int i, Unit& u) const {
        const long L = (long)i * G + c; if (L < 64 * 57) return lat.next(i, u);
        const int r = (int)(L - 64 * 57); if (r >= 4 * 48) return false;
        u.pm = 64 + (r & 3); u.pn = r >> 2; return true;
    }
    __device__ __forceinline__ void a_ready(const Unit&) const {}
    __device__ __forceinline__ void done(const Unit&) const {}
    __device__ __forceinline__ size_t aoff(const Unit& u, size_t tstep) const { return (size_t)u.pm * tstep; }
    __device__ __forceinline__ size_t boff(const Unit& u, size_t tstep) const { return (size_t)u.pn * tstep; }
};
struct UkvOrder {
    StaticOrder base; int G, c;
    __host__ __device__ void init(int M, int N, int G_, int c_) { base.init(M, N, G_, c_); G = G_; c = c_; }
    __host__ __device__ bool next(int i, Unit& u) const {
        if (G != 256 || base.nwg != 1088) return base.next(i, u);
        long L;
        if (i < 3) L = (long)i * 256 + c;
        else if (i == 3) { if (c < 48) return false; L = 768 + (c - 48); }
        else if (i == 4) { if (c < 48 || c >= 160) return false; L = 976 + (c - 48); }
        else return false;
        return base.tile(L, u);
    }
    __device__ __forceinline__ void a_ready(const Unit&) const {}
    __device__ __forceinline__ void done(const Unit&) const {}
    __device__ __forceinline__ size_t aoff(const Unit& u, size_t tstep) const { return (size_t)u.pm * tstep; }
    __device__ __forceinline__ size_t boff(const Unit& u, size_t tstep) const { return (size_t)u.pn * tstep; }
};
struct OddInOrder {
    StaticOrder lat; int G, c;
    __host__ __device__ void init(int G_, int c_) { lat.init(16384, 24576, G_, c_); G = G_; c = c_; }
    __host__ __device__ bool next(int i, Unit& u) const {
        const long L = (long)i * G + c; if (L < 64 * 96) return lat.next(i, u);
        const int r = (int)(L - 64 * 96); if (r >= 4 * 64) return false;
        u.pm = 64 + (r & 3); u.pn = r >> 2; return true;
    }
    __device__ __forceinline__ void a_ready(const Unit&) const {}
    __device__ __forceinline__ void done(const Unit&) const {}
    __device__ __forceinline__ size_t aoff(const Unit& u, size_t tstep) const { return (size_t)u.pm * tstep; }
    __device__ __forceinline__ size_t boff(const Unit& u, size_t tstep) const { return (size_t)u.pn * tstep; }
};
struct CtxSplitOrder {
    int G, c, kq_bytes, n, ns;
    __host__ __device__ void init(int G_, int c_, int K, int n_ = 256, int ns_ = 4) { G = G_; c = c_; kq_bytes = (K / ns_) * 2; n = n_; ns = ns_; }
    __host__ __device__ bool next(int i, Unit& u) const { const long L = (long)i * G + c; if (L >= n) return false; const int r = (int)L, t = r / ns; u.kq = r - t * ns; u.pm = t & 3; u.pn = t >> 2; return true; }
    __device__ __forceinline__ void a_ready(const Unit&) const {}
    __device__ __forceinline__ void done(const Unit&) const {}
    __device__ __forceinline__ size_t aoff(const Unit& u, size_t tstep) const { return (size_t)u.pm * tstep + (size_t)u.kq * kq_bytes; }
    __device__ __forceinline__ size_t boff(const Unit& u, size_t tstep) const { return (size_t)u.pn * tstep + (size_t)u.kq * kq_bytes; }
};
struct EpiPart {
    static constexpr bool PERM = false, AFTER_DRAIN = false;
    float* part; int pitch;
    __device__ __forceinline__ void operator()(const f32x4 (&acc)[2][2][4][2], const Unit& u, int wr, int wc, int fr, int fq) const {
        float* o = part + ((size_t)u.kq * 1024 + (size_t)u.pm * BM + wr * 64 + fr) * pitch + u.pn * BM + wc * 32 + 4 * fq;
#pragma unroll
        for (int ai = 0; ai < 2; ++ai)
#pragma unroll
            for (int m = 0; m < 4; ++m)
#pragma unroll
                for (int bj = 0; bj < 2; ++bj)
#pragma unroll
                    for (int n = 0; n < 2; ++n) *(f32x4*)(o + (size_t)(ai * HALF + m * 16) * pitch + bj * HALF + n * 16) = acc[ai][bj][m][n];
    }
};

template <class Epi, class Sched, bool ALIGN_EPI = false, bool SP2 = false>
__device__ __forceinline__ void gemm_phase(PG8_LAS unsigned char* lds, const Gemm g, const Sched& S, const Epi& E) {
    int tid = threadIdx.x; asm volatile("" : "+v"(tid));
    const int wid = __builtin_amdgcn_readfirstlane(tid >> 6), lane = tid & 63, wr = wid >> 2, wc = wid & 3, fr = lane & 15, fq = lane >> 4;
    const int K = g.ld ? g.ld : g.K, nt = g.K / BK;
    unsigned voffA[2], voffB[2];
#pragma unroll
    for (int i = 0; i < 2; ++i) { int R, C; stage_rc(tid * 16 + i * 8192, R, C); const int Rb = Epi::PERM ? ((R & ~31) + perm32(R & 31)) : R;
        voffA[i] = (unsigned)(R * K + C) * 2u; voffB[i] = (unsigned)(Rb * K + C) * 2u; }
    const size_t kstep = (size_t)(BK * 2);
    const size_t hstep = (size_t)HALF * K * 2;
    const size_t tstep = 2 * hstep;
    const unsigned ldsw = (unsigned)wid * 1024u;
    const int aoff = lds_byte(wr * 64 + fr, fq * 8), boff = lds_byte(wc * 32 + fr, fq * 8);
#define PG8_SA(b, h) (((b) * 2 + (h)) * HTB)
#define PG8_SB(b, h) ((4 + (b) * 2 + (h)) * HTB)
#define PG8_STAGE(bufoff, gbase, voff) do { _Pragma("unroll") for (int _i = 0; _i < 2; ++_i) \
        __builtin_amdgcn_global_load_lds((const unsigned*)((const char*)(gbase) + (voff)[_i]), (PG8_LAS unsigned*)(lds + (bufoff) + ldsw + _i * 8192), 16, 0, 0); } while (0)
#define PG8_LDA(dst, b, h) do { _Pragma("unroll") for (int m = 0; m < 4; ++m) _Pragma("unroll") for (int k = 0; k < 2; ++k) dst[m][k] = *(const PG8_LAS bf16x8*)(lds + PG8_SA(b, h) + aoff + m * 2048 + k * 1024); } while (0)
#define PG8_LDB(dst, b, h) do { _Pragma("unroll") for (int n = 0; n < 2; ++n) _Pragma("unroll") for (int k = 0; k < 2; ++k) dst[n][k] = *(const PG8_LAS bf16x8*)(lds + PG8_SB(b, h) + boff + n * 2048 + k * 1024); } while (0)
#define PG8_MMA(ai, bj, At, Bt) do { __builtin_amdgcn_s_setprio(1); _Pragma("unroll") for (int m = 0; m < 4; ++m) _Pragma("unroll") for (int n = 0; n < 2; ++n) _Pragma("unroll") for (int k = 0; k < 2; ++k) \
        acc[ai][bj][m][n] = __builtin_amdgcn_mfma_f32_16x16x32_bf16(Bt[n][k], At[m][k], acc[ai][bj][m][n], 0, 0, 0); __builtin_amdgcn_s_setprio(0); } while (0)
#define PG8_WAIT_V(n) asm volatile("s_waitcnt vmcnt(" #n ")" ::: "memory")
#define PG8_WAIT_L(n) asm volatile("s_waitcnt lgkmcnt(" #n ")" ::: "memory")
#define PG8_BAR __builtin_amdgcn_s_barrier()
#define PG8_SCHED __builtin_amdgcn_sched_barrier(0)
    Unit cur, nxt; int ui = 0;
    if (!S.next(0, cur)) return;
    f32x4 acc[2][2][4][2];
#pragma unroll
    for (int a = 0; a < 2; ++a)
#pragma unroll
        for (int b = 0; b < 2; ++b)
#pragma unroll
            for (int m = 0; m < 4; ++m)
#pragma unroll
                for (int n = 0; n < 2; ++n) acc[a][b][m][n] = (f32x4){0.f, 0.f, 0.f, 0.f};
    bf16x8 At[4][2], B0[2][2], B1[2][2];
    const char* cA = (const char*)g.A + S.aoff(cur, tstep); const char* cB = (const char*)g.Bt + S.boff(cur, tstep);
    S.a_ready(cur);
    if constexpr (SP2) {
        PG8_STAGE(PG8_SB(0, 0), cB, voffB); PG8_STAGE(PG8_SB(0, 1), cB + hstep, voffB); PG8_STAGE(PG8_SA(0, 0), cA, voffA); PG8_STAGE(PG8_SA(0, 1), cA + hstep, voffA);
        if (wr == 1) PG8_BAR;
        PG8_WAIT_V(2); PG8_BAR;
        PG8_STAGE(PG8_SB(1, 0), cB + kstep, voffB); PG8_STAGE(PG8_SA(1, 0), cA + kstep, voffA); PG8_STAGE(PG8_SB(1, 1), cB + hstep + kstep, voffB);
        PG8_WAIT_V(6); PG8_BAR;
    } else {
        PG8_STAGE(PG8_SB(0, 0), cB, voffB); PG8_STAGE(PG8_SA(0, 0), cA, voffA); PG8_STAGE(PG8_SB(0, 1), cB + hstep, voffB); PG8_STAGE(PG8_SA(0, 1), cA + hstep, voffA);
        if (wr == 1) PG8_BAR;
        PG8_WAIT_V(4); PG8_BAR;
        PG8_STAGE(PG8_SB(1, 0), cB + kstep, voffB); PG8_STAGE(PG8_SA(1, 0), cA + kstep, voffA); PG8_STAGE(PG8_SB(1, 1), cB + hstep + kstep, voffB);
        PG8_WAIT_V(6); PG8_BAR;
    }
    for (;;) {
        const bool has_next = S.next(ui + 1, nxt);
        const char* nA = has_next ? (const char*)g.A + S.aoff(nxt, tstep) : cA; const char* nB = has_next ? (const char*)g.Bt + S.boff(nxt, tstep) : cB;
        for (int t = 0; t < nt; t += 2) {
            const bool last = (t == nt - 2);
            const char* a1 = cA + (size_t)(t + 1) * kstep;
            const char* a2 = last ? nA : cA + (size_t)(t + 2) * kstep; const char* b2 = last ? nB : cB + (size_t)(t + 2) * kstep;
            const char* a3 = a2 + kstep; const char* b3 = b2 + kstep;
            if (last && has_next) S.a_ready(nxt);
            if constexpr (SP2) {
            PG8_LDB(B0, 0, 0); PG8_LDB(B1, 0, 1); PG8_SCHED; PG8_LDA(At, 0, 0); PG8_STAGE(PG8_SA(1, 1), a1 + hstep, voffA);
            PG8_WAIT_V(8); PG8_WAIT_L(0); PG8_BAR; PG8_MMA(0, 0, At, B0); PG8_MMA(0, 1, At, B1); PG8_BAR; PG8_SCHED;
            PG8_LDA(At, 0, 1); PG8_STAGE(PG8_SB(0, 0), b2, voffB); PG8_STAGE(PG8_SB(0, 1), b2 + hstep, voffB); PG8_STAGE(PG8_SA(0, 0), a2, voffA);
            PG8_WAIT_V(8); PG8_WAIT_L(0); PG8_BAR; PG8_MMA(1, 0, At, B0); PG8_MMA(1, 1, At, B1); PG8_BAR; PG8_SCHED;
            PG8_LDB(B0, 1, 0); PG8_LDB(B1, 1, 1); PG8_SCHED; PG8_LDA(At, 1, 0); PG8_STAGE(PG8_SA(0, 1), a2 + hstep, voffA);
            PG8_WAIT_V(8); PG8_WAIT_L(0); PG8_BAR; PG8_MMA(0, 0, At, B0); PG8_MMA(0, 1, At, B1); PG8_BAR; PG8_SCHED;
            PG8_LDA(At, 1, 1); PG8_STAGE(PG8_SB(1, 0), b3, voffB); PG8_STAGE(PG8_SB(1, 1), b3 + hstep, voffB); PG8_STAGE(PG8_SA(1, 0), a3, voffA);
            PG8_WAIT_V(8); PG8_WAIT_L(0); PG8_BAR; PG8_MMA(1, 0, At, B0); PG8_MMA(1, 1, At, B1); PG8_BAR; PG8_SCHED;
            } else {
            PG8_LDB(B0, 0, 0); PG8_SCHED; PG8_LDA(At, 0, 0); PG8_STAGE(PG8_SA(1, 1), a1 + hstep, voffA);
            PG8_WAIT_L(8); PG8_BAR; PG8_WAIT_L(0); PG8_MMA(0, 0, At, B0); PG8_BAR; PG8_SCHED;
            PG8_LDB(B1, 0, 1); PG8_STAGE(PG8_SB(0, 0), b2, voffB);
            PG8_BAR; PG8_WAIT_L(0); PG8_MMA(0, 1, At, B1); PG8_BAR;
            PG8_LDA(At, 0, 1); PG8_STAGE(PG8_SA(0, 0), a2, voffA);
            PG8_BAR; PG8_WAIT_L(0); PG8_MMA(1, 0, At, B0); PG8_BAR; PG8_SCHED;
            PG8_STAGE(PG8_SB(0, 1), b2 + hstep, voffB);
            PG8_WAIT_V(6); PG8_BAR; PG8_MMA(1, 1, At, B1); PG8_BAR;
            PG8_LDB(B0, 1, 0); PG8_SCHED; PG8_LDA(At, 1, 0); PG8_STAGE(PG8_SA(0, 1), a2 + hstep, voffA);
            PG8_WAIT_L(8); PG8_BAR; PG8_WAIT_L(0); PG8_MMA(0, 0, At, B0); PG8_BAR; PG8_SCHED;
            PG8_LDB(B1, 1, 1); PG8_STAGE(PG8_SB(1, 0), b3, voffB);
            PG8_BAR; PG8_WAIT_L(0); PG8_MMA(0, 1, At, B1); PG8_BAR;
            PG8_LDA(At, 1, 1); PG8_STAGE(PG8_SA(1, 0), a3, voffA);
            PG8_BAR; PG8_WAIT_L(0); PG8_MMA(1, 0, At, B0); PG8_BAR; PG8_SCHED;
            PG8_STAGE(PG8_SB(1, 1), b3 + hstep, voffB);
            PG8_WAIT_V(6); PG8_BAR; PG8_MMA(1, 1, At, B1); PG8_BAR;
            }
        }
        if constexpr (ALIGN_EPI) { if (wr == 0) PG8_BAR; }
        if constexpr (!Epi::AFTER_DRAIN) { E(acc, cur, wr, wc, fr, fq); S.done(cur); }
        if (!has_next) break;
#pragma unroll
        for (int a = 0; a < 2; ++a)
#pragma unroll
            for (int b = 0; b < 2; ++b)
#pragma unroll
                for (int m = 0; m < 4; ++m)
#pragma unroll
                    for (int n = 0; n < 2; ++n) acc[a][b][m][n] = (f32x4){0.f, 0.f, 0.f, 0.f};
        cur = nxt; cA = nA; cB = nB; ++ui;
        if constexpr (ALIGN_EPI) { if (wr == 1) PG8_BAR; }
    }
    PG8_WAIT_V(0);
    if constexpr (!ALIGN_EPI) { if (wr == 0) PG8_BAR; }
    PG8_BAR;
    if constexpr (Epi::AFTER_DRAIN) { E.fused(acc, cur, wr, wc, fr, fq, lds, wid, lane); S.done(cur); }
#undef PG8_SA
#undef PG8_SB
#undef PG8_STAGE
#undef PG8_LDA
#undef PG8_LDB
#undef PG8_MMA
#undef PG8_WAIT_V
#undef PG8_WAIT_L
#undef PG8_BAR
#undef PG8_SCHED
}
}
#ifndef PG8_SP2
#define PG8_SP2 true
#endif
#ifndef PG8_ALIGN
#define PG8_ALIGN true
#endif
constexpr int NWAVES = 8;
constexpr int DM = 4096, NB = 4, SEQ = 4096, CTXL = 256, DEPTH = 4;
constexpr int M_LAT = NB * SEQ, M_CTX = NB * CTXL, MT = M_LAT + M_CTX;
constexpr int HEADS = 16, QKD = 192, NOPE = 128, ROPED = 64, VDIM = 128, Q_LORA = 1536, KV_LORA = 512;
constexpr int E_CQ = 0, E_CKV = 1536, E_KPE = 2048, E_GM = 2112, E_QH = 4160, E_FF = 6208, E_FB = 8256, E_IH = 10304, E_GH = 12352, E_END = 14400, E_PAD = 14592;
constexpr int O_Q = 0, O_K = 4096, O_V = 8192, O_G = 16384, O_END = 24576;
constexpr int NQ = HEADS * QKD, NKV = HEADS * 256;
constexpr float EPS = 1e-6f;
constexpr int MODW = 3 * DM;
constexpr int KCH = 32;
constexpr size_t al256(size_t x) { return (x + 255) / 256 * 256; }
constexpr size_t WS_CTL = 0, CTL_ZERO_BYTES = 1u << 20;
constexpr size_t WS_MODP = CTL_ZERO_BYTES;
constexpr size_t WS_MOD  = WS_MODP + al256((size_t)KCH * 4 * 5 * MODW * 4);
constexpr size_t WS_LB   = WS_MOD + al256((size_t)4 * 5 * MODW * 4);
constexpr size_t WS_WINE = WS_LB + al256((size_t)2 * 2 * 2048 * 4);
constexpr size_t WS_WUQ  = WS_WINE + (size_t)2 * E_PAD * DM * 2;
constexpr size_t WS_WUKV = WS_WUQ + (size_t)2 * NQ * Q_LORA * 2;
constexpr size_t WS_WOE  = WS_WUKV + (size_t)2 * NKV * KV_LORA * 2;
constexpr size_t WS_WINO = WS_WOE + (size_t)2 * DM * DM * 2;
constexpr size_t WS_WOO  = WS_WINO + (size_t)2 * O_END * DM * 2;
constexpr size_t WS_XS   = WS_WOO + (size_t)2 * DM * 8192 * 2;
constexpr size_t WS_H    = WS_XS + (size_t)MT * DM * 4;
constexpr size_t WS_P    = WS_H + (size_t)MT * DM * 2;
constexpr size_t WS_U    = WS_P + (size_t)MT * O_END * 2;
constexpr size_t WS_CQN  = WS_U;
constexpr size_t WS_CKVN = WS_CQN + (size_t)MT * Q_LORA * 2;
constexpr size_t WS_QF   = WS_CKVN + (size_t)MT * KV_LORA * 2;
constexpr size_t WS_KV   = WS_QF + (size_t)MT * NQ * 2;
constexpr size_t WS_KF   = WS_KV + (size_t)MT * NKV * 2;
constexpr size_t WS_OFE  = WS_KF + (size_t)MT * NQ * 2;
constexpr size_t WS_OBE  = WS_OFE + (size_t)MT * 2048 * 2;
constexpr size_t WS_UE_END = WS_OBE + (size_t)MT * 2048 * 2;
constexpr size_t WS_OFO  = WS_U;
constexpr size_t WS_OBO  = WS_OFO + (size_t)MT * 8192 * 2;
constexpr size_t WS_UO_END = WS_OBO + (size_t)MT * 8192 * 2;
constexpr size_t WS_A    = WS_UE_END > WS_UO_END ? WS_UE_END : WS_UO_END;
constexpr size_t WS_END  = WS_A + (size_t)MT * 8192 * 2;
constexpr int CW_BAR = 4096, CW_QUEUE = 8192;
constexpr int CW_BAR_ = 0;
constexpr int LDS_BYTES = 163840 - 1024;
constexpr int MISC_OFF = LDS_BYTES - 256;
#define LAS __attribute__((address_space(3)))
typedef unsigned short bf16;
typedef unsigned v4u __attribute__((ext_vector_type(4)));
typedef unsigned v2u __attribute__((ext_vector_type(2)));
typedef float f32x4 __attribute__((ext_vector_type(4)));
typedef float f32x16 __attribute__((ext_vector_type(16)));
typedef short bf16x8 __attribute__((ext_vector_type(8)));
typedef short s16x4 __attribute__((ext_vector_type(4)));
#define DI __device__ __forceinline__
typedef __bf16 bf2_t __attribute__((ext_vector_type(2)));
typedef float f32x2_t __attribute__((ext_vector_type(2)));
DI unsigned pk2(float lo, float hi) { const f32x2_t v = {lo, hi}; return __builtin_bit_cast(unsigned, __builtin_convertvector(v, bf2_t)); }
DI unsigned f2bf(float f) { return (unsigned)__builtin_bit_cast(unsigned short, (__bf16)f); }
DI float bflo(unsigned w) { return __uint_as_float(w << 16); }
DI float bfhi(unsigned w) { return __uint_as_float(w & 0xffff0000u); }
DI float bf2f(bf16 v) { return __uint_as_float(((unsigned)v) << 16); }
DI float bperm(int srclane, float v) { return __int_as_float(__builtin_amdgcn_ds_bpermute(srclane << 2, __float_as_int(v))); }
DI float wave_sum(float v, int lane) {
#pragma unroll
    for (int o = 1; o < 64; o <<= 1) v += bperm(lane ^ o, v);
    return v;
}
DI float siluf(float x) { return x / (1.0f + __expf(-x)); }
#define MFMA16(a, b, c) __builtin_amdgcn_mfma_f32_16x16x32_bf16((a), (b), (c), 0, 0, 0)
#define MFMA32(a, b, c) __builtin_amdgcn_mfma_f32_32x32x16_bf16((a), (b), (c), 0, 0, 0)
DI int crow(int r, int hi) { return (r & 3) + 8 * (r >> 2) + 4 * hi; }
DI unsigned img_off(unsigned row, unsigned ch) { return 256u * row + 16u * (ch ^ (((row & 3u) << 2) | ((row >> 2) & 3u))); }
DI unsigned tr32_addr(unsigned lane, unsigned k0, unsigned c, unsigned t) {
    const unsigned h = lane >> 5, blk = (lane >> 4) & 1u, q = (lane & 15u) >> 2, p = lane & 3u;
    return img_off(k0 + 8 * h + 4 * t + q, 4 * c + 2 * blk + (p >> 1)) + 8 * (p & 1u);
}
DI unsigned tr16_addr(unsigned lane, unsigned k0, unsigned c, unsigned t) {
    const unsigned g = lane >> 4, q = (lane & 15u) >> 2, p = lane & 3u;
    return img_off(k0 + 8 * g + 4 * t + q, 2 * c + (p >> 1)) + 8 * (p & 1u);
}
DI s16x4 tr_issue(unsigned lds_addr) { s16x4 r; asm volatile("ds_read_b64_tr_b16 %0, %1" : "=&v"(r) : "v"(lds_addr) : "memory"); return r; }
#define LDS_WAIT_PIN() do { asm volatile("s_waitcnt lgkmcnt(0)" ::: "memory"); __builtin_amdgcn_sched_barrier(0); } while (0)
#define CAT8(L, H) (bf16x8){L[0], L[1], L[2], L[3], H[0], H[1], H[2], H[3]}
DI unsigned cvtpk(float lo, float hi) { unsigned r; asm volatile("v_cvt_pk_bf16_f32 %0, %1, %2" : "=v"(r) : "v"(lo), "v"(hi)); return r; }

constexpr size_t WS_COS = WS_END, WS_SIN = WS_COS + (size_t)SEQ * 128 * 4, WS_END2 = WS_SIN + (size_t)SEQ * 128 * 4;
constexpr size_t WS_PART = WS_END2, WS_END3 = WS_PART + (size_t)4 * M_CTX * DM * 4;
constexpr size_t WS_SILU = WS_END3, WS_END4 = WS_SILU + (size_t)5 * DM * 4;
static_assert(WS_END4 <= (size_t)3221225472ull, "workspace map must fit 4 x the largest tensor (3 GiB)");
#define XB_TMO      128
#define XB_XCNT(j)  (256  + 64 * (j))
#define XB_XSUB(j)  (1280 + 64 * (j))
#define XB_XGEN(j)  (2304 + 64 * (j))
#define XB_TOP      3328
#define XB_TOPGEN   3392
#define XCD_BAR_WORDS 3456
#define XB_SPIN_CAP (1u << 18)

__device__ __forceinline__ unsigned xb_ld(unsigned* p)              { return __hip_atomic_load(p, __ATOMIC_RELAXED, __HIP_MEMORY_SCOPE_AGENT); }
__device__ __forceinline__ unsigned xb_add(unsigned* p, unsigned v) { return __hip_atomic_fetch_add(p, v, __ATOMIC_RELAXED, __HIP_MEMORY_SCOPE_AGENT); }
__device__ __forceinline__ unsigned xb_xcc_id() { return (unsigned)__builtin_amdgcn_s_getreg((3 << 11) | 20) & 0xFu; }
#define XB_SPIN(cond, bar) do { unsigned _sp = 0; while (cond) { __builtin_amdgcn_s_sleep(1); \
    if ((++_sp & 255u) == 0u) { if (xb_ld(&(bar)[XB_TMO])) break; if (_sp > XB_SPIN_CAP) { atomicAdd(&(bar)[XB_TMO], 1u); break; } } } } while (0)

struct XcdBarrier {
    unsigned* bar; unsigned x;
    volatile LAS unsigned* st;
};

__device__ __forceinline__ XcdBarrier xcd_barrier_post(unsigned* bar, volatile LAS unsigned* st) {
    XcdBarrier b; b.bar = bar; b.x = xb_xcc_id(); b.st = st;
    if (threadIdx.x == 0) (void)xb_add(&bar[XB_XCNT(b.x)], 1u);
    return b;
}
__device__ __forceinline__ void xcd_barrier_complete(unsigned* bar, unsigned x, unsigned& nloc, unsigned& nx) {
    const unsigned G = gridDim.x * gridDim.y * gridDim.z;
    unsigned sum, cnt, mine, sp = 0u;
    for (;;) {
        sum = 0u; cnt = 0u; mine = 0u;
#pragma unroll
        for (unsigned j = 0; j < 16; ++j) { const unsigned c = xb_ld(&bar[XB_XCNT(j)]); sum += c; cnt += (c > 0u) ? 1u : 0u; mine = (j == x) ? c : mine; }
        if (sum == G) break;
        __builtin_amdgcn_s_sleep(1);
        if ((++sp & 255u) == 0u) { if (xb_ld(&bar[XB_TMO])) break; if (sp > XB_SPIN_CAP) { atomicAdd(&bar[XB_TMO], 1u); break; } }
    }
    nloc = mine > 0u ? mine : 1u; nx = cnt > 0u ? cnt : 1u;
}

__device__ __forceinline__ void xcd_barrier(const XcdBarrier& b) {
    asm volatile("s_waitcnt vmcnt(0)" ::: "memory");
    __syncthreads();
    if (threadIdx.x == 0) {
        unsigned* bar = b.bar;
        __builtin_amdgcn_s_waitcnt(0);
        unsigned nloc = b.st[0], nx = b.st[1];
        if (nloc == 0u) { xcd_barrier_complete(bar, b.x, nloc, nx); b.st[0] = nloc; b.st[1] = nx; }
        const unsigned old = xb_add(&bar[XB_XSUB(b.x)], 1u);
        const unsigned gen = old / nloc;
        if (old + 1u == (gen + 1u) * nloc) {
            __builtin_amdgcn_fence(__ATOMIC_RELEASE, "agent");
            asm volatile("s_waitcnt vmcnt(0)" ::: "memory");
            const unsigned og = xb_add(&bar[XB_TOP], 1u);
            const unsigned tg = og / nx;
            if (og + 1u == (tg + 1u) * nx) xb_add(&bar[XB_TOPGEN], 1u);
            else XB_SPIN(xb_ld(&bar[XB_TOPGEN]) == tg, bar);
            __builtin_amdgcn_fence(__ATOMIC_ACQUIRE, "agent");
            xb_add(&bar[XB_XGEN(b.x)], 1u);
            asm volatile("s_waitcnt vmcnt(0)" ::: "memory");
        } else {
            XB_SPIN(xb_ld(&bar[XB_XGEN(b.x)]) == gen, bar);
            __builtin_amdgcn_fence(__ATOMIC_ACQUIRE, "agent");
            asm volatile("s_waitcnt vmcnt(0)" ::: "memory");
        }
    }
    __syncthreads();
}
struct Frame {
    LAS unsigned char* lds;
    int tid, lane, wave, vcu, G;
    unsigned char* ws;
    const float *x, *c, *ctx, *c_ctx, *mod_w, *mod_b, *norm_gain, *even_w_in, *q_a_gain, *kv_a_gain, *w_uq, *w_ukv, *q_norm_gain, *k_norm_gain, *hg_lb, *hg_norm_gain, *even_w_out, *odd_w_in, *ret_decay, *odd_w_out;
    float* out;
};
#define WSP(T, off) ((T*)(F.ws + (off)))
DI const float* ld_ptr(const LAS unsigned* tbl, int k) { const unsigned lo = __builtin_amdgcn_readfirstlane(tbl[2 * k]), hi = __builtin_amdgcn_readfirstlane(tbl[2 * k + 1]); return (const float*)(uintptr_t)(((unsigned long long)hi << 32) | lo); }
#define LOADPTRS(F) do { const LAS unsigned* t_ = (const LAS unsigned*)((F).lds + MISC_OFF + 64); \
    (F).x = ld_ptr(t_, 0); (F).c = ld_ptr(t_, 1); (F).ctx = ld_ptr(t_, 2); (F).c_ctx = ld_ptr(t_, 3); (F).mod_w = ld_ptr(t_, 4); (F).mod_b = ld_ptr(t_, 5); (F).norm_gain = ld_ptr(t_, 6); (F).even_w_in = ld_ptr(t_, 7); \
    (F).q_a_gain = ld_ptr(t_, 8); (F).kv_a_gain = ld_ptr(t_, 9); (F).w_uq = ld_ptr(t_, 10); (F).w_ukv = ld_ptr(t_, 11); (F).q_norm_gain = ld_ptr(t_, 12); (F).k_norm_gain = ld_ptr(t_, 13); (F).hg_lb = ld_ptr(t_, 14); \
    (F).hg_norm_gain = ld_ptr(t_, 15); (F).even_w_out = ld_ptr(t_, 16); (F).odd_w_in = ld_ptr(t_, 17); (F).ret_decay = ld_ptr(t_, 18); (F).odd_w_out = ld_ptr(t_, 19); } while (0)

struct ConvDesc { const float* W; bf16* WT; int K, N, item; };
constexpr int I_WINE = (DM / 64) * (E_END / 32), I_WUQ = (Q_LORA / 64) * (NQ / 32), I_WUKV = (KV_LORA / 64) * (NKV / 32), I_WOE = (DM / 64) * (DM / 32),
              I_WINO = (DM / 64) * (O_END / 32), I_WOO = (8192 / 64) * (DM / 32), I_EVEN = I_WINE + I_WUQ + I_WUKV + I_WOE, I_ODD = I_WINO + I_WOO;
constexpr int CONV_LIST_LEN[3] = {I_EVEN - I_WOE, I_WOE + I_ODD + I_EVEN, I_ODD};
DI ConvDesc conv_decode(Frame& F, int list, int g) {
    int i, odd, r;
    if (list == 0) { i = 0; odd = 0; r = g; } else if (list == 2) { i = 1; odd = 1; r = g; } else if (g < I_WOE) { i = 0; odd = 0; r = I_EVEN - I_WOE + g; } else if (g < I_WOE + I_ODD) { i = 0; odd = 1; r = g - I_WOE; } else { i = 1; odd = 0; r = g - I_WOE - I_ODD; }
    ConvDesc d;
    if (odd) {
        if (r < I_WINO) { d.W = F.odd_w_in + (size_t)i * DM * O_END; d.K = DM; d.N = O_END; d.WT = WSP(bf16, WS_WINO) + (size_t)i * O_END * DM; d.item = r; }
        else { d.W = F.odd_w_out + (size_t)i * 8192 * DM; d.K = 8192; d.N = DM; d.WT = WSP(bf16, WS_WOO) + (size_t)i * DM * 8192; d.item = r - I_WINO; }
    } else {
        if (r < I_WINE) { d.W = F.even_w_in + (size_t)i * DM * E_END; d.K = DM; d.N = E_END; d.WT = WSP(bf16, WS_WINE) + (size_t)i * E_PAD * DM; d.item = r; }
        else if (r < I_WINE + I_WUQ) { d.W = F.w_uq + (size_t)i * Q_LORA * NQ; d.K = Q_LORA; d.N = NQ; d.WT = WSP(bf16, WS_WUQ) + (size_t)i * NQ * Q_LORA; d.item = r - I_WINE; }
        else if (r < I_WINE + I_WUQ + I_WUKV) { d.W = F.w_ukv + (size_t)i * KV_LORA * NKV; d.K = KV_LORA; d.N = NKV; d.WT = WSP(bf16, WS_WUKV) + (size_t)i * NKV * KV_LORA; d.item = r - I_WINE - I_WUQ; }
        else { d.W = F.even_w_out + (size_t)i * DM * DM; d.K = DM; d.N = DM; d.WT = WSP(bf16, WS_WOE) + (size_t)i * DM * DM; d.item = r - I_WINE - I_WUQ - I_WUKV; }
    }
    return d;
}
DI void tp_load(const ConvDesc& d, int lane, f32x4 (&tv)[8]) {
    const int nblk = d.N / 32, kb = d.item / nblk, nb = d.item % nblk; const float* p = d.W + (size_t)(64 * kb + 8 * (lane >> 3)) * d.N + 32 * nb + 4 * (lane & 7);
#pragma unroll
    for (int e = 0; e < 8; ++e) tv[e] = *(const f32x4*)(p + (size_t)e * d.N);
}
DI void tp_store(const ConvDesc& d, const f32x4 (&tv)[8], int lane) {
    const int nblk = d.N / 32, kb = d.item / nblk, nb = d.item % nblk, k0 = 64 * kb + 8 * (lane >> 3), n0 = 32 * nb + 4 * (lane & 7);
#pragma unroll
    for (int j = 0; j < 4; ++j) { v4u o; o.x = pk2(tv[0][j], tv[1][j]); o.y = pk2(tv[2][j], tv[3][j]); o.z = pk2(tv[4][j], tv[5][j]); o.w = pk2(tv[6][j], tv[7][j]);
        *(v4u*)(d.WT + (size_t)(n0 + j) * d.K + k0) = o; }
}
DI void conv_items(Frame& F, int list, int start, int end, int stride) {
    for (int it = start; it < end; it += 4 * stride) {
        const bool h1 = it + stride < end, h2 = it + 2 * stride < end, h3 = it + 3 * stride < end;
        f32x4 t0[8], t1[8], t2[8], t3[8];
        const ConvDesc d0 = conv_decode(F, list, it); ConvDesc d1 = d0, d2 = d0, d3 = d0;
        tp_load(d0, F.lane, t0);
        if (h1) { d1 = conv_decode(F, list, it + stride); tp_load(d1, F.lane, t1); }
        if (h2) { d2 = conv_decode(F, list, it + 2 * stride); tp_load(d2, F.lane, t2); }
        if (h3) { d3 = conv_decode(F, list, it + 3 * stride); tp_load(d3, F.lane, t3); }
        tp_store(d0, t0, F.lane);
        if (h1) tp_store(d1, t1, F.lane);
        if (h2) tp_store(d2, t2, F.lane);
        if (h3) tp_store(d3, t3, F.lane);
    }
}
DI void ph_prologue(Frame& F) {
    const int gw = F.vcu * NWAVES + F.wave, NGW = F.G * NWAVES;
    conv_items(F, 0, gw, CONV_LIST_LEN[0], NGW);
    { const size_t n16 = (size_t)(E_PAD - E_END) * DM * 2 / 16;
      for (size_t j = (size_t)blockIdx.x * 512 + F.tid; j < 2 * n16; j += (size_t)F.G * 512) { const size_t i = j / n16, o = j % n16;
          *((v4u*)(WSP(bf16, WS_WINE) + (i * E_PAD + E_END) * DM) + o) = (v4u){0u, 0u, 0u, 0u}; } }
    { float* cs = WSP(float, WS_COS); float* sn = WSP(float, WS_SIN);
      for (int j = blockIdx.x * 512 + F.tid; j < SEQ * 128; j += F.G * 512) { const int pos = j >> 7, i = j & 127; const float inv = 1.0f / powf(10000.0f, (float)i * (1.0f / 127.0f));
          float sv, cv; sincosf((float)pos * inv, &sv, &cv); cs[j] = cv; sn[j] = sv; } }
    __syncthreads();
    LAS float* tab = (LAS float*)F.lds;
    for (int j = F.tid; j < 5 * DM; j += 512) { const int r = j >> 12, k = j & 4095; const float v = r < 4 ? F.c[r * DM + k] : F.c_ctx[k]; const float sv = v / (1.0f + __expf(-v)); tab[j] = sv;
        if (F.vcu == 0) WSP(float, WS_SILU)[j] = sv; }
    __syncthreads();
    constexpr int NT = MODW / 256, KC = DM / KCH;
    float* modp = WSP(float, WS_MODP);
    for (int it = gw; it < NT * KCH; it += NGW) {
        const int kc = it % KCH, nt = (it / KCH) % NT, l = 0;
        const float* W = F.mod_w + ((size_t)l * DM + (size_t)kc * KC) * MODW + nt * 256 + F.lane * 4;
        f32x4 acc[5];
#pragma unroll
        for (int r = 0; r < 5; ++r) acc[r] = (f32x4){0.f, 0.f, 0.f, 0.f};
#pragma unroll 8
        for (int k = 0; k < KC; ++k) { const f32x4 w = *(const f32x4*)(W + (size_t)k * MODW);
#pragma unroll
            for (int r = 0; r < 5; ++r) { const float s = tab[r * DM + kc * KC + k]; acc[r] += w * s; } }
#pragma unroll
        for (int r = 0; r < 5; ++r) *(f32x4*)(modp + ((size_t)(kc * 4 + l) * 5 + r) * MODW + nt * 256 + F.lane * 4) = acc[r];
    }
}
DI void adaln_batch(Frame& F, int bidx) {
    constexpr int NT = MODW / 256, KC = DM / KCH;
    const int l = 1 + bidx / (KCH * (NT / 8)), rem = bidx % (KCH * (NT / 8)), kc = rem / (NT / 8), nt = (rem % (NT / 8)) * 8 + F.wave;
    LAS float* tab = (LAS float*)(F.lds + 131072); const float* sg = WSP(float, WS_SILU);
    for (int j = F.tid; j < 5 * KC; j += 512) { const int r = j / KC, k = j % KC; tab[j] = sg[r * DM + kc * KC + k]; }
    __syncthreads();
    const float* W = F.mod_w + ((size_t)l * DM + (size_t)kc * KC) * MODW + nt * 256 + F.lane * 4;
    f32x4 acc[5];
#pragma unroll
    for (int r = 0; r < 5; ++r) acc[r] = (f32x4){0.f, 0.f, 0.f, 0.f};
#pragma unroll 8
    for (int k = 0; k < KC; ++k) { const f32x4 w = *(const f32x4*)(W + (size_t)k * MODW);
#pragma unroll
        for (int r = 0; r < 5; ++r) { const float s = tab[r * KC + k]; acc[r] += w * s; } }
    float* modp = WSP(float, WS_MODP);
#pragma unroll
    for (int r = 0; r < 5; ++r) *(f32x4*)(modp + ((size_t)(kc * 4 + l) * 5 + r) * MODW + nt * 256 + F.lane * 4) = acc[r];
    __syncthreads();
}
constexpr int ADALN_NB = 3 * KCH * (MODW / 256 / 8);
DI void ph_finalize_mod(Frame& F, int l_lo, int l_hi) {
    const float* modp = WSP(float, WS_MODP); float* mod = WSP(float, WS_MOD);
    for (int j = 5 * l_lo * (MODW / 4) + blockIdx.x * 512 + F.tid; j < 5 * l_hi * (MODW / 4); j += F.G * 512) {
        const int n4 = j % (MODW / 4), lr = j / (MODW / 4), l = lr / 5;
        f32x4 s = *(const f32x4*)(F.mod_b + (size_t)l * MODW + n4 * 4);
        for (int kc = 0; kc < KCH; ++kc) s += *(const f32x4*)(modp + ((size_t)kc * 20 + lr) * MODW + n4 * 4);
        *(f32x4*)(mod + (size_t)lr * MODW + n4 * 4) = s;
    }
}
DI void ph_finalize(Frame& F) {
    ph_finalize_mod(F, 0, 1);
    float* lb = WSP(float, WS_LB);
    for (int j = blockIdx.x * 512 + F.tid; j < 2 * 2048; j += F.G * 512) {
        const float a0 = F.hg_lb[j], a1 = F.hg_lb[2 * 2048 + j], m = fmaxf(a0, a1), e0 = expf(a0 - m), e1 = expf(a1 - m);
        lb[j] = 0.f; lb[2 * 2048 + j] = e1 / (e0 + e1);
    }
}
DI void ph_ada_in(Frame& F, int l, const void* xl, bool xl_f32, const void* xc, bool xc_f32) {
    const int gw = F.vcu * NWAVES + F.wave, NGW = F.G * NWAVES;
    const float* gain = F.norm_gain + (size_t)l * DM; bf16* H = WSP(bf16, WS_H);
    for (int row = gw; row < MT; row += NGW) {
        const bool lat = row < M_LAT; const bool sf32 = lat ? xl_f32 : xc_f32;
        const size_t ro = lat ? (size_t)row * DM : (size_t)(row - M_LAT) * DM; const void* sp = lat ? xl : xc;
        const int seg = lat ? (row >> 12) : 4;
        const float* md = WSP(float, WS_MOD) + ((size_t)l * 5 + seg) * MODW;
        float v[8][8]; float ss = 0.f;
        if (sf32) {
#pragma unroll
            for (int j = 0; j < 8; ++j) { const int c8 = F.lane + 64 * j; const f32x4 a = *((const f32x4*)((const float*)sp + ro) + 2 * c8), b = *((const f32x4*)((const float*)sp + ro) + 2 * c8 + 1);
                v[j][0] = a.x; v[j][1] = a.y; v[j][2] = a.z; v[j][3] = a.w; v[j][4] = b.x; v[j][5] = b.y; v[j][6] = b.z; v[j][7] = b.w; }
        } else {
#pragma unroll
            for (int j = 0; j < 8; ++j) { const int c8 = F.lane + 64 * j; const v4u w = *((const v4u*)((const bf16*)sp + ro) + c8);
#pragma unroll
                for (int e = 0; e < 4; ++e) { v[j][2 * e] = bflo(w[e]); v[j][2 * e + 1] = bfhi(w[e]); } }
        }
        if (l >= 1 && !lat) { const float* pp = WSP(float, WS_PART) + (size_t)(row - M_LAT) * DM; const float* gt = WSP(float, WS_MOD) + ((size_t)(l - 1) * 5 + 4) * MODW + 2 * DM;
            bf16* xs = WSP(bf16, WS_XS) + (size_t)row * DM;
#pragma unroll
            for (int j = 0; j < 8; ++j) { const int c8 = F.lane + 64 * j; f32x4 s0 = *((const f32x4*)pp + 2 * c8), s1 = *((const f32x4*)pp + 2 * c8 + 1);
#pragma unroll
                for (int q = 1; q < 4; ++q) { s0 += *((const f32x4*)(pp + (size_t)q * M_CTX * DM) + 2 * c8); s1 += *((const f32x4*)(pp + (size_t)q * M_CTX * DM) + 2 * c8 + 1); }
                const f32x4 g0 = *((const f32x4*)gt + 2 * c8), g1 = *((const f32x4*)gt + 2 * c8 + 1);
                v[j][0] += g0.x * s0.x; v[j][1] += g0.y * s0.y; v[j][2] += g0.z * s0.z; v[j][3] += g0.w * s0.w; v[j][4] += g1.x * s1.x; v[j][5] += g1.y * s1.y; v[j][6] += g1.z * s1.z; v[j][7] += g1.w * s1.w;
                v4u o; o.x = pk2(v[j][0], v[j][1]); o.y = pk2(v[j][2], v[j][3]); o.z = pk2(v[j][4], v[j][5]); o.w = pk2(v[j][6], v[j][7]); *((v4u*)xs + c8) = o; } }
#pragma unroll
        for (int j = 0; j < 8; ++j)
#pragma unroll
            for (int e = 0; e < 8; ++e) ss += v[j][e] * v[j][e];
        const float rinv = rsqrtf(wave_sum(ss, F.lane) * (1.0f / DM) + EPS);
#pragma unroll
        for (int j = 0; j < 8; ++j) { const int c8 = F.lane + 64 * j;
            const f32x4 g0 = *((const f32x4*)gain + 2 * c8), g1 = *((const f32x4*)gain + 2 * c8 + 1), h0 = *((const f32x4*)md + 2 * c8), h1 = *((const f32x4*)md + 2 * c8 + 1),
                        c0 = *((const f32x4*)(md + DM) + 2 * c8), c1 = *((const f32x4*)(md + DM) + 2 * c8 + 1);
            v4u o; o.x = pk2(v[j][0] * rinv * g0.x * (c0.x + 1.0f) + h0.x, v[j][1] * rinv * g0.y * (c0.y + 1.0f) + h0.y); o.y = pk2(v[j][2] * rinv * g0.z * (c0.z + 1.0f) + h0.z, v[j][3] * rinv * g0.w * (c0.w + 1.0f) + h0.w);
            o.z = pk2(v[j][4] * rinv * g1.x * (c1.x + 1.0f) + h1.x, v[j][5] * rinv * g1.y * (c1.y + 1.0f) + h1.y); o.w = pk2(v[j][6] * rinv * g1.z * (c1.z + 1.0f) + h1.z, v[j][7] * rinv * g1.w * (c1.w + 1.0f) + h1.w);
            *((v4u*)(H + (size_t)row * DM) + c8) = o; }
    }
}
DI void ph_tail_fold(Frame& F) {
    const float* part = WSP(float, WS_PART); bf16* P = WSP(bf16, WS_P);
    for (int idx = F.vcu * (NWAVES * 64) + F.tid; idx < M_CTX * 288; idx += F.G * (NWAVES * 64)) { const int row = idx / 288, ch = idx - row * 288;
        const float* p = part + (size_t)row * DM + ch * 8;
        f32x4 a0 = *(const f32x4*)p, a1 = *(const f32x4*)(p + 4);
#pragma unroll
        for (int q = 1; q < 4; ++q) { a0 += *(const f32x4*)(p + (size_t)q * M_CTX * DM); a1 += *(const f32x4*)(p + (size_t)q * M_CTX * DM + 4); }
        v4u w; w.x = pk2(a0[0], a0[1]); w.y = pk2(a0[2], a0[3]); w.z = pk2(a1[0], a1[1]); w.w = pk2(a1[2], a1[3]);
        *(v4u*)(P + (size_t)(M_LAT + row) * E_PAD + 48 * 256 + ch * 8) = w; }
}
DI void ph_lora_norm(Frame& F, int i) {
    const int gw = F.vcu * NWAVES + F.wave, NGW = F.G * NWAVES;
    const bf16* P = WSP(bf16, WS_P); bf16* CQN = WSP(bf16, WS_CQN); bf16* CKVN = WSP(bf16, WS_CKVN);
    const float* qg = F.q_a_gain + (size_t)i * Q_LORA; const float* kg = F.kv_a_gain + (size_t)i * KV_LORA;
    for (int row = gw; row < MT; row += NGW) {
        const bf16* pr = P + (size_t)row * E_PAD;
        v4u a[3]; float ss = 0.f;
#pragma unroll
        for (int j = 0; j < 3; ++j) { a[j] = *((const v4u*)(pr + E_CQ) + F.lane + 64 * j);
#pragma unroll
            for (int e = 0; e < 4; ++e) { const float lo = bflo(a[j][e]), hi = bfhi(a[j][e]); ss += lo * lo + hi * hi; } }
        const float rq = rsqrtf(wave_sum(ss, F.lane) * (1.0f / Q_LORA) + EPS);
#pragma unroll
        for (int j = 0; j < 3; ++j) { const int c8 = F.lane + 64 * j; const f32x4 g0 = *((const f32x4*)qg + 2 * c8), g1 = *((const f32x4*)qg + 2 * c8 + 1); v4u o;
            o.x = pk2(bflo(a[j].x) * rq * g0.x, bfhi(a[j].x) * rq * g0.y); o.y = pk2(bflo(a[j].y) * rq * g0.z, bfhi(a[j].y) * rq * g0.w);
            o.z = pk2(bflo(a[j].z) * rq * g1.x, bfhi(a[j].z) * rq * g1.y); o.w = pk2(bflo(a[j].w) * rq * g1.z, bfhi(a[j].w) * rq * g1.w);
            *((v4u*)(CQN + (size_t)row * Q_LORA) + c8) = o; }
        const v4u b = *((const v4u*)(pr + E_CKV) + F.lane); float s2 = 0.f;
#pragma unroll
        for (int e = 0; e < 4; ++e) { const float lo = bflo(b[e]), hi = bfhi(b[e]); s2 += lo * lo + hi * hi; }
        const float rk = rsqrtf(wave_sum(s2, F.lane) * (1.0f / KV_LORA) + EPS);
        { const f32x4 g0 = *((const f32x4*)kg + 2 * F.lane), g1 = *((const f32x4*)kg + 2 * F.lane + 1); v4u o;
          o.x = pk2(bflo(b.x) * rk * g0.x, bfhi(b.x) * rk * g0.y); o.y = pk2(bflo(b.y) * rk * g0.z, bfhi(b.y) * rk * g0.w);
          o.z = pk2(bflo(b.z) * rk * g1.x, bfhi(b.z) * rk * g1.y); o.w = pk2(bflo(b.w) * rk * g1.z, bfhi(b.w) * rk * g1.w);
          *((v4u*)(CKVN + (size_t)row * KV_LORA) + F.lane) = o; }
    }
}
DI void ph_qk_norm_rope(Frame& F, int i) {
    const int gw = F.vcu * NWAVES + F.wave, NGW = F.G * NWAVES;
    bf16* QF = WSP(bf16, WS_QF); const bf16* KV = WSP(bf16, WS_KV); bf16* KF = WSP(bf16, WS_KF); const bf16* P = WSP(bf16, WS_P);
    const float* qg = F.q_norm_gain + (size_t)i * QKD; const float* kg = F.k_norm_gain + (size_t)i * QKD;
    const int h = F.lane >> 2, part = F.lane & 3;
    float inv[8];
#pragma unroll
    for (int j = 0; j < 8; ++j) inv[j] = exp2f(-(float)(8 * (part & 1) + j) * (13.287712379549449f / 16.0f));
    constexpr float QSCL = 0.07216878364870322f * 1.4426950408889634f;
    for (int row = gw; row < MT; row += NGW) {
        const bool lat = row < M_LAT; const int t = row & 4095; const float prow = (float)(t >> 6), pcol = (float)(t & 63);
        float cs[2][8], sn[2][8];
        if (lat) {
#pragma unroll
            for (int j = 0; j < 8; ++j) { sincosf(prow * inv[j], &sn[0][j], &cs[0][j]); sincosf(pcol * inv[j], &sn[1][j], &cs[1][j]); }
        }
#pragma unroll
        for (int which = 0; which < 2; ++which) {
            float v[6][8]; float ss = 0.f;
#pragma unroll
            for (int ii = 0; ii < 6; ++ii) { const int c = part + 4 * ii; v4u w;
                if (which == 0) w = *(const v4u*)(QF + (size_t)row * NQ + h * QKD + 8 * c);
                else if (ii < 4) w = *(const v4u*)(KV + (size_t)row * NKV + h * 256 + 8 * c);
                else w = *(const v4u*)(P + (size_t)row * E_PAD + E_KPE + 8 * (c - 16));
#pragma unroll
                for (int e = 0; e < 4; ++e) { v[ii][2 * e] = bflo(w[e]); v[ii][2 * e + 1] = bfhi(w[e]); ss += v[ii][2 * e] * v[ii][2 * e] + v[ii][2 * e + 1] * v[ii][2 * e + 1]; } }
            ss += bperm(F.lane ^ 1, ss); ss += bperm(F.lane ^ 2, ss);
            const float rn = rsqrtf(ss * (1.0f / QKD) + EPS); const float* gg = which == 0 ? qg : kg;
#pragma unroll
            for (int ii = 0; ii < 6; ++ii) { const int c = part + 4 * ii;
#pragma unroll
                for (int e = 0; e < 8; ++e) v[ii][e] = v[ii][e] * rn * gg[8 * c + e]; }
            if (lat) {
#pragma unroll
                for (int hf = 0; hf < 2; ++hf) {
#pragma unroll
                    for (int e = 0; e < 8; ++e) { const float m = v[4 + hf][e], o = bperm(F.lane ^ 2, m);
                        v[4 + hf][e] = (part < 2) ? (m * cs[hf][e] - o * sn[hf][e]) : (o * sn[hf][e] + m * cs[hf][e]); } }
            }
            const float scl = which == 0 ? QSCL : 1.0f;
#pragma unroll
            for (int ii = 0; ii < 6; ++ii) { const int c = part + 4 * ii; v4u o;
#pragma unroll
                for (int e = 0; e < 4; ++e) o[e] = pk2(v[ii][2 * e] * scl, v[ii][2 * e + 1] * scl);
                if (which == 0) *(v4u*)(QF + (size_t)row * NQ + h * QKD + 8 * c) = o; else *(v4u*)(KF + (size_t)row * NQ + h * QKD + 8 * c) = o; }
        }
    }
}
DI void hg_merge_rows(Frame& F, int i, int start, int end, int stride) {
    const bf16* OFp = WSP(bf16, WS_OFE); const bf16* OBp = WSP(bf16, WS_OBE); const bf16* P = WSP(bf16, WS_P); bf16* A = WSP(bf16, WS_A);
    const float* hgg = F.hg_norm_gain + (size_t)i * 128; const int h = F.lane >> 2, part = F.lane & 3;
    for (int row = start; row < end; row += stride) {
        const size_t o0 = (size_t)row * 2048 + h * 128 + part * 32; f32x4 v[8]; float ss = 0.f;
#pragma unroll
        for (int j = 0; j < 4; ++j) { const v4u a = *((const v4u*)(OFp + o0) + j), b = *((const v4u*)(OBp + o0) + j);
            v[2 * j] = (f32x4){bflo(a.x) + bflo(b.x), bfhi(a.x) + bfhi(b.x), bflo(a.y) + bflo(b.y), bfhi(a.y) + bfhi(b.y)};
            v[2 * j + 1] = (f32x4){bflo(a.z) + bflo(b.z), bfhi(a.z) + bfhi(b.z), bflo(a.w) + bflo(b.w), bfhi(a.w) + bfhi(b.w)}; }
#pragma unroll
        for (int j = 0; j < 8; ++j) ss += (v[j].x * v[j].x + v[j].y * v[j].y) + (v[j].z * v[j].z + v[j].w * v[j].w);
        ss += bperm(F.lane ^ 1, ss); ss += bperm(F.lane ^ 2, ss);
        const float rn = rsqrtf(ss * (1.0f / 128) + EPS);
        const bf16* gp = P + (size_t)row * E_PAD + E_GH + h * 128 + part * 32; bf16* ap = A + (size_t)row * DM + 2048 + h * 128 + part * 32;
#pragma unroll
        for (int j = 0; j < 4; ++j) { const v4u g = *((const v4u*)gp + j); const f32x4 a = v[2 * j], b = v[2 * j + 1];
            const f32x4 g0 = *((const f32x4*)(hgg + part * 32) + 2 * j), g1 = *((const f32x4*)(hgg + part * 32) + 2 * j + 1); v4u o;
            o.x = pk2(a.x * rn * g0.x * siluf(bflo(g.x)), a.y * rn * g0.y * siluf(bfhi(g.x))); o.y = pk2(a.z * rn * g0.z * siluf(bflo(g.y)), a.w * rn * g0.w * siluf(bfhi(g.y)));
            o.z = pk2(b.x * rn * g1.x * siluf(bflo(g.z)), b.y * rn * g1.y * siluf(bfhi(g.z))); o.w = pk2(b.z * rn * g1.z * siluf(bflo(g.w)), b.w * rn * g1.w * siluf(bfhi(g.w)));
            *((v4u*)ap + j) = o; }
    }
}
DI void ph_ret_rope(Frame& F) {
    const int gw = F.vcu * NWAVES + F.wave, NGW = F.G * NWAVES; bf16* P = WSP(bf16, WS_P);
    const int hsub = F.lane >> 4, i0 = 8 * (F.lane & 15);
    float inv[8];
#pragma unroll
    for (int j = 0; j < 8; ++j) inv[j] = 1.0f / powf(10000.0f, (float)(i0 + j) * (1.0f / 127.0f));
    for (int row = gw; row < MT; row += NGW) {
        const bool lat = row < M_LAT; const float pos = (float)(row & 4095);
        float cs[8], sn[8];
#pragma unroll
        for (int j = 0; j < 8; ++j) { if (lat) sincosf(pos * inv[j], &sn[j], &cs[j]); else { cs[j] = 1.f; sn[j] = 0.f; } }
#pragma unroll
        for (int which = 0; which < 2; ++which) {
            const float scl = which ? 0.0625f : 1.0f;
#pragma unroll
            for (int it = 0; it < 4; ++it) { const int h = 4 * it + hsub; bf16* p1 = P + (size_t)row * O_END + (which ? O_K : O_Q) + h * 256 + i0; bf16* p2 = p1 + 128;
                const v4u a = *(const v4u*)p1, b = *(const v4u*)p2; v4u oa, ob;
#pragma unroll
                for (int e = 0; e < 4; ++e) { const float x1l = bflo(a[e]), x1h = bfhi(a[e]), x2l = bflo(b[e]), x2h = bfhi(b[e]);
                    oa[e] = pk2((x1l * cs[2 * e] - x2l * sn[2 * e]) * scl, (x1h * cs[2 * e + 1] - x2h * sn[2 * e + 1]) * scl);
                    ob[e] = pk2((x1l * sn[2 * e] + x2l * cs[2 * e]) * scl, (x1h * sn[2 * e + 1] + x2h * cs[2 * e + 1]) * scl); }
                *(v4u*)p1 = oa; *(v4u*)p2 = ob; }
        }
    }
}
DI void ph_ret_merge(Frame& F, int li, bool ctx_split) {
    const int gw = F.vcu * NWAVES + F.wave, NGW = F.G * NWAVES;
    const bf16* OFp = WSP(bf16, WS_OFO); const bf16* OBp = WSP(bf16, WS_OBO); const bf16* P = WSP(bf16, WS_P); bf16* A = WSP(bf16, WS_A);
    LAS float* l2t = (LAS float*)F.lds;
    if (F.tid < 32) { const float dl = F.ret_decay[(size_t)li * 32 + F.tid]; l2t[F.tid] = -log1pf(expf(-dl)) * 1.4426950408889634f; }
    __syncthreads();
    for (int row = gw; row < MT; row += NGW) {
        const float j = (float)(row & 63);
#pragma unroll 4
        for (int h = 0; h < 16; ++h) { const size_t o0 = (size_t)row * 8192 + h * 512 + F.lane * 8;
            const float sf = __builtin_amdgcn_exp2f((j - 63.0f) * l2t[h]), sb = __builtin_amdgcn_exp2f(-j * l2t[16 + h]);
            const v4u fa = *(const v4u*)(OFp + o0), fb = *(const v4u*)(OBp + o0);
            const f32x4 a = (f32x4){bflo(fa.x) * sf + bflo(fb.x) * sb, bfhi(fa.x) * sf + bfhi(fb.x) * sb, bflo(fa.y) * sf + bflo(fb.y) * sb, bfhi(fa.y) * sf + bfhi(fb.y) * sb};
            const f32x4 b = (f32x4){bflo(fa.z) * sf + bflo(fb.z) * sb, bfhi(fa.z) * sf + bfhi(fb.z) * sb, bflo(fa.w) * sf + bflo(fb.w) * sb, bfhi(fa.w) * sf + bfhi(fb.w) * sb};
            const float ss = (a.x * a.x + a.y * a.y) + (a.z * a.z + a.w * a.w) + (b.x * b.x + b.y * b.y) + (b.z * b.z + b.w * b.w);
            const float rn = rsqrtf(wave_sum(ss, F.lane) * (1.0f / 512) + EPS);
            v4u g;
            if (ctx_split && row >= M_LAT) { const float* pp = WSP(float, WS_PART) + (size_t)(row - M_LAT) * 8192 + h * 512 + F.lane * 8; const size_t hs = (size_t)M_CTX * 8192;
                const f32x4 x0 = *(const f32x4*)pp + *(const f32x4*)(pp + hs), x1 = *(const f32x4*)(pp + 4) + *(const f32x4*)(pp + hs + 4);
                g.x = pk2(x0[0], x0[1]); g.y = pk2(x0[2], x0[3]); g.z = pk2(x1[0], x1[1]); g.w = pk2(x1[2], x1[3]); }
            else g = *(const v4u*)(P + (size_t)row * O_END + O_G + h * 512 + F.lane * 8);
            v4u o;
            o.x = pk2(a.x * rn * siluf(bflo(g.x)), a.y * rn * siluf(bfhi(g.x))); o.y = pk2(a.z * rn * siluf(bflo(g.y)), a.w * rn * siluf(bfhi(g.y)));
            o.z = pk2(b.x * rn * siluf(bflo(g.z)), b.y * rn * siluf(bfhi(g.z))); o.w = pk2(b.z * rn * siluf(bflo(g.w)), b.w * rn * siluf(bfhi(g.w)));
            *(v4u*)(A + (size_t)row * 8192 + h * 512 + F.lane * 8) = o; }
    }
}
namespace att {
constexpr int KP = 400;
constexpr int VB = 64 * 128 * 2, KB = 64 * KP;
constexpr int OFF_V = 0, OFF_K = 3 * VB, OFF_WS = OFF_K + 3 * KB;
static_assert(OFF_WS + 8 * 256 <= MISC_OFF, "attention LDS map");
constexpr float THR2 = 11.5f;
DI int v_st(int k, int c) { const int kk = (k & ~0xC) | ((k & 4) << 1) | ((k & 8) >> 1); return ((kk >> 3) * 4 + (c >> 5)) * 512 + ((kk & 7) * 32 + (c & 31)) * 2; }
DI int v_rd_base(int lane) { return ((lane & 3) << 3) | (((lane >> 2) & 3) << 6) | (((lane >> 4) & 1) << 5) | (((lane >> 5) & 1) << 8); }
constexpr int v_rd_off(int d0, int ks, int half) { return d0 * 512 + ks * 4096 + half * 2048; }
template <int OFF> DI s16x4 tr_read(int vb) { s16x4 r; asm volatile("ds_read_b64_tr_b16 %0, %1 offset:%2" : "=&v"(r) : "v"(vb), "i"(OFF) : "memory"); return r; }
template <int D0> DI void pv_one(f32x16& od, int vb, bf16x8 pa0, bf16x8 pa1, bf16x8 pa2, bf16x8 pa3) {
    const s16x4 l0 = tr_read<v_rd_off(D0, 0, 0)>(vb), h0 = tr_read<v_rd_off(D0, 0, 1)>(vb), l1 = tr_read<v_rd_off(D0, 1, 0)>(vb), h1 = tr_read<v_rd_off(D0, 1, 1)>(vb);
    const s16x4 l2 = tr_read<v_rd_off(D0, 2, 0)>(vb), h2 = tr_read<v_rd_off(D0, 2, 1)>(vb), l3 = tr_read<v_rd_off(D0, 3, 0)>(vb), h3 = tr_read<v_rd_off(D0, 3, 1)>(vb);
    LDS_WAIT_PIN();
    od = MFMA32(pa0, CAT8(l0, h0), od); od = MFMA32(pa1, CAT8(l1, h1), od); od = MFMA32(pa2, CAT8(l2, h2), od); od = MFMA32(pa3, CAT8(l3, h3), od);
}
DI void unit(Frame& F, int h, int qrow0, int klat0, int nlat, int kctx0, int NT, int ldp) {
    const int tid = F.tid, wid = F.wave, lane = F.lane, r32 = lane & 31, hi = lane >> 5;
    const bf16* QF = WSP(bf16, WS_QF); const bf16* KF = WSP(bf16, WS_KF); const bf16* KV = WSP(bf16, WS_KV); const bf16* P = WSP(bf16, WS_P); bf16* A = WSP(bf16, WS_A);
    LAS unsigned char* Vl = F.lds + OFF_V; LAS unsigned char* Kl = F.lds + OFF_K;
    LAS float* wsl = (LAS float*)(F.lds + OFF_WS) + wid * 64; LAS float* li_l = wsl; LAS float* al_l = wsl + 32;
    float m_reg = -1e30f, l_reg = 0.f; f32x16 o[4];
#pragma unroll
    for (int d = 0; d < 4; ++d)
#pragma unroll
        for (int r = 0; r < 16; ++r) o[d][r] = 0.f;
    bf16x8 qr[12];
    { const bf16* Qw = QF + (size_t)(qrow0 + wid * 32 + r32) * NQ + h * QKD + hi * 8;
#pragma unroll
      for (int d0 = 0; d0 < 12; ++d0) qr[d0] = *(const bf16x8*)(Qw + d0 * 16); }
    int krow[3], kch[3];
#pragma unroll
    for (int i = 0; i < 3; ++i) { const int idx = tid + 512 * i; krow[i] = idx / 24; kch[i] = idx % 24; }
    const int vrow0 = tid >> 4, vc = (tid & 15) * 8;
    v4u sk[3], sv[2];
    const int vb0 = (int)(uintptr_t)Vl + v_rd_base(lane);
#define KEYROW(kt) ((kt) < nlat ? klat0 + 64 * (kt) : kctx0 + 64 * ((kt) - nlat))
#define SLOADK(kt) do { const int kr_ = KEYROW(kt); _Pragma("unroll") for (int i = 0; i < 3; ++i) sk[i] = *(const v4u*)(KF + (size_t)(kr_ + krow[i]) * NQ + h * QKD + kch[i] * 8); } while (0)
#define SLOADV(kt) do { const int kr_ = KEYROW(kt); _Pragma("unroll") for (int i = 0; i < 2; ++i) sv[i] = *(const v4u*)(KV + (size_t)(kr_ + vrow0 + 32 * i) * NKV + h * 256 + 128 + vc); } while (0)
#define SWRITEK(b) do { _Pragma("unroll") for (int i = 0; i < 3; ++i) *(LAS v4u*)(Kl + (b) * KB + krow[i] * KP + kch[i] * 16) = sk[i]; } while (0)
#define SWRITEV(b) do { _Pragma("unroll") for (int i = 0; i < 2; ++i) *(LAS v4u*)(Vl + (b) * VB + v_st(vrow0 + 32 * i, vc)) = sv[i]; } while (0)
    const bool grpA = wid < 4;
    SLOADK(0); SLOADV(0); SWRITEK(0); SWRITEV(0);
    if (NT > 1) { SLOADK(1); SWRITEK(1); }
    if (NT > 2) SLOADK(2);
    if (NT > 1) SLOADV(1);
    __syncthreads();
    int kb = 0, kb2 = 2, vb1 = 1;
    for (int j = 0; j < NT; ++j) {
        f32x16 p0, p1;
#pragma unroll
        for (int r = 0; r < 16; ++r) { p0[r] = 0.f; p1[r] = 0.f; }
        { const LAS unsigned char* Ks = Kl + kb * KB; __builtin_amdgcn_s_setprio(1);
#pragma unroll
          for (int d0 = 0; d0 < 12; ++d0) { const int cb = (d0 * 16 + hi * 8) * 2;
              const bf16x8 b0 = *(const LAS bf16x8*)(Ks + r32 * KP + cb), b1 = *(const LAS bf16x8*)(Ks + (32 + r32) * KP + cb);
              p0 = MFMA32(b0, qr[d0], p0); p1 = MFMA32(b1, qr[d0], p1); } __builtin_amdgcn_s_setprio(0); }
        if (grpA) __syncthreads();
        float pmax = p0[0];
#pragma unroll
        for (int r = 1; r < 16; ++r) pmax = fmaxf(pmax, p0[r]);
#pragma unroll
        for (int r = 0; r < 16; ++r) pmax = fmaxf(pmax, p1[r]);
        { auto rr = __builtin_amdgcn_permlane32_swap(__float_as_uint(pmax), __float_as_uint(pmax), false, false); pmax = fmaxf(__uint_as_float(rr[0]), __uint_as_float(rr[1])); }
        float mn, alpha;
        if (__all(pmax - m_reg <= THR2)) { mn = m_reg; alpha = 1.f; }
        else { mn = fmaxf(m_reg, pmax); alpha = __builtin_amdgcn_exp2f(m_reg - mn); m_reg = mn; }
        float ps = 0.f;
#pragma unroll
        for (int r = 0; r < 16; ++r) { p0[r] = __builtin_amdgcn_exp2f(p0[r] - mn); p1[r] = __builtin_amdgcn_exp2f(p1[r] - mn); ps += p0[r] + p1[r]; }
        { auto rr = __builtin_amdgcn_permlane32_swap(__float_as_uint(ps), __float_as_uint(ps), false, false); ps = __uint_as_float(rr[0]) + __uint_as_float(rr[1]); }
        l_reg = l_reg * alpha + ps;
        bf16x8 pa0, pa1, pa2, pa3;
#define PK4(Pv, BASE, OUT) do { unsigned a0 = cvtpk(Pv[BASE + 0], Pv[BASE + 1]), a1 = cvtpk(Pv[BASE + 2], Pv[BASE + 3]); \
        unsigned b0_ = cvtpk(Pv[BASE + 4], Pv[BASE + 5]), b1_ = cvtpk(Pv[BASE + 6], Pv[BASE + 7]); \
        auto r0 = __builtin_amdgcn_permlane32_swap(a0, b0_, false, false); auto r1 = __builtin_amdgcn_permlane32_swap(a1, b1_, false, false); \
        v4u w = {r0[0], r1[0], r0[1], r1[1]}; OUT = __builtin_bit_cast(bf16x8, w); } while (0)
        PK4(p0, 0, pa0); PK4(p0, 8, pa1); PK4(p1, 0, pa2); PK4(p1, 8, pa3);
#undef PK4
        if (__any(alpha < 1.f)) { if (hi == 0) al_l[r32] = alpha; asm volatile("s_waitcnt lgkmcnt(0)" ::: "memory");
#pragma unroll
            for (int r = 0; r < 16; ++r) { const float a = al_l[crow(r, hi)];
#pragma unroll
                for (int d = 0; d < 4; ++d) o[d][r] *= a; } }
        if (j + 2 < NT) SWRITEK(kb2);
        if (j + 1 < NT) SWRITEV(vb1);
        if (j + 3 < NT) SLOADK(j + 3);
        if (j + 2 < NT) SLOADV(j + 2);
        if (!grpA) __syncthreads();
        { const int vb = vb0 + kb * VB;
          pv_one<0>(o[0], vb, pa0, pa1, pa2, pa3); pv_one<1>(o[1], vb, pa0, pa1, pa2, pa3); pv_one<2>(o[2], vb, pa0, pa1, pa2, pa3); pv_one<3>(o[3], vb, pa0, pa1, pa2, pa3); }
        kb = kb == 2 ? 0 : kb + 1; kb2 = kb2 == 2 ? 0 : kb2 + 1; vb1 = vb1 == 2 ? 0 : vb1 + 1;
    }
    __syncthreads();
#undef SLOADK
#undef SLOADV
#undef SWRITEK
#undef SWRITEV
#undef KEYROW
    if (hi == 0) li_l[r32] = l_reg; asm volatile("s_waitcnt lgkmcnt(0)" ::: "memory");
#pragma unroll
    for (int r = 0; r < 16; ++r) { const int orow = crow(r, hi); const float rl = __builtin_amdgcn_rcpf(li_l[orow]); const size_t grow = (size_t)(qrow0 + wid * 32 + orow);
#pragma unroll
        for (int d0 = 0; d0 < 4; ++d0) { const int col = h * 128 + d0 * 32 + r32; const float g = bf2f(P[grow * ldp + E_GM + col]);
            A[grow * DM + col] = (bf16)f2bf(o[d0][r] * rl * siluf(g)); } }
    __syncthreads();
}
}
namespace hg {
constexpr int TP = 272;
constexpr int OFF_QP = 0, OFF_KP = OFF_QP + 32 * TP, OFF_QS = OFF_KP + 32 * TP, OFF_KH = OFF_QS + 32 * TP, OFF_V = OFF_KH + 8192, OFF_A = OFF_V + 8192, OFF_E = OFF_A + 2560, OFF_SB = OFF_E + 512, SB_BYTES = 128 * TP;
static_assert(OFF_SB + 2 * SB_BYTES <= MISC_OFF && OFF_SB % 16 == 0, "hgrn LDS map");
constexpr int NCH = 8 + 128;
template <int OFF> DI s16x4 tr_off(unsigned base) { s16x4 r; asm volatile("ds_read_b64_tr_b16 %0, %1 offset:%2" : "=&v"(r) : "v"(base), "i"(OFF) : "memory"); return r; }
DI float scan32(float x) {
    x += __int_as_float(__builtin_amdgcn_update_dpp(0, __float_as_int(x), 0x111, 0xF, 0xF, false));
    x += __int_as_float(__builtin_amdgcn_update_dpp(0, __float_as_int(x), 0x112, 0xF, 0xF, false));
    x += __int_as_float(__builtin_amdgcn_update_dpp(0, __float_as_int(x), 0x114, 0xF, 0xF, false));
    x += __int_as_float(__builtin_amdgcn_update_dpp(0, __float_as_int(x), 0x118, 0xF, 0xF, false));
    x += __int_as_float(__builtin_amdgcn_update_dpp(0, __float_as_int(x), 0x142, 0xA, 0xF, false));
    return x;
}
DI void unit(Frame& F, int li, int b, int h, int dir) {
    const int wid = F.wave, lane0 = F.lane;
    const bf16* P = WSP(bf16, WS_P); bf16* OUT = dir ? WSP(bf16, WS_OBE) : WSP(bf16, WS_OFE);
    LAS unsigned char* L = F.lds;
    const int p0 = lane0 & 31, ch0 = 2 * wid + (lane0 >> 5);
    float lbv[8], omv[8];
    { const float* lbp = WSP(float, WS_LB) + ((size_t)li * 2 + dir) * 2048 + h * 128 + ch0 * 8;
#pragma unroll
      for (int j = 0; j < 8; ++j) { lbv[j] = lbp[j]; omv[j] = 1.0f - lbv[j]; } }
    const unsigned goff = (unsigned)(((dir ? 31 - p0 : p0) * E_PAD + ch0 * 8) * 2);
    const unsigned lrow = p0 * TP + ch0 * 16, limg = img_off(p0, ch0);
    const int fcol = (dir ? E_FB : E_FF) + h * 128, qcol = E_QH + h * 128, vcol = E_IH + h * 128;
#define ROWLO(ci) ((ci) < 8 ? M_LAT + b * CTXL + (dir ? CTXL - 32 - (ci) * 32 : (ci) * 32) : b * SEQ + (dir ? SEQ - 32 - ((ci) - 8) * 32 : ((ci) - 8) * 32))
#define HLOAD(ci) do { const char* pb_ = (const char*)(P + (size_t)ROWLO(ci) * E_PAD); rq = *(const v4u*)(pb_ + qcol * 2 + goff); rf = *(const v4u*)(pb_ + fcol * 2 + goff); rv = *(const v4u*)(pb_ + vcol * 2 + goff); } while (0)
    f32x16 accS[2];
#pragma unroll
    for (int i = 0; i < 2; ++i)
#pragma unroll
        for (int r = 0; r < 16; ++r) accS[i][r] = 0.f;
    for (int j = F.tid; j < SB_BYTES / 16; j += 512) *((LAS v4u*)(L + OFF_SB) + j) = (v4u){0u, 0u, 0u, 0u};
    v4u rq, rf, rv;
    HLOAD(0);
    __syncthreads();
    for (int cidx = 0; cidx < NCH; ++cidx) {
        int lane = lane0; asm volatile("" : "+v"(lane));
        const int cur = cidx & 1;
        const unsigned SBc = OFF_SB + cur * SB_BYTES, SBn = OFF_SB + (cur ^ 1) * SB_BYTES;
        const v4u cq = rq, cf = rf, cv = rv;
        if (cidx + 1 < NCH) HLOAD(cidx + 1);
        {
            v4u oqp, okp, oqs, okh; float qp[8], kp[8], qs[8], kh[8], e31[8];
            const bool up = lane >= 32;
#pragma unroll
            for (int e = 0; e < 8; ++e) { const float f = (e & 1) ? bfhi(cf[e >> 1]) : bflo(cf[e >> 1]), q = (e & 1) ? bfhi(cq[e >> 1]) : bflo(cq[e >> 1]);
                const float t = __builtin_amdgcn_exp2f(-1.4426950408889634f * __builtin_fabsf(f)), r = __builtin_amdgcn_rcpf(1.0f + t), tr = t * r;
                const float sp = f >= 0.f ? r : tr, sn = f >= 0.f ? tr : r;
                const float key = omv[e] * sn, g = lbv[e] + omv[e] * sp;
                const float bb = scan32(fmaxf(__builtin_amdgcn_logf(g), -120.0f));
                const int bi = __float_as_int(bb), s15 = __builtin_amdgcn_readlane(bi, 15), s47 = __builtin_amdgcn_readlane(bi, 47), s31 = __builtin_amdgcn_readlane(bi, 31), s63 = __builtin_amdgcn_readlane(bi, 63);
                const float c = __int_as_float(up ? s47 : s15), bl = __int_as_float(up ? s63 : s31);
                const float e1 = __builtin_amdgcn_exp2f(bb - c), e2 = __builtin_amdgcn_exp2f(c - bb), ec = __builtin_amdgcn_exp2f(c), ebc = __builtin_amdgcn_exp2f(bl - c);
                qp[e] = q * e1; kp[e] = key * e2; qs[e] = qp[e] * ec; kh[e] = kp[e] * ebc; e31[e] = ec * ebc; }
            if ((lane & 31) == 31) { *(LAS f32x4*)(L + OFF_E + ch0 * 32) = (f32x4){e31[0], e31[1], e31[2], e31[3]}; *(LAS f32x4*)(L + OFF_E + ch0 * 32 + 16) = (f32x4){e31[4], e31[5], e31[6], e31[7]}; }
#pragma unroll
            for (int e = 0; e < 4; ++e) { oqp[e] = pk2(qp[2 * e], qp[2 * e + 1]); okp[e] = pk2(kp[2 * e], kp[2 * e + 1]); oqs[e] = pk2(qs[2 * e], qs[2 * e + 1]); okh[e] = pk2(kh[2 * e], kh[2 * e + 1]); }
            *(LAS v4u*)(L + OFF_QP + lrow) = oqp; *(LAS v4u*)(L + OFF_KP + lrow) = okp; *(LAS v4u*)(L + OFF_QS + lrow) = oqs; *(LAS v4u*)(L + OFF_KH + limg) = okh; *(LAS v4u*)(L + OFF_V + limg) = cv;
        }
        __syncthreads();
        if (wid < 3) { const int mi = wid >= 1 ? 1 : 0, ni = wid == 2 ? 1 : 0; f32x4 acc = {0.f, 0.f, 0.f, 0.f};
            const unsigned qa = OFF_QP + (mi * 16 + (lane & 15)) * TP + (lane >> 4) * 16, ka = OFF_KP + (ni * 16 + (lane & 15)) * TP + (lane >> 4) * 16;
#pragma unroll
            for (int ks = 0; ks < 4; ++ks) { const bf16x8 a = *(const LAS bf16x8*)(L + qa + ks * 64); const bf16x8 bfr = *(const LAS bf16x8*)(L + ka + ks * 64); acc = MFMA16(a, bfr, acc); }
            const int tq = 4 * (lane >> 4), sc = lane & 15;
#pragma unroll
            for (int r = 0; r < 4; ++r) { const float v = (mi != ni || tq + r >= sc) ? acc[r] : 0.f; *(LAS bf16*)(L + OFF_A + (mi * 16 + tq + r) * 80 + (ni * 16 + sc) * 2) = (bf16)f2bf(v); } }
        else if (wid == 3 && cidx == 0) { const int t = lane >> 2, s0 = 16 + 4 * (lane & 3); *(LAS v2u*)(L + OFF_A + t * 80 + s0 * 2) = (v2u){0u, 0u}; }
        __syncthreads();
        {
            const unsigned lbase = (unsigned)(uintptr_t)L, hi = lane >> 5, g4 = lane >> 4, q4 = (lane & 15) >> 2, p4 = lane & 3, blk = (lane >> 4) & 1;
            const int mk = wid >> 1, nv0 = 2 * (wid & 1);
            s16x4 v16[2], ka[2][2], vb[2][2][2];
#pragma unroll
            for (int t = 0; t < 2; ++t) { const unsigned row = 8 * g4 + 4 * t + q4; v16[t] = tr_off<0>(lbase + OFF_V + img_off(row, 2 * wid + (p4 >> 1)) + 8 * (p4 & 1)); }
#pragma unroll
            for (int t = 0; t < 2; ++t) { const unsigned row = 8 * hi + 4 * t + q4, sw = (q4 << 2) | ((2 * hi + t) & 3u), lo8 = 8 * (p4 & 1);
                const unsigned kb = lbase + OFF_KH + 256u * row + 16u * ((unsigned)(4 * mk + 2 * blk + (p4 >> 1)) ^ sw) + lo8;
                ka[0][t] = tr_off<0>(kb); ka[1][t] = tr_off<4096>(kb);
#pragma unroll
                for (int nvi = 0; nvi < 2; ++nvi) { const unsigned vbb = lbase + OFF_V + 256u * row + 16u * ((unsigned)(4 * (nv0 + nvi) + 2 * blk + (p4 >> 1)) ^ sw) + lo8;
                    vb[nvi][0][t] = tr_off<0>(vbb); vb[nvi][1][t] = tr_off<4096>(vbb); } }
            LDS_WAIT_PIN();
            const bf16x8 vfr = CAT8(v16[0], v16[1]);
            f32x4 accO[2];
            const unsigned aa = OFF_A + (lane & 15) * 80 + g4 * 16, qa = OFF_QS + (lane & 15) * TP + g4 * 16, sa = SBc + (16 * wid + (lane & 15)) * TP + g4 * 16;
#pragma unroll
            for (int mi = 0; mi < 2; ++mi) { accO[mi] = (f32x4){0.f, 0.f, 0.f, 0.f};
                const bf16x8 afr = *(const LAS bf16x8*)(L + aa + mi * 16 * 80);
                accO[mi] = MFMA16(afr, vfr, accO[mi]);
#pragma unroll
                for (int ks = 0; ks < 4; ++ks) { const bf16x8 qf = *(const LAS bf16x8*)(L + qa + mi * 16 * TP + ks * 64); const bf16x8 sf = *(const LAS bf16x8*)(L + sa + ks * 64); accO[mi] = MFMA16(qf, sf, accO[mi]); } }
            { bf16* ob = OUT + (size_t)ROWLO(cidx) * 2048 + h * 128 + 16 * wid; const int t0 = 4 * g4;
              const unsigned o0 = (unsigned)(((dir ? 31 - t0 : t0) * 2048 + (lane & 15)) * 2); const int sgn = dir ? -4096 : 4096;
#pragma unroll
              for (int mi = 0; mi < 2; ++mi)
#pragma unroll
                  for (int r = 0; r < 4; ++r) *(bf16*)((char*)ob + (o0 + (unsigned)(sgn * (16 * mi + r)))) = (bf16)f2bf(accO[mi][r]); }
            const unsigned sbw = SBn + (lane & 31) * TP + (32 * mk) * 2 + 8 * hi;
#pragma unroll
            for (int nvi = 0; nvi < 2; ++nvi) {
#pragma unroll
                for (int g = 0; g < 4; ++g) { const f32x4 ev = *(const LAS f32x4*)(L + OFF_E + (32 * mk + 8 * g + 4 * hi) * 4);
#pragma unroll
                    for (int j = 0; j < 4; ++j) accS[nvi][4 * g + j] *= ev[j]; }
#pragma unroll
                for (int ks = 0; ks < 2; ++ks) accS[nvi] = MFMA32(CAT8(ka[ks][0], ka[ks][1]), CAT8(vb[nvi][ks][0], vb[nvi][ks][1]), accS[nvi]);
#pragma unroll
                for (int g = 0; g < 4; ++g) { v2u w; w.x = pk2(accS[nvi][4 * g], accS[nvi][4 * g + 1]); w.y = pk2(accS[nvi][4 * g + 2], accS[nvi][4 * g + 3]);
                    *(LAS v2u*)(L + sbw + 32 * (nv0 + nvi) * TP + g * 16) = w; }
            }
        }
        __syncthreads();
    }
#undef HLOAD
#undef ROWLO
}
}
namespace rt {
constexpr int QP = 528, SBP = 528, PP = 144;
constexpr int OFF_Q = 0, OFF_K = OFF_Q + 64 * QP, OFF_V = OFF_K + 32768, OFF_P = OFF_V + 16384, OFF_SB = OFF_P + 64 * PP, LDS_END = OFF_SB + 128 * SBP;
static_assert(LDS_END <= MISC_OFF, "retention LDS map");
constexpr int NCH = 4 + 64;
template <int OFF> DI s16x4 tr_off(unsigned base) { s16x4 r; asm volatile("ds_read_b64_tr_b16 %0, %1 offset:%2" : "=&v"(r) : "v"(base), "i"(OFF) : "memory"); return r; }
DI void unit(Frame& F, int li, int b, int h, int dir, int vs) {
    const int tid = F.tid, wid = F.wave, lane0 = F.lane;
    const bf16* P = WSP(bf16, WS_P); bf16* OUT = dir ? WSP(bf16, WS_OBO) : WSP(bf16, WS_OFO);
    LAS unsigned char* L = F.lds;
    const float dl = F.ret_decay[((size_t)li * 2 + dir) * 16 + h];
    const float l2g = -log1pf(expf(-dl)) * 1.4426950408889634f;
    const float g64 = exp2f(64.0f * l2g);
    f32x16 accS[4];
#pragma unroll
    for (int i = 0; i < 4; ++i)
#pragma unroll
        for (int r = 0; r < 16; ++r) accS[i][r] = 0.f;
    const int qrow = tid >> 5, qc = tid & 31, vrow = tid >> 4, vc = tid & 15;
    unsigned gq[4], gv[2]; float vw[2];
#pragma unroll
    for (int i = 0; i < 4; ++i) { const int r = qrow + 16 * i; gq[i] = (unsigned)(((dir ? 63 - r : r) * O_END + qc * 8) * 2); }
#pragma unroll
    for (int i = 0; i < 2; ++i) { const int r = vrow + 32 * i; gv[i] = (unsigned)(((dir ? 63 - r : r) * O_END + vc * 8) * 2); vw[i] = exp2f((float)(63 - r) * l2g); }
    const unsigned lq = OFF_Q + qrow * QP + qc * 16, lk = OFF_K + (qc >> 4) * 16384 + img_off(qrow, qc & 15), lv = OFF_V + img_off(vrow, vc);
    v4u sq[4], sk[4], sv[2];
#define ROWLO(ci) ((ci) < 4 ? M_LAT + b * CTXL + (dir ? CTXL - 64 - (ci) * 64 : (ci) * 64) : b * SEQ + (dir ? SEQ - 64 - ((ci) - 4) * 64 : ((ci) - 4) * 64))
#define RLOAD(ci) do { const char* pb_ = (const char*)(P + (size_t)ROWLO(ci) * O_END + h * 256); const char* pv_ = (const char*)(P + (size_t)ROWLO(ci) * O_END + O_V + h * 512 + vs * 128); \
        _Pragma("unroll") for (int i = 0; i < 4; ++i) { sq[i] = *(const v4u*)(pb_ + gq[i]); sk[i] = *(const v4u*)(pb_ + O_K * 2 + gq[i]); } \
        _Pragma("unroll") for (int i = 0; i < 2; ++i) sv[i] = *(const v4u*)(pv_ + gv[i]); } while (0)
    RLOAD(0);
    const int nv = wid & 3, mk0 = 4 * (wid >> 2), mt = wid >> 2;
    if (tid < 256) { const int blk = tid >> 7, e = tid & 127, t = 32 * blk + (e >> 3), s0 = 32 * blk + 16 + 2 * (e & 7); *(LAS unsigned*)(L + OFF_P + t * PP + s0 * 2) = 0u; }
    for (int cidx = 0; cidx < NCH; ++cidx) {
        int lane = lane0; asm volatile("" : "+v"(lane));
        const int r32 = lane & 31, hi = lane >> 5;
#pragma unroll
        for (int i = 0; i < 4; ++i) { *(LAS v4u*)(L + lq + i * 16 * QP) = sq[i]; *(LAS v4u*)(L + lk + i * 4096) = sk[i]; }
#pragma unroll
        for (int i = 0; i < 2; ++i) { v4u o;
#pragma unroll
            for (int e = 0; e < 4; ++e) o[e] = pk2(bflo(sv[i][e]) * vw[i], bfhi(sv[i][e]) * vw[i]);
            *(LAS v4u*)(L + lv + i * 8192) = o; }
        __syncthreads();
        if (cidx + 1 < NCH) RLOAD(cidx + 1);
        {
#pragma unroll
            for (int rep = 0; rep < 2; ++rep) { const int tl = wid + 8 * rep;
                if (tl < 10) { const int mi = tl >= 6 ? 3 : (tl >= 3 ? 2 : (tl >= 1 ? 1 : 0)), ni = tl - (mi * (mi + 1)) / 2; f32x4 acc = {0.f, 0.f, 0.f, 0.f};
                    const unsigned qa = OFF_Q + (mi * 16 + (lane & 15)) * QP + (lane >> 4) * 16;
                    const unsigned krow = ni * 16 + (lane & 15), ksw = ((krow & 3u) << 2) | ((krow >> 2) & 3u), kb = OFF_K + 256u * krow;
#pragma unroll
                    for (int ks = 0; ks < 8; ++ks) { const bf16x8 a = *(const LAS bf16x8*)(L + qa + ks * 64);
                        const bf16x8 bfr = *(const LAS bf16x8*)(L + kb + (ks >> 2) * 16384 + 16u * ((unsigned)(4 * (ks & 3) + (lane >> 4)) ^ ksw)); acc = MFMA16(a, bfr, acc); }
                    const int tq = 4 * (lane >> 4), sc = lane & 15;
#pragma unroll
                    for (int r = 0; r < 4; ++r) { const float v = (mi != ni || tq + r >= sc) ? acc[r] : 0.f;
                        *(LAS bf16*)(L + OFF_P + (mi * 16 + tq + r) * PP + (ni * 16 + sc) * 2) = (bf16)f2bf(v); } } }
            const unsigned sbw = OFF_SB + (32 * nv + r32) * SBP + 8 * hi;
#pragma unroll
            for (int i = 0; i < 4; ++i) {
#pragma unroll
                for (int r = 0; r < 16; ++r) accS[i][r] *= g64;
#pragma unroll
                for (int g = 0; g < 4; ++g) { v2u w; w.x = pk2(accS[i][4 * g], accS[i][4 * g + 1]); w.y = pk2(accS[i][4 * g + 2], accS[i][4 * g + 3]);
                    *(LAS v2u*)(L + sbw + (mk0 + i) * 64 + g * 16) = w; } } }
        __syncthreads();
        {
            const unsigned lbase = (unsigned)(uintptr_t)L;
            const unsigned q4 = (lane & 15) >> 2, p4 = lane & 3, blk = (lane >> 4) & 1;
            unsigned vbase[2], kbase[4][2];
#pragma unroll
            for (int t = 0; t < 2; ++t) { const unsigned row = 8 * hi + 4 * t + q4, sw = (q4 << 2) | ((2 * hi + t) & 3u);
                vbase[t] = lbase + OFF_V + 256u * row + 16u * ((unsigned)(4 * nv + 2 * blk + (p4 >> 1)) ^ sw) + 8 * (p4 & 1);
#pragma unroll
                for (int c = 0; c < 4; ++c) kbase[c][t] = lbase + OFF_K + (mk0 >> 2) * 16384 + 256u * row + 16u * ((unsigned)(4 * c + 2 * blk + (p4 >> 1)) ^ sw) + 8 * (p4 & 1); }
            s16x4 vf[4][2];
            vf[0][0] = tr_off<0>(vbase[0]); vf[0][1] = tr_off<0>(vbase[1]); vf[1][0] = tr_off<4096>(vbase[0]); vf[1][1] = tr_off<4096>(vbase[1]);
            vf[2][0] = tr_off<8192>(vbase[0]); vf[2][1] = tr_off<8192>(vbase[1]); vf[3][0] = tr_off<12288>(vbase[0]); vf[3][1] = tr_off<12288>(vbase[1]);
            LDS_WAIT_PIN();
            f32x16 accO, accO2;
#pragma unroll
            for (int r = 0; r < 16; ++r) { accO[r] = 0.f; accO2[r] = 0.f; }
            const unsigned pa = OFF_P + (32 * mt + r32) * PP + 16 * hi, qa = OFF_Q + (32 * mt + r32) * QP + 16 * hi, sa = OFF_SB + (32 * nv + r32) * SBP + 16 * hi;
#pragma unroll
            for (int ks = 0; ks < 4; ++ks) { if (ks < 2 || mt == 1) { const bf16x8 pf = *(const LAS bf16x8*)(L + pa + ks * 32); accO = MFMA32(pf, CAT8(vf[ks][0], vf[ks][1]), accO); } }
#pragma unroll
            for (int kg = 0; kg < 4; ++kg) {
#pragma unroll
                for (int kk = 0; kk < 4; ++kk) { const int ks = 4 * kg + kk;
                    const bf16x8 qf = *(const LAS bf16x8*)(L + qa + ks * 32); const bf16x8 sf = *(const LAS bf16x8*)(L + sa + ks * 32);
                    if (kk & 1) accO2 = MFMA32(qf, sf, accO2); else accO = MFMA32(qf, sf, accO); }
                asm volatile("" ::: "memory"); }
#pragma unroll
            for (int r = 0; r < 16; ++r) accO[r] += accO2[r];
            { bf16* ob = OUT + (size_t)ROWLO(cidx) * 8192 + h * 512 + vs * 128 + 32 * nv;
              const int tl0 = 32 * mt + 4 * hi; const unsigned o0 = (unsigned)(((dir ? 63 - tl0 : tl0) * 8192 + r32) * 2); const int sgn = dir ? -16384 : 16384;
#pragma unroll
              for (int r = 0; r < 16; ++r) *(bf16*)((char*)ob + (o0 + (unsigned)(sgn * ((r & 3) + 8 * (r >> 2))))) = (bf16)f2bf(accO[r]); }
            s16x4 kfa[4][2], kfb[4][2];
#define KTR(dst, i_) do { dst[0][0] = tr_off<0>(kbase[i_][0]); dst[0][1] = tr_off<0>(kbase[i_][1]); dst[1][0] = tr_off<4096>(kbase[i_][0]); dst[1][1] = tr_off<4096>(kbase[i_][1]); \
                dst[2][0] = tr_off<8192>(kbase[i_][0]); dst[2][1] = tr_off<8192>(kbase[i_][1]); dst[3][0] = tr_off<12288>(kbase[i_][0]); dst[3][1] = tr_off<12288>(kbase[i_][1]); } while (0)
#define KMM(src, i_) do { _Pragma("unroll") for (int ks = 0; ks < 4; ++ks) accS[i_] = MFMA32(CAT8(src[ks][0], src[ks][1]), CAT8(vf[ks][0], vf[ks][1]), accS[i_]); } while (0)
            KTR(kfa, 0); KTR(kfb, 1);
            asm volatile("s_waitcnt lgkmcnt(8)" ::: "memory"); __builtin_amdgcn_sched_barrier(0);
            KMM(kfa, 0); __builtin_amdgcn_sched_barrier(0);
            KTR(kfa, 2);
            asm volatile("s_waitcnt lgkmcnt(8)" ::: "memory"); __builtin_amdgcn_sched_barrier(0);
            KMM(kfb, 1); __builtin_amdgcn_sched_barrier(0);
            KTR(kfb, 3);
            asm volatile("s_waitcnt lgkmcnt(8)" ::: "memory"); __builtin_amdgcn_sched_barrier(0);
            KMM(kfa, 2); __builtin_amdgcn_sched_barrier(0);
            LDS_WAIT_PIN();
            KMM(kfb, 3);
#undef KTR
#undef KMM
        }
        __syncthreads();
    }
#undef RLOAD
#undef ROWLO
}
}
#ifndef MK_MULTI
#define MK_MULTI 0
#endif
constexpr int N_PHASES = 2 + 2 * 12;
struct Args { const float* in[20]; float* out; unsigned char* ws; int ph_lo, ph_hi; };
__global__ void __launch_bounds__(NWAVES * 64, 2) fwd_kernel(Args args) {
    extern __shared__ __attribute__((aligned(16))) unsigned char lds_raw[];
    Frame F0;
    F0.lds = (LAS unsigned char*)lds_raw;
    F0.tid = threadIdx.x; F0.lane = F0.tid & 63; F0.wave = __builtin_amdgcn_readfirstlane(F0.tid >> 6);
    F0.G = gridDim.x; { const int bx = blockIdx.x; F0.vcu = (F0.G % 8 == 0) ? (bx % 8) * (F0.G / 8) + bx / 8 : bx; }
    F0.ws = args.ws; F0.out = args.out;
    LAS unsigned* MISC = (LAS unsigned*)(F0.lds + MISC_OFF);
    if (F0.tid < 16) MISC[F0.tid] = 0u;
    if (F0.tid < 20) { const unsigned long long pv = (unsigned long long)(uintptr_t)args.in[F0.tid]; MISC[16 + 2 * F0.tid] = (unsigned)pv; MISC[17 + 2 * F0.tid] = (unsigned)(pv >> 32); }
    __syncthreads();
    unsigned* ctl = (unsigned*)(F0.ws + WS_CTL);
    if (!MK_MULTI) (void)xcd_barrier_post(ctl + CW_BAR, (volatile LAS unsigned*)(MISC + 8));
#define GRID_BAR() do { XcdBarrier b_; b_.bar = (unsigned*)(F0.ws + WS_CTL) + CW_BAR; b_.x = xb_xcc_id(); b_.st = (volatile LAS unsigned*)(F0.lds + MISC_OFF + 32); xcd_barrier(b_); } while (0)
    const int lo = args.ph_lo, hi = args.ph_hi;
    int ph = 0;
#ifndef PHASE_MASK
#define PHASE_MASK 0xFFFFFFFFu
#endif
#ifndef RT_REPS
#define RT_REPS 1
#endif
#ifndef REP_MASK
#define REP_MASK 0u
#endif
#define PH_BEGIN(kind) if ((((PHASE_MASK) >> (kind)) & 1u) && lo <= ph && ph < hi) for (int rep_ = 0; rep_ < ((((REP_MASK) >> (kind)) & 1u) ? 2 : 1); ++rep_) { if (rep_) __syncthreads(); Frame F = F0; { int t_ = F0.tid; asm volatile("" : "+v"(t_)); F.tid = t_; F.lane = t_ & 63; F.wave = __builtin_amdgcn_readfirstlane(t_ >> 6); } LOADPTRS(F);
#define PH_END   } if (!MK_MULTI && lo <= ph && ph + 1 < hi) GRID_BAR(); ++ph;
#define PH_END_NOBAR }

    PH_BEGIN(0) ph_prologue(F); PH_END
    PH_BEGIN(1) ph_finalize(F); PH_END
    bf16* XS = (bf16*)(F0.ws + WS_XS);
    { constexpr int L2 = 0;
        { const int l = 2 * L2, i = L2;
          const bool first = (L2 == 0);
          PH_BEGIN(2) ph_ada_in(F, l, first ? (const void*)F.x : (const void*)XS, first, first ? (const void*)F.ctx : (const void*)(XS + (size_t)M_LAT * DM), first); PH_END
          PH_BEGIN(3) { { pg8::Gemm g{WSP(pg8::bf16_t, WS_H), WSP(pg8::bf16_t, WS_WINE) + (size_t)i * E_PAD * DM, MT, E_PAD, DM}; pg8::EvenInOrder S; S.init(F.G, (int)blockIdx.x);
                       pg8::EpiBf16 E{WSP(pg8::bf16_t, WS_P), E_PAD}; pg8::gemm_phase<pg8::EpiBf16, pg8::EvenInOrder, PG8_ALIGN, PG8_SP2>(F.lds, g, S, E); }
                     __syncthreads();
                     { pg8::Gemm g{WSP(pg8::bf16_t, WS_H) + (size_t)M_LAT * DM, WSP(pg8::bf16_t, WS_WINE) + ((size_t)i * E_PAD + 48 * 256) * DM, M_CTX, 9 * 256, DM / 4, DM}; pg8::CtxSplitOrder S; S.init(F.G, (int)blockIdx.x, DM, 144);
                       pg8::EpiPart E{WSP(float, WS_PART), DM}; pg8::gemm_phase<pg8::EpiPart, pg8::CtxSplitOrder, PG8_ALIGN, PG8_SP2>(F.lds, g, S, E); } } PH_END
          PH_BEGIN(4) { ph_tail_fold(F); ph_lora_norm(F, i); } PH_END
          PH_BEGIN(5) { { pg8::Gemm g{WSP(pg8::bf16_t, WS_CQN), WSP(pg8::bf16_t, WS_WUQ) + (size_t)i * NQ * Q_LORA, MT, NQ, Q_LORA}; pg8::StaticOrder S; S.init(MT, NQ, F.G, (int)blockIdx.x);
                       pg8::EpiBf16 E{WSP(pg8::bf16_t, WS_QF), NQ}; pg8::gemm_phase<pg8::EpiBf16, pg8::StaticOrder, PG8_ALIGN, PG8_SP2>(F.lds, g, S, E); } __syncthreads(); } PH_END_NOBAR
          PH_BEGIN(16) { { pg8::Gemm g{WSP(pg8::bf16_t, WS_CKVN), WSP(pg8::bf16_t, WS_WUKV) + (size_t)i * NKV * KV_LORA, MT, NKV, KV_LORA}; pg8::UkvOrder S; S.init(MT, NKV, F.G, (int)blockIdx.x);
                       pg8::EpiBf16 E{WSP(pg8::bf16_t, WS_KV), NKV}; pg8::gemm_phase<pg8::EpiBf16, pg8::UkvOrder, PG8_ALIGN, PG8_SP2>(F.lds, g, S, E); } } PH_END
          PH_BEGIN(6) ph_qk_norm_rope(F, i); PH_END
          PH_BEGIN(17) { unsigned* hctr = (unsigned*)(F.ws + WS_CTL) + CW_QUEUE + 256 + 64 * L2;
                         for (int s = 0; s < 128; ++s) if ((64 + s) % F.G == F.vcu) { hg::unit(F, i, s >> 5, (s >> 1) & 15, s & 1);
                             asm volatile("s_waitcnt vmcnt(0)" ::: "memory"); __syncthreads();
                             if (F.tid == 0) { __builtin_amdgcn_fence(__ATOMIC_RELEASE, "agent"); asm volatile("s_waitcnt vmcnt(0)" ::: "memory"); (void)xb_add(hctr, 1u); } } } PH_END_NOBAR
#if defined(CLK_PROBE) && defined(CLK_SITE_ATT)
          long long clkA_ = 0, rtA_ = 0; if (L2 == 0 && lo <= ph && ph < hi) { clkA_ = clock64(); rtA_ = wall_clock64(); }
#endif
          PH_BEGIN(7) {
#ifndef NO_ATT
              {
                  unsigned* qctr = (unsigned*)(F.ws + WS_CTL) + CW_QUEUE + 64 * L2; unsigned* cctr = qctr + 128;
                  LAS unsigned* qslot = (LAS unsigned*)(F.lds + MISC_OFF) + 14;
                  constexpr int CONV_LIST = 1 + L2, CONV_LEN = CONV_LIST_LEN[CONV_LIST], CONV_BATCH = 256, CONV_NW = (CONV_LEN + CONV_BATCH - 1) / CONV_BATCH, CONV_NB = CONV_NW + (L2 == 0 ? ADALN_NB : 0);
                  constexpr int HGM_ROWS = 64, BG_NB = CONV_NB + MT / HGM_ROWS;
                  unsigned* hctr = qctr + 256; bool hg_ok = false;
                  int cb = 0;
                  for (;;) {
                      if (F.tid == 0) *qslot = __hip_atomic_fetch_add(qctr, 1u, __ATOMIC_RELAXED, __HIP_MEMORY_SCOPE_AGENT);
                      __syncthreads();
                      const int u = __builtin_amdgcn_readfirstlane((int)*qslot);
                      __syncthreads();
                      Frame Fu = F; { int t_ = F.tid; asm volatile("" : "+v"(t_)); Fu.tid = t_; Fu.lane = t_ & 63; Fu.wave = __builtin_amdgcn_readfirstlane(t_ >> 6); }
                      if (u < 1024) { const int b = u >> 8, h = (u >> 4) & 15, qb = u & 15; att::unit(Fu, h, b * SEQ + qb * 256, b * SEQ, 64, M_LAT + b * CTXL, 68, E_PAD); }
                      else if (u < 1088) { const int v = u - 1024, b = v >> 4, h = v & 15; att::unit(Fu, h, M_LAT + b * CTXL, 0, 0, M_LAT + b * CTXL, 4, E_PAD); }
                      if (cb < BG_NB) {
                          if (F.tid == 0) qslot[1] = __hip_atomic_fetch_add(cctr, 1u, __ATOMIC_RELAXED, __HIP_MEMORY_SCOPE_AGENT);
                          __syncthreads();
                          cb = __builtin_amdgcn_readfirstlane((int)qslot[1]);
                          __syncthreads();
                          if (cb >= CONV_NB && cb < BG_NB) {
                              if (!hg_ok) { if (F.tid == 0) { unsigned sp = 0u; while (xb_ld(hctr) < 128u && ++sp < (1u << 22)) __builtin_amdgcn_s_sleep(8);
                                                __builtin_amdgcn_fence(__ATOMIC_ACQUIRE, "agent"); asm volatile("s_waitcnt vmcnt(0)" ::: "memory"); }
                                            __syncthreads(); hg_ok = true; }
                              Frame Fc = F; { int t_ = F.tid; asm volatile("" : "+v"(t_)); Fc.tid = t_; Fc.lane = t_ & 63; Fc.wave = __builtin_amdgcn_readfirstlane(t_ >> 6); }
                              const int r0 = (cb - CONV_NB) * HGM_ROWS; hg_merge_rows(Fc, i, r0 + Fc.wave, r0 + HGM_ROWS, NWAVES); }
                          else if (cb < CONV_NB) { const int e0 = cb * CONV_BATCH, e1 = e0 + CONV_BATCH < CONV_LEN ? e0 + CONV_BATCH : CONV_LEN; Frame Fc = F; { int t_ = F.tid; asm volatile("" : "+v"(t_)); Fc.tid = t_; Fc.lane = t_ & 63; Fc.wave = __builtin_amdgcn_readfirstlane(t_ >> 6); }
                              if (cb < CONV_NW) { conv_items(Fc, CONV_LIST, e0 + Fc.wave, e1, NWAVES); __syncthreads(); } else adaln_batch(Fc, cb - CONV_NW); } }
                      if (u >= 1088 && cb >= BG_NB) break; } }
#endif
#if defined(CLK_PROBE) && defined(CLK_SITE_ATT)
              if (L2 == 0 && blockIdx.x == CLK_PROBE && F.tid == 0) { const long long dc = clock64() - clkA_, dr = wall_clock64() - rtA_; ((LAS unsigned*)(F0.lds + MISC_OFF))[12] = (unsigned)((dc * 10000) / (dr > 0 ? dr : 1)); }
#endif
              } PH_END
          PH_BEGIN(9) { { pg8::Gemm g{WSP(pg8::bf16_t, WS_A), WSP(pg8::bf16_t, WS_WOE) + (size_t)i * DM * DM, M_LAT, DM, DM, 0}; pg8::StaticOrder S; S.init(M_LAT, DM, F.G, (int)blockIdx.x);
                       if constexpr (L2 == 0) { pg8::EpiResT<false, true> E{F.x, XS, WSP(float, WS_MOD) + (size_t)l * 5 * MODW + 2 * DM}; pg8::gemm_phase<pg8::EpiResT<false, true>, pg8::StaticOrder, PG8_ALIGN, PG8_SP2>(F.lds, g, S, E); }
                       else { pg8::EpiResT<true, true> E{XS, XS, WSP(float, WS_MOD) + (size_t)l * 5 * MODW + 2 * DM}; pg8::gemm_phase<pg8::EpiResT<true, true>, pg8::StaticOrder, PG8_ALIGN, PG8_SP2>(F.lds, g, S, E); } }
                     __syncthreads();
                     { pg8::Gemm g{WSP(pg8::bf16_t, WS_A) + (size_t)M_LAT * DM, WSP(pg8::bf16_t, WS_WOE) + (size_t)i * DM * DM, M_CTX, DM, DM / 4, DM}; pg8::CtxSplitOrder S; S.init(F.G, (int)blockIdx.x, DM);
                       pg8::EpiPart E{WSP(float, WS_PART), DM}; pg8::gemm_phase<pg8::EpiPart, pg8::CtxSplitOrder, PG8_ALIGN, PG8_SP2>(F.lds, g, S, E); }
                     if constexpr (L2 == 0) { __syncthreads(); ph_finalize_mod(F, 1, 4); } } PH_END
        }
        { const int l = 2 * L2 + 1, i = L2; const bool last = (L2 == 1);
          PH_BEGIN(10) ph_ada_in(F, l, XS, false, L2 == 0 ? (const void*)F.ctx : (const void*)(XS + (size_t)M_LAT * DM), L2 == 0); PH_END
#ifdef CLK_PROBE
          long long clk0_ = 0, rt0_ = 0; if (L2 == 0 && lo <= ph && ph < hi) { clk0_ = clock64(); rt0_ = wall_clock64(); }
#endif
          PH_BEGIN(11) { pg8::Gemm g{WSP(pg8::bf16_t, WS_H), WSP(pg8::bf16_t, WS_WINO) + (size_t)i * O_END * DM, MT, O_END, DM}; pg8::EpiBf16Rope E{WSP(pg8::bf16_t, WS_P), O_END, WSP(float, WS_COS), WSP(float, WS_SIN)};
                     if constexpr (L2 == 1) { pg8::LastOddOrder S; S.init(F.G, (int)blockIdx.x); pg8::gemm_phase<pg8::EpiBf16Rope, pg8::LastOddOrder, PG8_ALIGN, PG8_SP2>(F.lds, g, S, E); }
                     else { { pg8::OddInOrder S; S.init(F.G, (int)blockIdx.x); pg8::gemm_phase<pg8::EpiBf16Rope, pg8::OddInOrder, PG8_ALIGN, PG8_SP2>(F.lds, g, S, E); }
                            __syncthreads();
                            pg8::Gemm g2{WSP(pg8::bf16_t, WS_H) + (size_t)M_LAT * DM, WSP(pg8::bf16_t, WS_WINO) + ((size_t)i * O_END + O_G) * DM, M_CTX, 8192, DM / 2, DM}; pg8::CtxSplitOrder S2; S2.init(F.G, (int)blockIdx.x, DM, 256, 2);
                            pg8::EpiPart E2{WSP(float, WS_PART), 8192}; pg8::gemm_phase<pg8::EpiPart, pg8::CtxSplitOrder, PG8_ALIGN, PG8_SP2>(F.lds, g2, S2, E2); } }
#if defined(CLK_PROBE) && !defined(CLK_SITE_ATT)
          if (L2 == 0 && blockIdx.x == CLK_PROBE && F.tid == 0) { const long long dc = clock64() - clk0_, dr = wall_clock64() - rt0_; ((LAS unsigned*)(F0.lds + MISC_OFF))[12] = (unsigned)((dc * 10000) / (dr > 0 ? dr : 1)); }
#endif
          PH_END
          PH_BEGIN(13) { for (int u0 = F.vcu; u0 < 512 * RT_REPS; u0 += F.G) { const int u = u0 & 511; rt::unit(F, i, u >> 7, (u >> 3) & 15, (u >> 2) & 1, u & 3); __syncthreads(); } } PH_END
          PH_BEGIN(14) ph_ret_merge(F, i, L2 == 0); PH_END
          PH_BEGIN(15) { { pg8::Gemm g{WSP(pg8::bf16_t, WS_A), WSP(pg8::bf16_t, WS_WOO) + (size_t)i * DM * 8192, M_LAT, DM, 8192, 0}; pg8::StaticOrder S; S.init(M_LAT, DM, F.G, (int)blockIdx.x);
                       if constexpr (L2 == 1) { pg8::EpiResT<true, false> E{XS, F.out, WSP(float, WS_MOD) + (size_t)l * 5 * MODW + 2 * DM}; pg8::gemm_phase<pg8::EpiResT<true, false>, pg8::StaticOrder, PG8_ALIGN, PG8_SP2>(F.lds, g, S, E); }
                       else { pg8::EpiResT<true, true> E{XS, XS, WSP(float, WS_MOD) + (size_t)l * 5 * MODW + 2 * DM}; pg8::gemm_phase<pg8::EpiResT<true, true>, pg8::StaticOrder, PG8_ALIGN, PG8_SP2>(F.lds, g, S, E); } }
                     if constexpr (L2 == 0) { __syncthreads();
                       pg8::Gemm g{WSP(pg8::bf16_t, WS_A) + (size_t)M_LAT * 8192, WSP(pg8::bf16_t, WS_WOO) + (size_t)i * DM * 8192, M_CTX, DM, 8192 / 4, 8192}; pg8::CtxSplitOrder S; S.init(F.G, (int)blockIdx.x, 8192);
                       pg8::EpiPart E{WSP(float, WS_PART), DM}; pg8::gemm_phase<pg8::EpiPart, pg8::CtxSplitOrder, PG8_ALIGN, PG8_SP2>(F.lds, g, S, E); } } PH_END
        }
    }
    { constexpr int L2 = 1;
        { const int l = 2 * L2, i = L2;
          const bool first = (L2 == 0);
          PH_BEGIN(2) ph_ada_in(F, l, first ? (const void*)F.x : (const void*)XS, first, first ? (const void*)F.ctx : (const void*)(XS + (size_t)M_LAT * DM), first); PH_END
          PH_BEGIN(3) { { pg8::Gemm g{WSP(pg8::bf16_t, WS_H), WSP(pg8::bf16_t, WS_WINE) + (size_t)i * E_PAD * DM, MT, E_PAD, DM}; pg8::EvenInOrder S; S.init(F.G, (int)blockIdx.x);
                       pg8::EpiBf16 E{WSP(pg8::bf16_t, WS_P), E_PAD}; pg8::gemm_phase<pg8::EpiBf16, pg8::EvenInOrder, PG8_ALIGN, PG8_SP2>(F.lds, g, S, E); }
                     __syncthreads();
                     { pg8::Gemm g{WSP(pg8::bf16_t, WS_H) + (size_t)M_LAT * DM, WSP(pg8::bf16_t, WS_WINE) + ((size_t)i * E_PAD + 48 * 256) * DM, M_CTX, 9 * 256, DM / 4, DM}; pg8::CtxSplitOrder S; S.init(F.G, (int)blockIdx.x, DM, 144);
                       pg8::EpiPart E{WSP(float, WS_PART), DM}; pg8::gemm_phase<pg8::EpiPart, pg8::CtxSplitOrder, PG8_ALIGN, PG8_SP2>(F.lds, g, S, E); } } PH_END
          PH_BEGIN(4) { ph_tail_fold(F); ph_lora_norm(F, i); } PH_END
          PH_BEGIN(5) { { pg8::Gemm g{WSP(pg8::bf16_t, WS_CQN), WSP(pg8::bf16_t, WS_WUQ) + (size_t)i * NQ * Q_LORA, MT, NQ, Q_LORA}; pg8::StaticOrder S; S.init(MT, NQ, F.G, (int)blockIdx.x);
                       pg8::EpiBf16 E{WSP(pg8::bf16_t, WS_QF), NQ}; pg8::gemm_phase<pg8::EpiBf16, pg8::StaticOrder, PG8_ALIGN, PG8_SP2>(F.lds, g, S, E); } __syncthreads(); } PH_END_NOBAR
          PH_BEGIN(16) { { pg8::Gemm g{WSP(pg8::bf16_t, WS_CKVN), WSP(pg8::bf16_t, WS_WUKV) + (size_t)i * NKV * KV_LORA, MT, NKV, KV_LORA}; pg8::UkvOrder S; S.init(MT, NKV, F.G, (int)blockIdx.x);
                       pg8::EpiBf16 E{WSP(pg8::bf16_t, WS_KV), NKV}; pg8::gemm_phase<pg8::EpiBf16, pg8::UkvOrder, PG8_ALIGN, PG8_SP2>(F.lds, g, S, E); } } PH_END
          PH_BEGIN(6) ph_qk_norm_rope(F, i); PH_END
          PH_BEGIN(17) { unsigned* hctr = (unsigned*)(F.ws + WS_CTL) + CW_QUEUE + 256 + 64 * L2;
                         for (int s = 0; s < 128; ++s) if ((64 + s) % F.G == F.vcu) { hg::unit(F, i, s >> 5, (s >> 1) & 15, s & 1);
                             asm volatile("s_waitcnt vmcnt(0)" ::: "memory"); __syncthreads();
                             if (F.tid == 0) { __builtin_amdgcn_fence(__ATOMIC_RELEASE, "agent"); asm volatile("s_waitcnt vmcnt(0)" ::: "memory"); (void)xb_add(hctr, 1u); } } } PH_END_NOBAR
#if defined(CLK_PROBE) && defined(CLK_SITE_ATT)
          long long clkA_ = 0, rtA_ = 0; if (L2 == 0 && lo <= ph && ph < hi) { clkA_ = clock64(); rtA_ = wall_clock64(); }
#endif
          PH_BEGIN(7) {
#ifndef NO_ATT
              {
                  unsigned* qctr = (unsigned*)(F.ws + WS_CTL) + CW_QUEUE + 64 * L2; unsigned* cctr = qctr + 128;
                  LAS unsigned* qslot = (LAS unsigned*)(F.lds + MISC_OFF) + 14;
                  constexpr int CONV_LIST = 1 + L2, CONV_LEN = CONV_LIST_LEN[CONV_LIST], CONV_BATCH = 256, CONV_NW = (CONV_LEN + CONV_BATCH - 1) / CONV_BATCH, CONV_NB = CONV_NW + (L2 == 0 ? ADALN_NB : 0);
                  constexpr int HGM_ROWS = 64, BG_NB = CONV_NB + MT / HGM_ROWS;
                  unsigned* hctr = qctr + 256; bool hg_ok = false;
                  int cb = 0;
                  for (;;) {
                      if (F.tid == 0) *qslot = __hip_atomic_fetch_add(qctr, 1u, __ATOMIC_RELAXED, __HIP_MEMORY_SCOPE_AGENT);
                      __syncthreads();
                      const int u = __builtin_amdgcn_readfirstlane((int)*qslot);
                      __syncthreads();
                      Frame Fu = F; { int t_ = F.tid; asm volatile("" : "+v"(t_)); Fu.tid = t_; Fu.lane = t_ & 63; Fu.wave = __builtin_amdgcn_readfirstlane(t_ >> 6); }
                      if (u < 1024) { const int b = u >> 8, h = (u >> 4) & 15, qb = u & 15; att::unit(Fu, h, b * SEQ + qb * 256, b * SEQ, 64, M_LAT + b * CTXL, 68, E_PAD); }
                      else if (u < 1088) { const int v = u - 1024, b = v >> 4, h = v & 15; att::unit(Fu, h, M_LAT + b * CTXL, 0, 0, M_LAT + b * CTXL, 4, E_PAD); }
                      if (cb < BG_NB) {
                          if (F.tid == 0) qslot[1] = __hip_atomic_fetch_add(cctr, 1u, __ATOMIC_RELAXED, __HIP_MEMORY_SCOPE_AGENT);
                          __syncthreads();
                          cb = __builtin_amdgcn_readfirstlane((int)qslot[1]);
                          __syncthreads();
                          if (cb >= CONV_NB && cb < BG_NB) {
                              if (!hg_ok) { if (F.tid == 0) { unsigned sp = 0u; while (xb_ld(hctr) < 128u && ++sp < (1u << 22)) __builtin_amdgcn_s_sleep(8);
                                                __builtin_amdgcn_fence(__ATOMIC_ACQUIRE, "agent"); asm volatile("s_waitcnt vmcnt(0)" ::: "memory"); }
                                            __syncthreads(); hg_ok = true; }
                              Frame Fc = F; { int t_ = F.tid; asm volatile("" : "+v"(t_)); Fc.tid = t_; Fc.lane = t_ & 63; Fc.wave = __builtin_amdgcn_readfirstlane(t_ >> 6); }
                              const int r0 = (cb - CONV_NB) * HGM_ROWS; hg_merge_rows(Fc, i, r0 + Fc.wave, r0 + HGM_ROWS, NWAVES); }
                          else if (cb < CONV_NB) { const int e0 = cb * CONV_BATCH, e1 = e0 + CONV_BATCH < CONV_LEN ? e0 + CONV_BATCH : CONV_LEN; Frame Fc = F; { int t_ = F.tid; asm volatile("" : "+v"(t_)); Fc.tid = t_; Fc.lane = t_ & 63; Fc.wave = __builtin_amdgcn_readfirstlane(t_ >> 6); }
                              if (cb < CONV_NW) { conv_items(Fc, CONV_LIST, e0 + Fc.wave, e1, NWAVES); __syncthreads(); } else adaln_batch(Fc, cb - CONV_NW); } }
                      if (u >= 1088 && cb >= BG_NB) break; } }
#endif
#if defined(CLK_PROBE) && defined(CLK_SITE_ATT)
              if (L2 == 0 && blockIdx.x == CLK_PROBE && F.tid == 0) { const long long dc = clock64() - clkA_, dr = wall_clock64() - rtA_; ((LAS unsigned*)(F0.lds + MISC_OFF))[12] = (unsigned)((dc * 10000) / (dr > 0 ? dr : 1)); }
#endif
              } PH_END
          PH_BEGIN(9) { { pg8::Gemm g{WSP(pg8::bf16_t, WS_A), WSP(pg8::bf16_t, WS_WOE) + (size_t)i * DM * DM, M_LAT, DM, DM, 0}; pg8::StaticOrder S; S.init(M_LAT, DM, F.G, (int)blockIdx.x);
                       if constexpr (L2 == 0) { pg8::EpiResT<false, true> E{F.x, XS, WSP(float, WS_MOD) + (size_t)l * 5 * MODW + 2 * DM}; pg8::gemm_phase<pg8::EpiResT<false, true>, pg8::StaticOrder, PG8_ALIGN, PG8_SP2>(F.lds, g, S, E); }
                       else { pg8::EpiResT<true, true> E{XS, XS, WSP(float, WS_MOD) + (size_t)l * 5 * MODW + 2 * DM}; pg8::gemm_phase<pg8::EpiResT<true, true>, pg8::StaticOrder, PG8_ALIGN, PG8_SP2>(F.lds, g, S, E); } }
                     __syncthreads();
                     { pg8::Gemm g{WSP(pg8::bf16_t, WS_A) + (size_t)M_LAT * DM, WSP(pg8::bf16_t, WS_WOE) + (size_t)i * DM * DM, M_CTX, DM, DM / 4, DM}; pg8::CtxSplitOrder S; S.init(F.G, (int)blockIdx.x, DM);
                       pg8::EpiPart E{WSP(float, WS_PART), DM}; pg8::gemm_phase<pg8::EpiPart, pg8::CtxSplitOrder, PG8_ALIGN, PG8_SP2>(F.lds, g, S, E); }
                     if constexpr (L2 == 0) { __syncthreads(); ph_finalize_mod(F, 1, 4); } } PH_END
        }
        { const int l = 2 * L2 + 1, i = L2; const bool last = (L2 == 1);
          PH_BEGIN(10) ph_ada_in(F, l, XS, false, L2 == 0 ? (const void*)F.ctx : (const void*)(XS + (size_t)M_LAT * DM), L2 == 0); PH_END
#ifdef CLK_PROBE
          long long clk0_ = 0, rt0_ = 0; if (L2 == 0 && lo <= ph && ph < hi) { clk0_ = clock64(); rt0_ = wall_clock64(); }
#endif
          PH_BEGIN(11) { pg8::Gemm g{WSP(pg8::bf16_t, WS_H), WSP(pg8::bf16_t, WS_WINO) + (size_t)i * O_END * DM, MT, O_END, DM}; pg8::EpiBf16Rope E{WSP(pg8::bf16_t, WS_P), O_END, WSP(float, WS_COS), WSP(float, WS_SIN)};
                     if constexpr (L2 == 1) { pg8::LastOddOrder S; S.init(F.G, (int)blockIdx.x); pg8::gemm_phase<pg8::EpiBf16Rope, pg8::LastOddOrder, PG8_ALIGN, PG8_SP2>(F.lds, g, S, E); }
                     else { { pg8::OddInOrder S; S.init(F.G, (int)blockIdx.x); pg8::gemm_phase<pg8::EpiBf16Rope, pg8::OddInOrder, PG8_ALIGN, PG8_SP2>(F.lds, g, S, E); }
                            __syncthreads();
                            pg8::Gemm g2{WSP(pg8::bf16_t, WS_H) + (size_t)M_LAT * DM, WSP(pg8::bf16_t, WS_WINO) + ((size_t)i * O_END + O_G) * DM, M_CTX, 8192, DM / 2, DM}; pg8::CtxSplitOrder S2; S2.init(F.G, (int)blockIdx.x, DM, 256, 2);
                            pg8::EpiPart E2{WSP(float, WS_PART), 8192}; pg8::gemm_phase<pg8::EpiPart, pg8::CtxSplitOrder, PG8_ALIGN, PG8_SP2>(F.lds, g2, S2, E2); } }
#if defined(CLK_PROBE) && !defined(CLK_SITE_ATT)
          if (L2 == 0 && blockIdx.x == CLK_PROBE && F.tid == 0) { const long long dc = clock64() - clk0_, dr = wall_clock64() - rt0_; ((LAS unsigned*)(F0.lds + MISC_OFF))[12] = (unsigned)((dc * 10000) / (dr > 0 ? dr : 1)); }
#endif
          PH_END
          PH_BEGIN(13) { for (int u0 = F.vcu; u0 < 512 * RT_REPS; u0 += F.G) { const int u = u0 & 511; rt::unit(F, i, u >> 7, (u >> 3) & 15, (u >> 2) & 1, u & 3); __syncthreads(); } } PH_END
          PH_BEGIN(14) ph_ret_merge(F, i, L2 == 0); PH_END
          PH_BEGIN(15) { { pg8::Gemm g{WSP(pg8::bf16_t, WS_A), WSP(pg8::bf16_t, WS_WOO) + (size_t)i * DM * 8192, M_LAT, DM, 8192, 0}; pg8::StaticOrder S; S.init(M_LAT, DM, F.G, (int)blockIdx.x);
                       if constexpr (L2 == 1) { pg8::EpiResT<true, false> E{XS, F.out, WSP(float, WS_MOD) + (size_t)l * 5 * MODW + 2 * DM}; pg8::gemm_phase<pg8::EpiResT<true, false>, pg8::StaticOrder, PG8_ALIGN, PG8_SP2>(F.lds, g, S, E); }
                       else { pg8::EpiResT<true, true> E{XS, XS, WSP(float, WS_MOD) + (size_t)l * 5 * MODW + 2 * DM}; pg8::gemm_phase<pg8::EpiResT<true, true>, pg8::StaticOrder, PG8_ALIGN, PG8_SP2>(F.lds, g, S, E); } }
                     if constexpr (L2 == 0) { __syncthreads();
                       pg8::Gemm g{WSP(pg8::bf16_t, WS_A) + (size_t)M_LAT * 8192, WSP(pg8::bf16_t, WS_WOO) + (size_t)i * DM * 8192, M_CTX, DM, 8192 / 4, 8192}; pg8::CtxSplitOrder S; S.init(F.G, (int)blockIdx.x, 8192);
                       pg8::EpiPart E{WSP(float, WS_PART), DM}; pg8::gemm_phase<pg8::EpiPart, pg8::CtxSplitOrder, PG8_ALIGN, PG8_SP2>(F.lds, g, S, E); } } PH_END
        }
    }
#ifdef CLK_PROBE
    __syncthreads();
    if (blockIdx.x == CLK_PROBE && F0.tid == 0) { const unsigned long long ticks = ((LAS unsigned*)(F0.lds + MISC_OFF))[12]; const unsigned long long t0 = wall_clock64(); while ((unsigned long long)wall_clock64() - t0 < ticks) __builtin_amdgcn_s_sleep(8); }
#endif
#undef PH_BEGIN
#undef PH_END
}

extern "C" void kernel_launch(void* const* d_in, const int* in_sizes, int n_in, void* d_out, int out_size, void* d_ws, size_t ws_size, hipStream_t stream) {
    static int grid = 0;
    if (grid == 0) {
        if (n_in != 20 || in_sizes[0] != M_LAT * DM || out_size != M_LAT * DM || ws_size < WS_END4) {
            fprintf(stderr, "kernel_launch: shape mismatch (n_in %d, in0 %d, out %d, ws %zu need %zu); nothing launched\n", n_in, n_in > 0 ? in_sizes[0] : -1, out_size, ws_size, (size_t)WS_END4); grid = -1; return; }
        int dev = 0, cus = 0, per_cu = 0;
        if (hipGetDevice(&dev) != hipSuccess || hipDeviceGetAttribute(&cus, hipDeviceAttributeMultiprocessorCount, dev) != hipSuccess) { grid = -1; return; }
        if (hipFuncSetAttribute((const void*)fwd_kernel, hipFuncAttributeMaxDynamicSharedMemorySize, LDS_BYTES) != hipSuccess) { fprintf(stderr, "kernel_launch: hipFuncSetAttribute failed\n"); grid = -1; return; }
        if (hipOccupancyMaxActiveBlocksPerMultiprocessor(&per_cu, (const void*)fwd_kernel, NWAVES * 64, LDS_BYTES) != hipSuccess || per_cu < 1) { fprintf(stderr, "kernel_launch: occupancy query says %d\n", per_cu); }
        (void)hipGetLastError();
        grid = cus;
    }
    if (grid < 0) return;
    if (hipMemsetAsync((char*)d_ws + WS_CTL, 0, CTL_ZERO_BYTES, stream) != hipSuccess) return;
    Args a{};
    for (int i = 0; i < 20; ++i) a.in[i] = (const float*)d_in[i];
    a.out = (float*)d_out; a.ws = (unsigned char*)d_ws;
#if MK_MULTI
#ifndef DBG_HI
#define DBG_HI N_PHASES
#endif
#ifndef DBG_LO
#define DBG_LO 0
#endif
    for (int p = DBG_LO; p < DBG_HI; ++p) { a.ph_lo = p; a.ph_hi = p + 1; hipLaunchKernelGGL(fwd_kernel, dim3(grid), dim3(NWAVES * 64), LDS_BYTES, stream, a); }
#else
    a.ph_lo = 0; a.ph_hi = N_PHASES; hipLaunchKernelGGL(fwd_kernel, dim3(grid), dim3(NWAVES * 64), LDS_BYTES, stream, a);
#endif
    const hipError_t le = hipPeekAtLastError();
    if (le != hipSuccess) fprintf(stderr, "kernel_launch: launch failed: %s\n", hipGetErrorName(le));
}
```
